# Optimizing an MI355X kernel written in HIP

```python
import jax
import jax.numpy as jnp
from jax import lax
import numpy as np

D_MODEL = 2048
BATCH = 2
SEQ = 4096
DEPTH = 1
DEC_BATCH = 128
DEC_SEQ = 8
PAST_LEN = 16384
PAGE_SIZE = 128

WINDOW = 128
ATT_HEADS = 16
ATT_KV_HEADS = 4
ATT_HEAD_DIM = 64
ATT_GROUP = ATT_HEADS // ATT_KV_HEADS
ATT_Q = ATT_HEADS * ATT_HEAD_DIM
ATT_KV = ATT_KV_HEADS * ATT_HEAD_DIM
RET_HEADS = 8
RET_DK = 128
RET_DV = 256
RET_CHUNK = 128
RET_QK = RET_HEADS * RET_DK
RET_V = RET_HEADS * RET_DV
ROPE_BASE = 10000.0
D_FF = 5632
NORM_EPS = 1e-6
N_SUBLAYERS = 3
IN_SPLITS = (ATT_Q, ATT_KV, ATT_KV, RET_QK, RET_QK, RET_V, RET_V, D_MODEL, D_MODEL)
D_IN = ATT_Q + 2 * ATT_KV + 2 * RET_QK + 2 * RET_V + 2 * D_MODEL

kernel_name = 'hybrid_swa_retention_macaron_step'


def rms_norm(x, gain=None):
    xf = x.astype(jnp.float32)
    y = xf * lax.rsqrt(jnp.mean(xf * xf, axis=-1, keepdims=True) + NORM_EPS)
    if gain is not None:
        y = y * gain.astype(jnp.float32)
    return y.astype(x.dtype)


def swiglu(h, wg, wu, wd):
    return (jax.nn.silu(h @ wg) * (h @ wu)) @ wd


def split_cols(proj):
    parts = []
    start = 0
    for width in IN_SPLITS:
        parts.append(proj[..., start:start + width])
        start += width
    return parts


def rotate(x, pos):
    half = x.shape[-1] // 2
    inv_freq = ROPE_BASE ** (-jnp.linspace(0.0, 1.0, half, dtype=jnp.float32))
    ang = pos[:, None] * inv_freq[None, :]
    cos = jnp.cos(ang)[None, :, None, :]
    sin = jnp.sin(ang)[None, :, None, :]
    x1, x2 = x[..., :half], x[..., half:]
    return jnp.concatenate([x1 * cos - x2 * sin, x1 * sin + x2 * cos], axis=-1)


def alibi_slopes():
    return 2.0 ** (-8.0 * jnp.arange(1, ATT_HEADS + 1, dtype=jnp.float32) / ATT_HEADS)


def window_attend(q, k, v, kvalid, q_off, sinks):
    n, tq = q.shape[0], q.shape[1]
    tk = k.shape[1]
    qg = q.astype(jnp.float32).reshape(n, tq, ATT_KV_HEADS, ATT_GROUP, ATT_HEAD_DIM)
    s = jnp.einsum('nqkgd,nskd->nkgqs', qg, k.astype(jnp.float32)) * (ATT_HEAD_DIM ** -0.5)
    dist = q_off + jnp.arange(tq)[:, None] - jnp.arange(tk)[None, :]
    slopes = alibi_slopes().reshape(ATT_KV_HEADS, ATT_GROUP, 1, 1)
    s = s - slopes * dist.astype(jnp.float32)
    mask = ((dist >= 0) & (dist <= WINDOW))[None, None, None] & kvalid[:, None, None, None, :]
    s = jnp.where(mask, s, -jnp.inf)
    sink = sinks.astype(jnp.float32).reshape(1, ATT_KV_HEADS, ATT_GROUP, 1, 1)
    m = jnp.maximum(jnp.max(s, axis=-1, keepdims=True), sink)
    p = jnp.exp(s - m)
    p = p / (jnp.sum(p, axis=-1, keepdims=True) + jnp.exp(sink - m))
    o = jnp.einsum('nkgqs,nskd->nqkgd', p, v.astype(jnp.float32))
    return o.reshape(n, tq, ATT_Q).astype(q.dtype)


def banded_prompt_attention(q, k, v, sinks):
    b, s_len = q.shape[0], q.shape[1]
    nb = s_len // WINDOW
    pad = jnp.zeros((b, WINDOW) + k.shape[2:], k.dtype)
    kb = jnp.concatenate([pad, k], axis=1).reshape(b, nb + 1, WINDOW, ATT_KV_HEADS, ATT_HEAD_DIM)
    vb = jnp.concatenate([pad, v], axis=1).reshape(b, nb + 1, WINDOW, ATT_KV_HEADS, ATT_HEAD_DIM)
    kblk = jnp.concatenate([kb[:, :-1], kb[:, 1:]], axis=2).reshape(b * nb, 2 * WINDOW, ATT_KV_HEADS, ATT_HEAD_DIM)
    vblk = jnp.concatenate([vb[:, :-1], vb[:, 1:]], axis=2).reshape(b * nb, 2 * WINDOW, ATT_KV_HEADS, ATT_HEAD_DIM)
    qblk = q.reshape(b * nb, WINDOW, ATT_HEADS, ATT_HEAD_DIM)
    key_pos = jnp.arange(nb)[:, None] * WINDOW - WINDOW + jnp.arange(2 * WINDOW)[None, :]
    kvalid = jnp.broadcast_to((key_pos >= 0)[None], (b, nb, 2 * WINDOW)).reshape(b * nb, 2 * WINDOW)
    o = window_attend(qblk, kblk, vblk, kvalid, WINDOW, sinks)
    return o.reshape(b, s_len, ATT_Q)


def retention(q, k, v, s0, chunk):
    n, t, h, dk = q.shape
    dv = v.shape[-1]
    nc = t // chunk
    log_g = jnp.log(1.0 - 2.0 ** (-5.0 - jnp.arange(h, dtype=jnp.float32)))
    idx = jnp.arange(chunk, dtype=jnp.float32)
    diff = idx[:, None] - idx[None, :]
    decay = jnp.where(diff >= 0, jnp.exp(jnp.maximum(diff, 0.0)[None] * log_g[:, None, None]), 0.0)
    qc = q.reshape(n, nc, chunk, h, dk)
    kc = k.reshape(n, nc, chunk, h, dk)
    vc = v.reshape(n, nc, chunk, h, dv)
    scores = jnp.einsum('ncihd,ncjhd->nchij', qc, kc) * decay
    y_in = jnp.einsum('nchij,ncjhe->ncihe', scores, vc)
    k_w = jnp.exp((chunk - 1.0 - idx)[:, None] * log_g[None, :])
    kv = jnp.einsum('ncjhd,ncjhe->nchde', kc * k_w[:, :, None], vc)
    g_chunk = jnp.exp(chunk * log_g)[:, None, None]

    def step(s, kv_i):
        return g_chunk * s + kv_i, s

    s_fin, s_prev = lax.scan(step, s0, jnp.moveaxis(kv, 1, 0))
    q_w = jnp.exp((idx + 1.0)[:, None] * log_g[None, :])
    y_cross = jnp.einsum('ncihd,cnhde->ncihe', qc * q_w[:, :, None], s_prev)
    return (y_in + y_cross).reshape(n, t, h, dv), s_fin


def decoder_layer(x, c, pos, k_past, v_past, s_past, w_ada, b_ada, norm_pre, norm_post, w_in, sinks,
                  w_pa, w_pr, w_o, f1g, f1u, f1d, f2g, f2u, f2d):
    n, t, _ = x.shape
    mod = (jax.nn.silu(c) @ w_ada + b_ada).reshape(n, N_SUBLAYERS, 3, D_MODEL)
    shift, scale, gate = mod[:, :, 0], mod[:, :, 1], mod[:, :, 2]

    def pre(i, y):
        return rms_norm(y, norm_pre[i]) * (1.0 + scale[:, i, None]) + shift[:, i, None]

    def post(i, y):
        return gate[:, i, None] * rms_norm(y, norm_post[i])

    x = x + 0.5 * post(0, swiglu(pre(0, x), f1g, f1u, f1d))

    h = pre(1, x)
    qa, ka, va, qr, kr, vr, gr, gate_a, gate_r = split_cols(h @ w_in)
    qa = qa.reshape(n, t, ATT_HEADS, ATT_HEAD_DIM)
    ka = ka.reshape(n, t, ATT_KV_HEADS, ATT_HEAD_DIM)
    va = va.reshape(n, t, ATT_KV_HEADS, ATT_HEAD_DIM)
    if k_past is None:
        o_a = banded_prompt_attention(qa, ka, va, sinks)
        k_new, v_new = ka[:, -WINDOW:], va[:, -WINDOW:]
        s0 = jnp.zeros((n, RET_HEADS, RET_DK, RET_DV), jnp.float32)
        chunk = RET_CHUNK
    else:
        kcat = jnp.concatenate([k_past.astype(ka.dtype), ka], axis=1)
        vcat = jnp.concatenate([v_past.astype(va.dtype), va], axis=1)
        o_a = window_attend(qa, kcat, vcat, jnp.ones((n, kcat.shape[1]), bool), WINDOW, sinks)
        k_new, v_new = kcat[:, -WINDOW:], vcat[:, -WINDOW:]
        s0 = s_past.astype(jnp.float32)
        chunk = t
    qr = rotate(qr.reshape(n, t, RET_HEADS, RET_DK).astype(jnp.float32), pos)
    kr = rotate(kr.reshape(n, t, RET_HEADS, RET_DK).astype(jnp.float32), pos) * (RET_DK ** -0.5)
    vr = vr.reshape(n, t, RET_HEADS, RET_DV).astype(jnp.float32)
    o_r, s_new = retention(qr, kr, vr, s0, chunk)
    o_r = rms_norm(o_r).reshape(n, t, RET_V).astype(h.dtype)
    o_r = jax.nn.silu(gr) * o_r
    merged = jax.nn.sigmoid(gate_a) * (o_a @ w_pa) + jax.nn.sigmoid(gate_r) * (o_r @ w_pr)
    x = x + post(1, merged @ w_o)

    x = x + 0.5 * post(2, swiglu(pre(2, x), f2g, f2u, f2d))
    return x, k_new, v_new, s_new.astype(x.dtype)


def setup_inputs(seed: int = 0) -> dict:
    key = jax.random.key(seed)
    ks = jax.random.split(key, 22)
    f32 = jnp.float32
    nrm = lambda k, shape, s: jax.random.normal(k, shape, f32) * s
    return {
        'x_prompt': nrm(ks[0], (BATCH, SEQ, D_MODEL), 1.0),
        'x_sample': nrm(ks[1], (DEC_BATCH, DEC_SEQ, D_MODEL), 1.0),
        'cache_k_win': nrm(ks[2], (DEPTH, DEC_BATCH, WINDOW, ATT_KV_HEADS, ATT_HEAD_DIM), 1.0),
        'cache_v_win': nrm(ks[3], (DEPTH, DEC_BATCH, WINDOW, ATT_KV_HEADS, ATT_HEAD_DIM), 1.0),
        'state_ret': nrm(ks[4], (DEPTH, DEC_BATCH, RET_HEADS, RET_DK, RET_DV), 0.5),
        'c_prompt': nrm(ks[5], (BATCH, D_MODEL), 1.0),
        'c_sample': nrm(ks[6], (DEC_BATCH, D_MODEL), 1.0),
        'w_ada': nrm(ks[7], (DEPTH, D_MODEL, N_SUBLAYERS * 3 * D_MODEL), 0.5 * D_MODEL ** -0.5),
        'b_ada': nrm(ks[8], (DEPTH, N_SUBLAYERS * 3 * D_MODEL), 0.02),
        'norm_pre': 1.0 + nrm(ks[9], (DEPTH, N_SUBLAYERS, D_MODEL), 0.05),
        'norm_post': 1.0 + nrm(ks[10], (DEPTH, N_SUBLAYERS, D_MODEL), 0.05),
        'w_in': nrm(ks[11], (DEPTH, D_MODEL, D_IN), D_MODEL ** -0.5),
        'attn_sinks': nrm(ks[12], (DEPTH, ATT_HEADS), 0.5),
        'w_pa': nrm(ks[13], (DEPTH, ATT_Q, D_MODEL), ATT_Q ** -0.5),
        'w_pr': nrm(ks[14], (DEPTH, RET_V, D_MODEL), RET_V ** -0.5),
        'w_o': nrm(ks[15], (DEPTH, D_MODEL, D_MODEL), D_MODEL ** -0.5),
        'ffn1_gate': nrm(ks[16], (DEPTH, D_MODEL, D_FF), D_MODEL ** -0.5),
        'ffn1_up': nrm(ks[17], (DEPTH, D_MODEL, D_FF), D_MODEL ** -0.5),
        'ffn1_down': nrm(ks[18], (DEPTH, D_FF, D_MODEL), D_FF ** -0.5),
        'ffn2_gate': nrm(ks[19], (DEPTH, D_MODEL, D_FF), D_MODEL ** -0.5),
        'ffn2_up': nrm(ks[20], (DEPTH, D_MODEL, D_FF), D_MODEL ** -0.5),
        'ffn2_down': nrm(ks[21], (DEPTH, D_FF, D_MODEL), D_FF ** -0.5),
    }


def reference(x_prompt, x_sample, cache_k_win, cache_v_win, state_ret, c_prompt, c_sample,
              w_ada, b_ada, norm_pre, norm_post, w_in, attn_sinks, w_pa, w_pr, w_o,
              ffn1_gate, ffn1_up, ffn1_down, ffn2_gate, ffn2_up, ffn2_down):
    pos_p = jnp.arange(x_prompt.shape[1], dtype=jnp.float32)
    pos_s = jnp.arange(x_sample.shape[1], dtype=jnp.float32) + PAST_LEN
    yp, ys = x_prompt, x_sample
    kp_l, vp_l, sp_l, ks_l, vs_l, ss_l = [], [], [], [], [], []
    for l in range(DEPTH):
        w = (w_ada[l], b_ada[l], norm_pre[l], norm_post[l], w_in[l], attn_sinks[l], w_pa[l], w_pr[l],
             w_o[l], ffn1_gate[l], ffn1_up[l], ffn1_down[l], ffn2_gate[l], ffn2_up[l], ffn2_down[l])
        yp, kp, vp, sp = decoder_layer(yp, c_prompt, pos_p, None, None, None, *w)
        ys, kss, vss, sss = decoder_layer(ys, c_sample, pos_s, cache_k_win[l], cache_v_win[l], state_ret[l], *w)
        kp_l.append(kp)
        vp_l.append(vp)
        sp_l.append(sp)
        ks_l.append(kss)
        vs_l.append(vss)
        ss_l.append(sss)
    k_win_prompt = jnp.stack(kp_l)
    v_win_prompt = jnp.stack(vp_l)
    state_ret_prompt = jnp.stack(sp_l)
    k_win_sample = jnp.stack(ks_l)
    v_win_sample = jnp.stack(vs_l)
    state_ret_sample = jnp.stack(ss_l)
    return (yp, ys, k_win_prompt, v_win_prompt, state_ret_prompt, k_win_sample, v_win_sample, state_ret_sample)
```

```cpp
#include <hip/hip_runtime.h>
#include <hip/hip_cooperative_groups.h>
#include <cstdio>
#include <cstdint>
namespace cg = cooperative_groups;

#ifndef MK_SPLIT
#define MK_SPLIT 0
#endif

namespace pg8 {
#define PG8_LAS __attribute__((address_space(3)))
typedef unsigned short bf16_t;
typedef short bf16x8 __attribute__((ext_vector_type(8)));
typedef float f32x4 __attribute__((ext_vector_type(4)));
typedef unsigned u32x4 __attribute__((ext_vector_type(4)));
typedef unsigned u32x2 __attribute__((ext_vector_type(2)));
constexpr int BM = 256, BK = 64, HALF = 128, HTB = HALF * BK * 2  , STAGE_BYTES = 8 * HTB, NXCD = 8, WGM = 8;

__host__ __device__ __forceinline__ int lds_byte(int r, int c) { const int st = (r >> 4) * 2 + (c >> 5), rr = r & 15, cc = c & 31, ob = rr * 64 + cc * 2; return st * 1024 + (ob ^ (((ob >> 9) & 1) << 5)); }
__host__ __device__ __forceinline__ void stage_rc(int b, int& R, int& C) { const int st = b / 1024, sb = b % 1024, swz = sb ^ (((sb >> 9) & 1) << 5); R = (st >> 1) * 16 + swz / 64; C = (st & 1) * 32 + (swz % 64) / 2; }
__host__ __device__ __forceinline__ int perm32(int rho) { const int n = rho >> 4, i = rho & 15; return 8 * (i >> 2) + 4 * n + (i & 3); }

struct Unit { int pm, pn, ks; };
struct Gemm { const bf16_t* A; const bf16_t* Bt; int M, N, K, ld; };

struct StaticOrder {
    int nM, nN, nwg, G, c, ns;
    __host__ __device__ void init(int M, int N, int G_, int c_, int ns_ = 1) { nM = M / BM; nN = N / BM; nwg = nM * nN; G = G_; c = c_; ns = ns_; }
    __host__ __device__ bool next(int i, Unit& u) const {
        const long L = (long)i * G + c; if (L >= (long)nwg * ns) return false;
        u.ks = (int)(L / nwg);
        int wgid = (int)(L - (long)u.ks * nwg); { const int q = nwg / NXCD, r = nwg % NXCD, xcd = wgid % NXCD, off = wgid / NXCD; wgid = (xcd < r ? xcd * (q + 1) : r * (q + 1) + (xcd - r) * q) + off; }
        const int nig = WGM * nN, gid = wgid / nig, fm = gid * WGM, gsz = (nM - fm) < WGM ? (nM - fm) : WGM;
        u.pm = fm + ((wgid % nig) % gsz); u.pn = (wgid % nig) / gsz; return true;
    }
    __device__ __forceinline__ void a_ready(const Unit&) const {}
    __device__ __forceinline__ void done(const Unit&) const {}
};

typedef float f32x2_cv __attribute__((ext_vector_type(2)));
typedef __bf16 bf16x2_cv __attribute__((ext_vector_type(2)));
__device__ __forceinline__ unsigned cvt_pk_bf16(float lo, float hi) { const f32x2_cv v = {lo, hi}; const bf16x2_cv b = __builtin_convertvector(v, bf16x2_cv); return __builtin_bit_cast(unsigned, b); }

template <class Epi, class Sched>
__device__ __forceinline__ void gemm_phase(PG8_LAS unsigned char* lds, const Gemm g, const Sched& S, const Epi& E) {
    int tid_ = threadIdx.x; asm volatile("" : "+v"(tid_));
    const int tid = tid_, wid = __builtin_amdgcn_readfirstlane(tid >> 6), lane = tid & 63, wr = wid >> 2, wc = wid & 3, fr = lane & 15, fq = lane >> 4;
    const int K = g.ld, nt = g.K / BK;
    unsigned voffA[2], voffB[2];
#pragma unroll
    for (int i = 0; i < 2; ++i) { int R, C; stage_rc(tid * 16 + i * 8192, R, C); const int Rb = Epi::PERM ? ((R & ~31) + perm32(R & 31)) : R;
        voffA[i] = (unsigned)(R * K + C) * 2u; voffB[i] = (unsigned)(Rb * K + C) * 2u; }
    const size_t kstep = (size_t)(BK * 2);
    const size_t hstep = (size_t)HALF * K * 2;
    const size_t tstep = 2 * hstep;
    const unsigned ldsw = (unsigned)wid * 1024u;
    const int aoff = lds_byte(wr * 64 + fr, fq * 8), boff = lds_byte(wc * 32 + fr, fq * 8);
#define PG8_SA(b, h) (((b) * 2 + (h)) * HTB)
#define PG8_SB(b, h) ((4 + (b) * 2 + (h)) * HTB)
#define PG8_STAGE(bufoff, gbase, voff) do { _Pragma("unroll") for (int _i = 0; _i < 2; ++_i) \
        __builtin_amdgcn_global_load_lds((const unsigned*)((const char*)(gbase) + (voff)[_i]), (PG8_LAS unsigned*)(lds + (bufoff) + ldsw + _i * 8192), 16, 0, 0); } while (0)
#define PG8_LDA(dst, b, h) do { _Pragma("unroll") for (int m = 0; m < 4; ++m) _Pragma("unroll") for (int k = 0; k < 2; ++k) dst[m][k] = *(const PG8_LAS bf16x8*)(lds + PG8_SA(b, h) + aoff + m * 2048 + k * 1024); } while (0)
#define PG8_LDB(dst, b, h) do { _Pragma("unroll") for (int n = 0; n < 2; ++n) _Pragma("unroll") for (int k = 0; k < 2; ++k) dst[n][k] = *(const PG8_LAS bf16x8*)(lds + PG8_SB(b, h) + boff + n * 2048 + k * 1024); } while (0)
#define PG8_MMA(ai, bj, At, Bt) do { __builtin_amdgcn_s_setprio(1); _Pragma("unroll") for (int m = 0; m < 4; ++m) _Pragma("unroll") for (int n = 0; n < 2; ++n) _Pragma("unroll") for (int k = 0; k < 2; ++k) \
        acc[ai][bj][m][n] = __builtin_amdgcn_mfma_f32_16x16x32_bf16(Bt[n][k], At[m][k], acc[ai][bj][m][n], 0, 0, 0); __builtin_amdgcn_s_setprio(0); } while (0)
#define PG8_WAIT_V(n) asm volatile("s_waitcnt vmcnt(" #n ")" ::: "memory")
#define PG8_WAIT_L(n) asm volatile("s_waitcnt lgkmcnt(" #n ")" ::: "memory")
#define PG8_BAR __builtin_amdgcn_s_barrier()
#define PG8_SCHED __builtin_amdgcn_sched_barrier(0)
    Unit cur, nxt; int ui = 0;
    if (!S.next(0, cur)) return;
    f32x4 acc[2][2][4][2];
#pragma unroll
    for (int a = 0; a < 2; ++a)
#pragma unroll
        for (int b = 0; b < 2; ++b)
#pragma unroll
            for (int m = 0; m < 4; ++m)
#pragma unroll
                for (int n = 0; n < 2; ++n) acc[a][b][m][n] = (f32x4){0.f, 0.f, 0.f, 0.f};
    bf16x8 At[4][2], B0[2][2], B1[2][2];
    const size_t ksb = (size_t)g.K * 2;
    const char* cA = (const char*)g.A + (size_t)cur.pm * tstep + (size_t)cur.ks * ksb; const char* cB = (const char*)g.Bt + (size_t)cur.pn * tstep + (size_t)cur.ks * ksb;
    S.a_ready(cur);
    PG8_STAGE(PG8_SB(0, 0), cB, voffB); PG8_STAGE(PG8_SB(0, 1), cB + hstep, voffB); PG8_STAGE(PG8_SA(0, 0), cA, voffA); PG8_STAGE(PG8_SA(0, 1), cA + hstep, voffA);
    if (wr == 1) PG8_BAR;
    PG8_WAIT_V(2); PG8_BAR;
    PG8_STAGE(PG8_SB(1, 0), cB + kstep, voffB); PG8_STAGE(PG8_SA(1, 0), cA + kstep, voffA); PG8_STAGE(PG8_SB(1, 1), cB + hstep + kstep, voffB);
    PG8_WAIT_V(6); PG8_BAR;
    for (;;) {
        const bool has_next = S.next(ui + 1, nxt);
        const char* nA = has_next ? (const char*)g.A + (size_t)nxt.pm * tstep + (size_t)nxt.ks * ksb : cA; const char* nB = has_next ? (const char*)g.Bt + (size_t)nxt.pn * tstep + (size_t)nxt.ks * ksb : cB;
        for (int t = 0; t < nt; t += 2) {
            const bool last = (t == nt - 2);
            const char* a1 = cA + (size_t)(t + 1) * kstep;
            const char* a2 = last ? nA : cA + (size_t)(t + 2) * kstep; const char* b2 = last ? nB : cB + (size_t)(t + 2) * kstep;
            const char* a3 = a2 + kstep; const char* b3 = b2 + kstep;
            if (last && has_next) S.a_ready(nxt);
            PG8_LDB(B0, 0, 0); PG8_LDB(B1, 0, 1); PG8_SCHED; PG8_LDA(At, 0, 0); PG8_STAGE(PG8_SA(1, 1), a1 + hstep, voffA);
            PG8_WAIT_V(8); PG8_WAIT_L(0); PG8_BAR; PG8_MMA(0, 0, At, B0); PG8_MMA(0, 1, At, B1); PG8_BAR; PG8_SCHED;
            PG8_LDA(At, 0, 1); PG8_STAGE(PG8_SB(0, 0), b2, voffB); PG8_STAGE(PG8_SB(0, 1), b2 + hstep, voffB); PG8_STAGE(PG8_SA(0, 0), a2, voffA);
            PG8_WAIT_V(8); PG8_WAIT_L(0); PG8_BAR; PG8_MMA(1, 0, At, B0); PG8_MMA(1, 1, At, B1); PG8_BAR; PG8_SCHED;
            PG8_LDB(B0, 1, 0); PG8_LDB(B1, 1, 1); PG8_SCHED; PG8_LDA(At, 1, 0); PG8_STAGE(PG8_SA(0, 1), a2 + hstep, voffA);
            PG8_WAIT_V(8); PG8_WAIT_L(0); PG8_BAR; PG8_MMA(0, 0, At, B0); PG8_MMA(0, 1, At, B1); PG8_BAR; PG8_SCHED;
            PG8_LDA(At, 1, 1); PG8_STAGE(PG8_SB(1, 0), b3, voffB); PG8_STAGE(PG8_SB(1, 1), b3 + hstep, voffB); PG8_STAGE(PG8_SA(1, 0), a3, voffA);
            PG8_WAIT_V(8); PG8_WAIT_L(0); PG8_BAR; PG8_MMA(1, 0, At, B0); PG8_MMA(1, 1, At, B1); PG8_BAR; PG8_SCHED;
        }
        if (wr == 0) PG8_BAR;
        if constexpr (!Epi::AFTER_DRAIN) { E(acc, cur, wr, wc, fr, fq); S.done(cur); }
        if (!has_next) break;
#pragma unroll
        for (int a = 0; a < 2; ++a)
#pragma unroll
            for (int b = 0; b < 2; ++b)
#pragma unroll
                for (int m = 0; m < 4; ++m)
#pragma unroll
                    for (int n = 0; n < 2; ++n) acc[a][b][m][n] = (f32x4){0.f, 0.f, 0.f, 0.f};
        cur = nxt; cA = nA; cB = nB; ++ui;
        if (wr == 1) PG8_BAR;
    }
    PG8_WAIT_V(0);
    PG8_BAR;
    if constexpr (Epi::AFTER_DRAIN) { E.fused(acc, cur, wr, wc, fr, fq, lds, wid, lane); S.done(cur); }
#undef PG8_SA
#undef PG8_SB
#undef PG8_STAGE
#undef PG8_LDA
#undef PG8_LDB
#undef PG8_MMA
#undef PG8_WAIT_V
#undef PG8_WAIT_L
#undef PG8_BAR
#undef PG8_SCHED
}
}

using pg8::bf16_t; using pg8::bf16x8; using pg8::f32x4; using pg8::u32x4; using pg8::u32x2; using pg8::cvt_pk_bf16;
#define LAS __attribute__((address_space(3)))
#define LDS_WAIT() asm volatile("s_waitcnt lgkmcnt(0)" ::: "memory")

constexpr int D = 2048, NP = 8192, NS = 1024, MT = 9216, DFF = 5632, DIN = 11776, NADA = 18432;
constexpr int C_QA = 0, C_KA = 1024, C_VA = 1280, C_QR = 1536, C_KR = 2560, C_VR = 3584, C_GR = 5632, C_GA = 7680, C_GB = 9728;
constexpr float EPS = 1e-6f;
constexpr int LDS_BYTES = 147456;
constexpr int NPH = 16;
enum { PH_PREP = 0, PH_ADA, PH_ROW0, PH_GU1, PH_D1, PH_ROW1, PH_WIN, PH_MIX1, PH_SCAN, PH_RET3, PH_PAPR, PH_WO, PH_ROW2, PH_GU2, PH_D2, PH_ROW3 };

constexpr size_t al256(size_t x) { return (x + 255) & ~(size_t)255; }
constexpr size_t SZ_WGU = (size_t)2 * DFF * D * 2, SZ_WD = (size_t)D * DFF * 2, SZ_WIN = (size_t)DIN * D * 2, SZ_WPA = (size_t)D * 1024 * 2, SZ_WPR = (size_t)D * D * 2, SZ_WO = (size_t)D * D * 2;
constexpr size_t WS_WGU1 = 16384;
constexpr size_t WS_WD1 = WS_WGU1 + SZ_WGU;
constexpr size_t WS_WIN = WS_WD1 + SZ_WD;
constexpr size_t WS_WPA = WS_WIN + SZ_WIN;
constexpr size_t WS_WPR = WS_WPA + SZ_WPA;
constexpr size_t WS_WO = WS_WPR + SZ_WPR;
constexpr size_t WS_WGU2 = WS_WO + SZ_WO;
constexpr size_t WS_WD2 = WS_WGU2 + SZ_WGU;
constexpr size_t WS_MOD = WS_WD2 + SZ_WD;
constexpr size_t WS_CS = WS_MOD + (size_t)256 * NADA * 4;
constexpr size_t WS_ROTC = WS_CS + (size_t)256 * D * 2;
constexpr size_t WS_ROTS = WS_ROTC + al256((size_t)4104 * 64 * 4);
constexpr size_t WS_HB = WS_ROTS + al256((size_t)4104 * 64 * 4);
constexpr size_t WS_F = WS_HB + (size_t)MT * D * 2;
constexpr size_t WS_PROJ = WS_F + (size_t)MT * D * 4;
constexpr size_t WS_PART23 = WS_PROJ + (size_t)MT * DFF * 2;
constexpr size_t WS_OA = WS_PROJ + (size_t)MT * DIN * 2;
constexpr size_t WS_OR = WS_OA + (size_t)MT * 1024 * 2;
constexpr size_t WS_SPT = WS_OR + (size_t)MT * D * 2;
constexpr size_t WS_VT = WS_SPT + (size_t)512 * 32768 * 2;
constexpr size_t WS_END = WS_VT + (size_t)512 * 32768 * 2;

constexpr size_t O_Y = 0, O_KWP = (size_t)MT * D, O_VWP = O_KWP + 65536, O_SRP = O_VWP + 65536, O_KWS = O_SRP + 524288, O_VWS = O_KWS + 4194304, O_SRS = O_VWS + 4194304;

struct Params {
    const float* in[22];
    float* out;
    unsigned char* ws;
    int ph_lo, ph_hi;
};
enum { I_XP = 0, I_XS, I_CK, I_CV, I_ST, I_CP, I_CSM, I_WADA, I_BADA, I_NPRE, I_NPOST, I_WIN, I_SINK, I_WPA, I_WPR, I_WO, I_F1G, I_F1U, I_F1D, I_F2G, I_F2U, I_F2D };

__device__ __forceinline__ float bf2f(unsigned short b) { return __uint_as_float(((unsigned)b) << 16); }
__device__ __forceinline__ float bflo(unsigned w) { return __uint_as_float(w << 16); }
__device__ __forceinline__ float bfhi(unsigned w) { return __uint_as_float(w & 0xffff0000u); }
__device__ __forceinline__ float wave_sum(float v) {
#pragma unroll
    for (int o = 1; o < 64; o <<= 1) v += __shfl_xor(v, o);
    return v;
}
__device__ __forceinline__ float wave_max(float v) {
#pragma unroll
    for (int o = 1; o < 64; o <<= 1) v = fmaxf(v, __shfl_xor(v, o));
    return v;
}
__device__ __forceinline__ float silu_f(float x) { return x * __builtin_amdgcn_rcpf(1.0f + __expf(-x)); }
__device__ __forceinline__ float sigm_f(float x) { return __builtin_amdgcn_rcpf(1.0f + __expf(-x)); }
__device__ __forceinline__ float log2_gamma(int h) { return log2f(1.0f - exp2f(-5.0f - (float)h)); }
__device__ __forceinline__ f32x4 mfma16(bf16x8 a, bf16x8 b, f32x4 c) { return __builtin_amdgcn_mfma_f32_16x16x32_bf16(a, b, c, 0, 0, 0); }

struct EpiF32 {
    static constexpr bool PERM = false, AFTER_DRAIN = false;
    float* C; int ldc; const float* bias;
    __device__ __forceinline__ void operator()(const f32x4 (&acc)[2][2][4][2], const pg8::Unit& u, int wr, int wc, int fr, int fq) const {
        const int row0 = u.pm * 256 + wr * 64 + fr, col0 = u.pn * 256 + wc * 32 + 4 * fq;
        f32x4 bv[2][2];
#pragma unroll
        for (int bj = 0; bj < 2; ++bj)
#pragma unroll
            for (int n = 0; n < 2; ++n) bv[bj][n] = bias ? *(const f32x4*)(bias + col0 + bj * 128 + n * 16) : (f32x4){0.f, 0.f, 0.f, 0.f};
#pragma unroll
        for (int ai = 0; ai < 2; ++ai)
#pragma unroll
            for (int m = 0; m < 4; ++m) { float* rowp = C + (size_t)(row0 + ai * 128 + m * 16) * ldc + col0;
#pragma unroll
                for (int bj = 0; bj < 2; ++bj)
#pragma unroll
                    for (int n = 0; n < 2; ++n) *(f32x4*)(rowp + bj * 128 + n * 16) = acc[ai][bj][m][n] + bv[bj][n]; }
    }
};
struct EpiPart {
    static constexpr bool PERM = true, AFTER_DRAIN = false;
    bf16_t* P01; bf16_t* P23;
    __device__ __forceinline__ void operator()(const f32x4 (&acc)[2][2][4][2], const pg8::Unit& u, int wr, int wc, int fr, int fq) const {
        bf16_t* O = (u.ks < 2 ? P01 : P23) + (size_t)(u.ks & 1) * MT * D;
        const int row0 = u.pm * 256 + wr * 64 + fr, col0 = u.pn * 256 + wc * 32 + 8 * fq;
#pragma unroll
        for (int ai = 0; ai < 2; ++ai)
#pragma unroll
            for (int m = 0; m < 4; ++m) {
                bf16_t* rowp = O + (size_t)(row0 + ai * 128 + m * 16) * D + col0;
#pragma unroll
                for (int bj = 0; bj < 2; ++bj) {
                    const f32x4 v0 = acc[ai][bj][m][0], v1 = acc[ai][bj][m][1];
                    u32x4 w; w.x = cvt_pk_bf16(v0[0], v0[1]); w.y = cvt_pk_bf16(v0[2], v0[3]); w.z = cvt_pk_bf16(v1[0], v1[1]); w.w = cvt_pk_bf16(v1[2], v1[3]);
                    *(u32x4*)(rowp + bj * 128) = w;
                }
            }
    }
};
struct EpiSwiGLU {
    static constexpr bool PERM = true, AFTER_DRAIN = false;
    bf16_t* O;
    __device__ __forceinline__ void operator()(const f32x4 (&acc)[2][2][4][2], const pg8::Unit& u, int wr, int wc, int fr, int fq) const {
        const int row0 = u.pm * 256 + wr * 64 + fr, col0 = u.pn * 128 + wc * 32 + 8 * fq;
#pragma unroll
        for (int ai = 0; ai < 2; ++ai)
#pragma unroll
            for (int m = 0; m < 4; ++m) {
                bf16_t* rowp = O + (size_t)(row0 + ai * 128 + m * 16) * DFF + col0;
                const f32x4 g0 = acc[ai][0][m][0], g1 = acc[ai][0][m][1], u0 = acc[ai][1][m][0], u1 = acc[ai][1][m][1];
                u32x4 w;
                w.x = cvt_pk_bf16(silu_f(g0[0]) * u0[0], silu_f(g0[1]) * u0[1]); w.y = cvt_pk_bf16(silu_f(g0[2]) * u0[2], silu_f(g0[3]) * u0[3]);
                w.z = cvt_pk_bf16(silu_f(g1[0]) * u1[0], silu_f(g1[1]) * u1[1]); w.w = cvt_pk_bf16(silu_f(g1[2]) * u1[2], silu_f(g1[3]) * u1[3]);
                *(u32x4*)rowp = w;
            }
    }
};
struct EpiWin {
    static constexpr bool PERM = true, AFTER_DRAIN = false;
    bf16_t* O; const float* rc; const float* rs;
    __device__ __forceinline__ void operator()(const f32x4 (&acc)[2][2][4][2], const pg8::Unit& u, int wr, int wc, int fr, int fq) const {
        const int pn = u.pn, row0 = u.pm * 256 + wr * 64 + fr;
        if (pn >= 6 && pn < 14) {
            const int slice = (pn - 6) >> 2, tt = (pn - 6) & 3, head = 2 * tt + (wc >> 1), d0 = 32 * (wc & 1) + 8 * fq;
            const int colbase = C_QR + slice * 1024 + head * 128 + d0;
            const float sc = slice ? 0.08838834764831845f : 1.0f;
#pragma unroll
            for (int ai = 0; ai < 2; ++ai) {
                f32x4 tc0[4], tc1[4], ts0[4], ts1[4];
#pragma unroll
                for (int m = 0; m < 4; ++m) {
                    const int row = row0 + ai * 128 + m * 16;
                    const int pidx = row < NP ? (row & 4095) : 4096 + ((row - NP) & 7);
                    tc0[m] = *(const f32x4*)(rc + pidx * 64 + d0); tc1[m] = *(const f32x4*)(rc + pidx * 64 + d0 + 4);
                    ts0[m] = *(const f32x4*)(rs + pidx * 64 + d0); ts1[m] = *(const f32x4*)(rs + pidx * 64 + d0 + 4);
                }
#pragma unroll
                for (int m = 0; m < 4; ++m) {
                    const int row = row0 + ai * 128 + m * 16;
                    const f32x4 c0 = tc0[m], c1 = tc1[m], s0 = ts0[m], s1 = ts1[m];
                    const f32x4 a0 = acc[ai][0][m][0] * sc, a1 = acc[ai][0][m][1] * sc, b0 = acc[ai][1][m][0] * sc, b1 = acc[ai][1][m][1] * sc;
                    const f32x4 p0 = a0 * c0 - b0 * s0, p1 = a1 * c1 - b1 * s1, q0 = a0 * s0 + b0 * c0, q1 = a1 * s1 + b1 * c1;
                    u32x4 w1, w2;
                    w1.x = cvt_pk_bf16(p0[0], p0[1]); w1.y = cvt_pk_bf16(p0[2], p0[3]); w1.z = cvt_pk_bf16(p1[0], p1[1]); w1.w = cvt_pk_bf16(p1[2], p1[3]);
                    w2.x = cvt_pk_bf16(q0[0], q0[1]); w2.y = cvt_pk_bf16(q0[2], q0[3]); w2.z = cvt_pk_bf16(q1[0], q1[1]); w2.w = cvt_pk_bf16(q1[2], q1[3]);
                    bf16_t* rowp = O + (size_t)row * DIN + colbase;
                    *(u32x4*)rowp = w1; *(u32x4*)(rowp + 64) = w2;
                }
            }
        } else {
            const int mode = pn < 22 ? 0 : (pn < 30 ? 1 : 2);
            const int col0 = pn * 256 + wc * 32 + 8 * fq;
#pragma unroll
            for (int ai = 0; ai < 2; ++ai)
#pragma unroll
                for (int m = 0; m < 4; ++m) {
                    bf16_t* rowp = O + (size_t)(row0 + ai * 128 + m * 16) * DIN + col0;
#pragma unroll
                    for (int bj = 0; bj < 2; ++bj) {
                        f32x4 v0 = acc[ai][bj][m][0], v1 = acc[ai][bj][m][1];
                        if (mode == 1) {
#pragma unroll
                            for (int j = 0; j < 4; ++j) { v0[j] = silu_f(v0[j]); v1[j] = silu_f(v1[j]); }
                        } else if (mode == 2) {
#pragma unroll
                            for (int j = 0; j < 4; ++j) { v0[j] = sigm_f(v0[j]); v1[j] = sigm_f(v1[j]); }
                        }
                        u32x4 w; w.x = cvt_pk_bf16(v0[0], v0[1]); w.y = cvt_pk_bf16(v0[2], v0[3]); w.z = cvt_pk_bf16(v1[0], v1[1]); w.w = cvt_pk_bf16(v1[2], v1[3]);
                        *(u32x4*)(rowp + bj * 128) = w;
                    }
                }
        }
    }
};
struct EpiPa {
    static constexpr bool PERM = true, AFTER_DRAIN = false;
    float* T; const bf16_t* P;
    __device__ __forceinline__ void operator()(const f32x4 (&acc)[2][2][4][2], const pg8::Unit& u, int wr, int wc, int fr, int fq) const {
        const int row0 = u.pm * 256 + wr * 64 + fr, col0 = u.pn * 256 + wc * 32 + 8 * fq;
#pragma unroll
        for (int ai = 0; ai < 2; ++ai) {
            u32x4 gq[4][2];
#pragma unroll
            for (int m = 0; m < 4; ++m)
#pragma unroll
                for (int bj = 0; bj < 2; ++bj) gq[m][bj] = *(const u32x4*)(P + (size_t)(row0 + ai * 128 + m * 16) * DIN + C_GA + col0 + bj * 128);
#pragma unroll
            for (int m = 0; m < 4; ++m) {
                const int row = row0 + ai * 128 + m * 16;
#pragma unroll
                for (int bj = 0; bj < 2; ++bj) {
                    const u32x4 g = gq[m][bj];
                    f32x4 v0 = acc[ai][bj][m][0], v1 = acc[ai][bj][m][1];
                    v0[0] *= bflo(g.x); v0[1] *= bfhi(g.x); v0[2] *= bflo(g.y); v0[3] *= bfhi(g.y);
                    v1[0] *= bflo(g.z); v1[1] *= bfhi(g.z); v1[2] *= bflo(g.w); v1[3] *= bfhi(g.w);
                    float* tp = T + (size_t)row * D + col0 + bj * 128;
                    *(f32x4*)tp = v0; *(f32x4*)(tp + 4) = v1;
                }
            }
        }
    }
};
struct EpiPr {
    static constexpr bool PERM = true, AFTER_DRAIN = false;
    const float* T; const bf16_t* P; bf16_t* O;
    __device__ __forceinline__ void operator()(const f32x4 (&acc)[2][2][4][2], const pg8::Unit& u, int wr, int wc, int fr, int fq) const {
        const int row0 = u.pm * 256 + wr * 64 + fr, col0 = u.pn * 256 + wc * 32 + 8 * fq;
#pragma unroll
        for (int ai = 0; ai < 2; ++ai)
#pragma unroll
            for (int mp = 0; mp < 2; ++mp) {
                u32x4 gq[2][2]; f32x4 t0[2][2], t1[2][2];
#pragma unroll
                for (int mi = 0; mi < 2; ++mi)
#pragma unroll
                    for (int bj = 0; bj < 2; ++bj) {
                        const int row = row0 + ai * 128 + (2 * mp + mi) * 16;
                        gq[mi][bj] = *(const u32x4*)(P + (size_t)row * DIN + C_GB + col0 + bj * 128);
                        const float* tp = T + (size_t)row * D + col0 + bj * 128;
                        t0[mi][bj] = *(const f32x4*)tp; t1[mi][bj] = *(const f32x4*)(tp + 4);
                    }
#pragma unroll
                for (int mi = 0; mi < 2; ++mi)
#pragma unroll
                    for (int bj = 0; bj < 2; ++bj) {
                        const int m = 2 * mp + mi, row = row0 + ai * 128 + m * 16;
                        const u32x4 g = gq[mi][bj]; const f32x4 a0 = t0[mi][bj], a1 = t1[mi][bj];
                        f32x4 v0 = acc[ai][bj][m][0], v1 = acc[ai][bj][m][1];
                        v0[0] = a0[0] + v0[0] * bflo(g.x); v0[1] = a0[1] + v0[1] * bfhi(g.x); v0[2] = a0[2] + v0[2] * bflo(g.y); v0[3] = a0[3] + v0[3] * bfhi(g.y);
                        v1[0] = a1[0] + v1[0] * bflo(g.z); v1[1] = a1[1] + v1[1] * bfhi(g.z); v1[2] = a1[2] + v1[2] * bflo(g.w); v1[3] = a1[3] + v1[3] * bfhi(g.w);
                        u32x4 w; w.x = cvt_pk_bf16(v0[0], v0[1]); w.y = cvt_pk_bf16(v0[2], v0[3]); w.z = cvt_pk_bf16(v1[0], v1[1]); w.w = cvt_pk_bf16(v1[2], v1[3]);
                        *(u32x4*)(O + (size_t)row * D + col0 + bj * 128) = w;
                    }
            }
    }
};

template <class Epi>
__device__ __forceinline__ void run_gemm(LAS unsigned char* lds, const bf16_t* A, const bf16_t* Bt, int M, int N, int K, const Epi& E, int ns = 1) {
    pg8::Gemm g; g.A = A; g.Bt = Bt; g.M = M; g.N = N; g.K = K / ns; g.ld = K;
    pg8::StaticOrder S; S.init(M, N, (int)gridDim.x, (int)blockIdx.x, ns);
    pg8::gemm_phase<Epi, pg8::StaticOrder>(lds, g, S, E);
}

__device__ __forceinline__ void transpose_item(const float* __restrict__ W, int K, int N, bf16_t* WT, int k0, int n0, int drow, LAS float* scr, int lane) {
#pragma unroll 8
    for (int i = 0; i < 32; ++i) { const int kk = 2 * i + (lane >> 5); scr[kk * 33 + (lane & 31)] = W[(size_t)(k0 + kk) * N + n0 + (lane & 31)]; }
    LDS_WAIT();
    const int c = lane & 7;
#pragma unroll
    for (int j = 0; j < 4; ++j) { const int n = (lane >> 3) + 8 * j; const LAS float* s = scr + (8 * c) * 33 + n;
        u32x4 o; o.x = cvt_pk_bf16(s[0 * 33], s[1 * 33]); o.y = cvt_pk_bf16(s[2 * 33], s[3 * 33]); o.z = cvt_pk_bf16(s[4 * 33], s[5 * 33]); o.w = cvt_pk_bf16(s[6 * 33], s[7 * 33]);
        *(u32x4*)(WT + (size_t)(drow + n) * K + k0 + 8 * c) = o; }
    LDS_WAIT();
}
__device__ __forceinline__ int map_gu(int n0, int up) { return 256 * (n0 >> 7) + (n0 & 127) + (up ? 128 : 0); }
__device__ __forceinline__ int map_win(int n0) {
    if (n0 < C_QR || n0 >= C_VR) return n0;
    const int s = n0 - C_QR, slice = s >> 10, within = s & 1023, h = within >> 7, half = (within >> 6) & 1, d0 = within & 63;
    return C_QR + slice * 1024 + (h >> 1) * 256 + half * 128 + (h & 1) * 64 + d0;
}
__device__ __forceinline__ int tjob_items(int j) {
    return (j == 0 || j == 1 || j == 7 || j == 8) ? (D / 64) * (DFF / 32) : (j == 2 || j == 9) ? (DFF / 64) * (D / 32) : j == 3 ? (D / 64) * (DIN / 32) : j == 4 ? (1024 / 64) * (D / 32) : (D / 64) * (D / 32);
}
__device__ __forceinline__ void run_tjobs(const Params& p, LAS unsigned char* lds, int jlo, int jhi, int widx, int nw, int skip = 0, int limit = 0x7fffffff) {
    const int lane = threadIdx.x & 63, wave = threadIdx.x >> 6;
    LAS float* scr = (LAS float*)(lds + wave * 8704);
    unsigned char* ws = p.ws;
    int total = 0;
    for (int j = jlo; j < jhi; ++j) total += tjob_items(j);
    if (total > skip + limit) total = skip + limit;
    for (int it = skip + widx; it < total; it += nw) {
        int r = it, j = jlo;
        while (r >= tjob_items(j)) { r -= tjob_items(j); ++j; }
        const float* W; int K, N; bf16_t* WT; int kind;
        switch (j) {
        case 0: W = p.in[I_F1G]; K = D; N = DFF; WT = (bf16_t*)(ws + WS_WGU1); kind = 1; break;
        case 1: W = p.in[I_F1U]; K = D; N = DFF; WT = (bf16_t*)(ws + WS_WGU1); kind = 2; break;
        case 2: W = p.in[I_F1D]; K = DFF; N = D; WT = (bf16_t*)(ws + WS_WD1); kind = 0; break;
        case 3: W = p.in[I_WIN]; K = D; N = DIN; WT = (bf16_t*)(ws + WS_WIN); kind = 3; break;
        case 4: W = p.in[I_WPA]; K = 1024; N = D; WT = (bf16_t*)(ws + WS_WPA); kind = 0; break;
        case 5: W = p.in[I_WPR]; K = D; N = D; WT = (bf16_t*)(ws + WS_WPR); kind = 0; break;
        case 6: W = p.in[I_WO]; K = D; N = D; WT = (bf16_t*)(ws + WS_WO); kind = 0; break;
        case 7: W = p.in[I_F2G]; K = D; N = DFF; WT = (bf16_t*)(ws + WS_WGU2); kind = 1; break;
        case 8: W = p.in[I_F2U]; K = D; N = DFF; WT = (bf16_t*)(ws + WS_WGU2); kind = 2; break;
        default: W = p.in[I_F2D]; K = DFF; N = D; WT = (bf16_t*)(ws + WS_WD2); kind = 0; break;
        }
        const int nblk = N / 32, kb = r / nblk, nb = r - kb * nblk, k0 = 64 * kb, n0 = 32 * nb;
        const int drow = kind == 0 ? n0 : (kind == 3 ? map_win(n0) : map_gu(n0, kind == 2));
        transpose_item(W, K, N, WT, k0, n0, drow, scr, lane);
    }
}
__device__ __forceinline__ void tail_tjobs(const Params& p, LAS unsigned char* lds, int nunits, int jlo, int jhi, int skip = 0, int limit = 0x7fffffff) {
    const int G = gridDim.x, rem = nunits % G, c = blockIdx.x;
    if (rem == 0) { run_tjobs(p, lds, jlo, jhi, c * 8 + (threadIdx.x >> 6), G * 8, skip, limit); return; }
    if (c >= rem) run_tjobs(p, lds, jlo, jhi, (c - rem) * 8 + (threadIdx.x >> 6), (G - rem) * 8, skip, limit);
}
__device__ __forceinline__ void phase_prep(const Params& p, LAS unsigned char* lds) {
    const int tid = threadIdx.x, wave = tid >> 6;
    unsigned char* ws = p.ws;
    const int gt = blockIdx.x * 512 + tid, NGT = gridDim.x * 512;
    bf16_t* CS = (bf16_t*)(ws + WS_CS);
    for (int i = gt; i < 256 * D / 4; i += NGT) {
        const int r = i >> 9, k = (i & 511) * 4;
        u32x2 w = {0u, 0u};
        if (r < 130) {
            const float* c = r < 2 ? p.in[I_CP] + (size_t)r * D : p.in[I_CSM] + (size_t)(r - 2) * D;
            const f32x4 v = *(const f32x4*)(c + k);
            w.x = cvt_pk_bf16(silu_f(v[0]), silu_f(v[1])); w.y = cvt_pk_bf16(silu_f(v[2]), silu_f(v[3]));
        }
        *(u32x2*)(CS + (size_t)r * D + k) = w;
    }
    float* rc = (float*)(ws + WS_ROTC); float* rs = (float*)(ws + WS_ROTS);
    for (int i = gt; i < 4104 * 64; i += NGT) {
        const int pi = i >> 6, d = i & 63;
        const float pos = pi < 4096 ? (float)pi : (float)(16384 + (pi - 4096));
        const float inv = (float)exp(-((double)d / 63.0) * 9.210340371976184);
        const float ang = pos * inv;
        double rev = (double)ang * 0.15915494309189535; rev -= rint(rev);
        const float rf = (float)rev;
        rc[i] = __builtin_amdgcn_cosf(rf); rs[i] = __builtin_amdgcn_sinf(rf);
    }
    run_tjobs(p, lds, 0, 2, blockIdx.x * 8 + wave, gridDim.x * 8);
}
__device__ __forceinline__ void phase_ada(const Params& p, LAS unsigned char* lds) {
    const int tid = threadIdx.x, lane = tid & 63, wave = tid >> 6, fr = lane & 15, fq = lane >> 4;
    const int gw = blockIdx.x * 8 + wave, NGW = gridDim.x * 8;
    constexpr int NT = NADA / 16;
    const int nblk_ada = (NT + 7) / 8;
    if ((int)blockIdx.x >= nblk_ada) { run_tjobs(p, lds, 3, 4, (blockIdx.x - nblk_ada) * 8 + wave, ((int)gridDim.x - nblk_ada) * 8, 0, 8832); return; }
    const bf16_t* CS = (const bf16_t*)(p.ws + WS_CS);
    float* MOD = (float*)(p.ws + WS_MOD);
    const float* W = p.in[I_WADA];
    LAS bf16_t* As = (LAS bf16_t*)lds;
    {
        const int t = gw;
        const int n = 16 * (t < NT ? t : NT - 1) + fr;
        f32x4 acc[9];
#pragma unroll
        for (int mt = 0; mt < 9; ++mt) acc[mt] = (f32x4){0.f, 0.f, 0.f, 0.f};
#define ADA_LOAD(wv, g8_) do { const float* wp_ = W + (size_t)(256 * (g8_) + 8 * fq) * NADA + n; \
        _Pragma("unroll") for (int c = 0; c < 8; ++c) _Pragma("unroll") for (int i = 0; i < 8; ++i) wv[c][i] = wp_[(size_t)(32 * c + i) * NADA]; } while (0)
#define ADA_GROUP(wv, g8_) do { \
        u32x4 av_[9]; \
        _Pragma("unroll") for (int tt = 0; tt < 9; ++tt) { const int pc = tid + 512 * tt, r = pc >> 5, c8 = (pc & 31) * 8; av_[tt] = *(const u32x4*)(CS + (size_t)r * D + 256 * (g8_) + c8); } \
        __syncthreads(); \
        _Pragma("unroll") for (int tt = 0; tt < 9; ++tt) { const int pc = tid + 512 * tt, r = pc >> 5, c8 = (pc & 31) * 8; *(LAS u32x4*)(As + r * 264 + c8) = av_[tt]; } \
        __syncthreads(); \
        _Pragma("unroll") for (int c = 0; c < 8; ++c) { \
            union { bf16x8 v; u32x4 q; } bf; \
            bf.q.x = cvt_pk_bf16(wv[c][0], wv[c][1]); bf.q.y = cvt_pk_bf16(wv[c][2], wv[c][3]); bf.q.z = cvt_pk_bf16(wv[c][4], wv[c][5]); bf.q.w = cvt_pk_bf16(wv[c][6], wv[c][7]); \
            const LAS bf16_t* ap = As + fr * 264 + 32 * c + 8 * fq; \
            _Pragma("unroll") for (int mt = 0; mt < 9; ++mt) acc[mt] = mfma16(*(const LAS bf16x8*)(ap + (16 * mt) * 264), bf.v, acc[mt]); } } while (0)
        float wa[8][8], wb[8][8];
        ADA_LOAD(wa, 0);
#pragma unroll 1
        for (int g8 = 0; g8 < 8; g8 += 2) {
            ADA_LOAD(wb, g8 + 1);
            ADA_GROUP(wa, g8);
            if (g8 + 2 < 8) ADA_LOAD(wa, g8 + 2);
            ADA_GROUP(wb, g8 + 1);
        }
#undef ADA_LOAD
#undef ADA_GROUP
        const int sec = n >> 11, i3 = sec / 3, j3 = sec - 3 * i3, cc = n & 2047;
        const float bias = p.in[I_BADA][n];
        float mul = 1.0f, add = bias;
        if (j3 == 1) { mul = p.in[I_NPRE][i3 * D + cc]; add = bias + 1.0f; }
        else if (j3 == 2) mul = p.in[I_NPOST][i3 * D + cc] * (i3 == 1 ? 1.0f : 0.5f);
#pragma unroll
        for (int mt = 0; mt < 9; ++mt)
#pragma unroll
            for (int jj = 0; jj < 4; ++jj) { const int m = 16 * mt + 4 * fq + jj; if (m < 130 && t < NT) MOD[(size_t)m * NADA + n] = (acc[mt][jj] + add) * mul; }
    }
}

template <int KIND>
__device__ __forceinline__ void phase_row(const Params& p) {
    const int tid = threadIdx.x, lane = tid & 63, wave = tid >> 6;
    const int gw = blockIdx.x * 8 + wave, NGW = gridDim.x * 8;
    const float* MOD = (const float*)(p.ws + WS_MOD);
    const bf16_t* P01 = (const bf16_t*)(p.ws + WS_F);
    const bf16_t* P23 = (const bf16_t*)(p.ws + WS_PART23);
    bf16_t* HB = (bf16_t*)(p.ws + WS_HB);
    float* X = p.out;
#pragma unroll 1
    for (int row = gw; row < MT; row += NGW) {
        const int mrow = row < NP ? (row >> 12) : 2 + ((row - NP) >> 3);
        const float* mod = MOD + (size_t)mrow * NADA;
        const float* xin = row < NP ? p.in[I_XP] + (size_t)row * D : p.in[I_XS] + (size_t)(row - NP) * D;
        const float* xs = (KIND <= 1) ? xin : X + (size_t)row * D;
        f32x4 v[8], b1[8], b2[8];
#pragma unroll
        for (int j = 0; j < 8; ++j) v[j] = *(const f32x4*)(xs + 4 * (lane + 64 * j));
        __builtin_amdgcn_sched_barrier(0);
        if (KIND == 0) {
#pragma unroll
            for (int j = 0; j < 8; ++j) { b1[j] = *(const f32x4*)(mod + (KIND * 3 + 1) * D + 4 * (lane + 64 * j)); b2[j] = *(const f32x4*)(mod + (KIND * 3) * D + 4 * (lane + 64 * j)); }
        }
        if (KIND > 0) {
            u32x2 pr[4][8]; f32x4 a1[8];
#pragma unroll
            for (int j = 0; j < 8; ++j) {
                const size_t o = (size_t)row * D + 4 * (lane + 64 * j);
                pr[0][j] = *(const u32x2*)(P01 + o); pr[1][j] = *(const u32x2*)(P01 + (size_t)MT * D + o);
                pr[2][j] = *(const u32x2*)(P23 + o); pr[3][j] = *(const u32x2*)(P23 + (size_t)MT * D + o);
                a1[j] = *(const f32x4*)(mod + ((KIND - 1) * 3 + 2) * D + 4 * (lane + 64 * j));
            }
            __builtin_amdgcn_sched_barrier(0);
            f32x4 f[8]; float ss = 0.f;
#pragma unroll
            for (int j = 0; j < 8; ++j) {
                f[j][0] = (bflo(pr[0][j].x) + bflo(pr[1][j].x)) + (bflo(pr[2][j].x) + bflo(pr[3][j].x));
                f[j][1] = (bfhi(pr[0][j].x) + bfhi(pr[1][j].x)) + (bfhi(pr[2][j].x) + bfhi(pr[3][j].x));
                f[j][2] = (bflo(pr[0][j].y) + bflo(pr[1][j].y)) + (bflo(pr[2][j].y) + bflo(pr[3][j].y));
                f[j][3] = (bfhi(pr[0][j].y) + bfhi(pr[1][j].y)) + (bfhi(pr[2][j].y) + bfhi(pr[3][j].y));
                ss += (f[j][0] * f[j][0] + f[j][1] * f[j][1]) + (f[j][2] * f[j][2] + f[j][3] * f[j][3]);
            }
            __builtin_amdgcn_sched_barrier(0);
            if (KIND < 3) {
#pragma unroll
                for (int j = 0; j < 8; ++j) { b1[j] = *(const f32x4*)(mod + (KIND * 3 + 1) * D + 4 * (lane + 64 * j)); b2[j] = *(const f32x4*)(mod + (KIND * 3) * D + 4 * (lane + 64 * j)); }
            }
            __builtin_amdgcn_sched_barrier(0);
            const float rstd = rsqrtf(wave_sum(ss) * (1.0f / D) + EPS);
#pragma unroll
            for (int j = 0; j < 8; ++j) {
                v[j] = v[j] + (f[j] * rstd) * a1[j];
                *(f32x4*)(X + (size_t)row * D + 4 * (lane + 64 * j)) = v[j];
            }
        }
        __builtin_amdgcn_sched_barrier(0);
        if (KIND < 3) {
            float ss = 0.f;
#pragma unroll
            for (int j = 0; j < 8; ++j) ss += (v[j][0] * v[j][0] + v[j][1] * v[j][1]) + (v[j][2] * v[j][2] + v[j][3] * v[j][3]);
            const float rstd = rsqrtf(wave_sum(ss) * (1.0f / D) + EPS);
#pragma unroll
            for (int j = 0; j < 8; ++j) {
                const f32x4 h = (v[j] * rstd) * b1[j] + b2[j];
                u32x2 w; w.x = cvt_pk_bf16(h[0], h[1]); w.y = cvt_pk_bf16(h[2], h[3]);
                *(u32x2*)(HB + (size_t)row * D + 4 * (lane + 64 * j)) = w;
            }
        }
    }
}

__device__ __forceinline__ void kv_unit(const Params& p, LAS unsigned char* lds, int u) {
    const int tid = threadIdx.x, lane = tid & 63, w = tid >> 6, fr = lane & 15, fq = lane >> 4;
    const int c = u & 31, bh = u >> 5, h = bh & 7, b = bh >> 3;
    const int row0 = b * 4096 + c * 128;
    const bf16_t* PROJ = (const bf16_t*)(p.ws + WS_PROJ);
    const bf16_t* Kg = PROJ + (size_t)row0 * DIN + C_KR + h * 128;
    const bf16_t* Vg = PROJ + (size_t)row0 * DIN + C_VR + h * 256;
    LAS bf16_t* Kt = (LAS bf16_t*)lds;
    LAS bf16_t* Vt = (LAS bf16_t*)(lds + 34816);
    const float l2g = log2_gamma(h);
    {
        const int j = tid & 127, cgp = tid >> 7;
        const float kw = exp2f((float)(127 - j) * l2g);
#pragma unroll
        for (int it = 0; it < 4; ++it) {
            const int ch = cgp + 4 * it;
            const u32x4 v = *(const u32x4*)(Kg + (size_t)j * DIN + ch * 8);
            const unsigned a0 = cvt_pk_bf16(bflo(v.x) * kw, bfhi(v.x) * kw), a1 = cvt_pk_bf16(bflo(v.y) * kw, bfhi(v.y) * kw), a2 = cvt_pk_bf16(bflo(v.z) * kw, bfhi(v.z) * kw), a3 = cvt_pk_bf16(bflo(v.w) * kw, bfhi(v.w) * kw);
            LAS bf16_t* dst = Kt + (ch * 8) * 136 + j;
            dst[0 * 136] = (bf16_t)a0; dst[1 * 136] = (bf16_t)(a0 >> 16); dst[2 * 136] = (bf16_t)a1; dst[3 * 136] = (bf16_t)(a1 >> 16);
            dst[4 * 136] = (bf16_t)a2; dst[5 * 136] = (bf16_t)(a2 >> 16); dst[6 * 136] = (bf16_t)a3; dst[7 * 136] = (bf16_t)(a3 >> 16);
        }
#pragma unroll
        for (int it = 0; it < 8; ++it) {
            const int ch = cgp + 4 * it;
            const u32x4 v = *(const u32x4*)(Vg + (size_t)j * DIN + ch * 8);
            LAS bf16_t* dst = Vt + (ch * 8) * 136 + j;
            dst[0 * 136] = (bf16_t)v.x; dst[1 * 136] = (bf16_t)(v.x >> 16); dst[2 * 136] = (bf16_t)v.y; dst[3 * 136] = (bf16_t)(v.y >> 16);
            dst[4 * 136] = (bf16_t)v.z; dst[5 * 136] = (bf16_t)(v.z >> 16); dst[6 * 136] = (bf16_t)v.w; dst[7 * 136] = (bf16_t)(v.w >> 16);
        }
    }
    __syncthreads();
    {
        bf16_t* VTg = (bf16_t*)(p.ws + WS_VT) + (size_t)u * 32768;
#pragma unroll
        for (int it = 0; it < 8; ++it) { const int piece = tid + 512 * it, e = piece >> 4, jc = piece & 15;
            *(u32x4*)(VTg + e * 128 + jc * 8) = *(const LAS u32x4*)(Vt + e * 136 + jc * 8); }
    }
    f32x4 acc[8][2];
#pragma unroll
    for (int mt = 0; mt < 8; ++mt) { acc[mt][0] = (f32x4){0.f, 0.f, 0.f, 0.f}; acc[mt][1] = (f32x4){0.f, 0.f, 0.f, 0.f}; }
#pragma unroll
    for (int kc = 0; kc < 4; ++kc) {
        const bf16x8 b0 = *(const LAS bf16x8*)(Vt + (32 * w + fr) * 136 + kc * 32 + fq * 8);
        const bf16x8 b1 = *(const LAS bf16x8*)(Vt + (32 * w + 16 + fr) * 136 + kc * 32 + fq * 8);
#pragma unroll
        for (int mt = 0; mt < 8; ++mt) {
            const bf16x8 a = *(const LAS bf16x8*)(Kt + (16 * mt + fr) * 136 + kc * 32 + fq * 8);
            acc[mt][0] = mfma16(a, b0, acc[mt][0]); acc[mt][1] = mfma16(a, b1, acc[mt][1]);
        }
    }
    float* KVT = (float*)(p.ws + WS_F) + (size_t)u * 32768;
#pragma unroll
    for (int nt = 0; nt < 2; ++nt)
#pragma unroll
        for (int mt = 0; mt < 8; ++mt) *(f32x4*)(KVT + (32 * w + 16 * nt + fr) * 128 + 16 * mt + 4 * fq) = acc[mt][nt];
    __syncthreads();
}

__device__ __forceinline__ void attn_unit(const Params& p, LAS unsigned char* lds, int u) {
    const int tid = threadIdx.x, lane = tid & 63, w = tid >> 6, fr = lane & 15, fq = lane >> 4;
    const int kvh = u & 3, qb = (u >> 2) & 31, b = u >> 7;
    const int rowq0 = b * 4096 + qb * 128, rowk0 = rowq0 - 128;
    const bf16_t* PROJ = (const bf16_t*)(p.ws + WS_PROJ);
    bf16_t* OA = (bf16_t*)(p.ws + WS_OA);
    LAS bf16_t* Vt = (LAS bf16_t*)lds;
    {
        const int s = tid & 255, hf = tid >> 8;
        const bool ok = (qb > 0) || (s >= 128);
#pragma unroll
        for (int it = 0; it < 4; ++it) {
            const int ch = hf * 4 + it;
            u32x4 v = {0u, 0u, 0u, 0u};
            if (ok) v = *(const u32x4*)(PROJ + (size_t)(rowk0 + s) * DIN + C_VA + kvh * 64 + ch * 8);
            LAS bf16_t* dst = Vt + (ch * 8) * 296 + s;
            dst[0 * 296] = (bf16_t)v.x; dst[1 * 296] = (bf16_t)(v.x >> 16); dst[2 * 296] = (bf16_t)v.y; dst[3 * 296] = (bf16_t)(v.y >> 16);
            dst[4 * 296] = (bf16_t)v.z; dst[5 * 296] = (bf16_t)(v.z >> 16); dst[6 * 296] = (bf16_t)v.w; dst[7 * 296] = (bf16_t)(v.w >> 16);
        }
        const int d = tid >> 3, k4 = (tid & 7) * 4;
        *(LAS u32x2*)(Vt + d * 296 + 256 + k4) = (u32x2){0u, 0u};
    }
    __syncthreads();
    const int g = w >> 1, hh = kvh * 4 + g;
    const float slope = exp2f(-0.5f * (float)(hh + 1));
    const float sink = p.in[I_SINK][hh];
#pragma unroll 1
    for (int qt = 0; qt < 4; ++qt) {
        const int a0 = (w & 1) * 64 + 16 * qt, a = a0 + fr, kt0 = a0 >> 4;
        const bf16_t* qp = PROJ + (size_t)(rowq0 + a) * DIN + C_QA + hh * 64 + fq * 8;
        const bf16x8 q0 = *(const bf16x8*)qp, q1 = *(const bf16x8*)(qp + 32);
        f32x4 s[10];
#pragma unroll
        for (int kt = 0; kt < 10; ++kt) {
            const int sidx = 16 * (kt0 + kt) + fr;
            int krow = rowk0 + sidx;
            if (sidx > 255) krow = rowq0;
            if (krow < 0) krow = 0;
            const bf16_t* kp = PROJ + (size_t)krow * DIN + C_KA + kvh * 64 + fq * 8;
            const bf16x8 k0 = *(const bf16x8*)kp, k1 = *(const bf16x8*)(kp + 32);
            f32x4 z = {0.f, 0.f, 0.f, 0.f};
            z = mfma16(k0, q0, z); s[kt] = mfma16(k1, q1, z);
        }
        float m = sink;
#pragma unroll
        for (int kt = 0; kt < 10; ++kt)
#pragma unroll
            for (int jj = 0; jj < 4; ++jj) {
                const int sidx = 16 * (kt0 + kt) + 4 * fq + jj, dist = 128 + a - sidx;
                const bool valid = dist >= 0 && dist <= 128 && (qb > 0 || sidx >= 128);
                const float sc = valid ? s[kt][jj] * 0.125f - slope * (float)dist : -INFINITY;
                s[kt][jj] = sc; m = fmaxf(m, sc);
            }
        m = fmaxf(m, __shfl_xor(m, 16)); m = fmaxf(m, __shfl_xor(m, 32));
        float l = 0.f;
#pragma unroll
        for (int kt = 0; kt < 10; ++kt)
#pragma unroll
            for (int jj = 0; jj < 4; ++jj) { const float e = __expf(s[kt][jj] - m); s[kt][jj] = e; l += e; }
        l += __shfl_xor(l, 16); l += __shfl_xor(l, 32);
        l += __expf(sink - m);
        f32x4 o[4];
#pragma unroll
        for (int dt = 0; dt < 4; ++dt) o[dt] = (f32x4){0.f, 0.f, 0.f, 0.f};
#pragma unroll
        for (int cc = 0; cc < 5; ++cc) {
            union { bf16x8 v; u32x4 w; } pf;
            pf.w.x = cvt_pk_bf16(s[2 * cc][0], s[2 * cc][1]); pf.w.y = cvt_pk_bf16(s[2 * cc][2], s[2 * cc][3]);
            pf.w.z = cvt_pk_bf16(s[2 * cc + 1][0], s[2 * cc + 1][1]); pf.w.w = cvt_pk_bf16(s[2 * cc + 1][2], s[2 * cc + 1][3]);
#pragma unroll
            for (int dt = 0; dt < 4; ++dt) {
                const LAS bf16_t* vp = Vt + (16 * dt + fr) * 296 + 16 * (kt0 + 2 * cc) + 4 * fq;
                union { bf16x8 v; u32x2 h[2]; } af;
                af.h[0] = *(const LAS u32x2*)vp; af.h[1] = *(const LAS u32x2*)(vp + 16);
                o[dt] = mfma16(af.v, pf.v, o[dt]);
            }
        }
        const float inv = 1.0f / l;
        bf16_t* op = OA + (size_t)(rowq0 + a) * 1024 + hh * 64 + 4 * fq;
#pragma unroll
        for (int dt = 0; dt < 4; ++dt) { u32x2 wv; wv.x = cvt_pk_bf16(o[dt][0] * inv, o[dt][1] * inv); wv.y = cvt_pk_bf16(o[dt][2] * inv, o[dt][3] * inv); *(u32x2*)(op + 16 * dt) = wv; }
    }
    __syncthreads();
}

__device__ __forceinline__ void sattn_unit(const Params& p, LAS unsigned char* lds, int u) {
    const int tid = threadIdx.x, lane = tid & 63, w = tid >> 6;
    const int kvh = u & 3, n = u >> 2;
    const bf16_t* PROJ = (const bf16_t*)(p.ws + WS_PROJ);
    bf16_t* OA = (bf16_t*)(p.ws + WS_OA);
    LAS float* Ks = (LAS float*)lds;
    LAS float* Vs = Ks + 136 * 65;
    LAS float* Qs = Vs + 136 * 64;
    LAS float* Ps = Qs + 2048;
    const float* ck = p.in[I_CK]; const float* cv = p.in[I_CV];
    {
        f32x4 kq[4], vq[4];
#pragma unroll
        for (int t = 0; t < 4; ++t) { const int pc = tid + 512 * t, sr = pc >> 4, d4 = (pc & 15) * 4; const size_t o = ((size_t)(n * 128 + sr)) * 256 + kvh * 64 + d4;
            kq[t] = *(const f32x4*)(ck + o); vq[t] = *(const f32x4*)(cv + o); }
        const bf16_t* rn = PROJ + (size_t)(NP + n * 8 + (tid >> 6)) * DIN + kvh * 64 + (tid & 63);
        const bf16_t kn = rn[C_KA], vn = rn[C_VA];
        const int qr_ = tid >> 4, qd4 = (tid & 15) * 4, qg = qr_ >> 3, qa = qr_ & 7;
        const u32x2 qv = *(const u32x2*)(PROJ + (size_t)(NP + n * 8 + qa) * DIN + C_QA + (kvh * 4 + qg) * 64 + qd4);
#pragma unroll
        for (int t = 0; t < 4; ++t) { const int pc = tid + 512 * t, sr = pc >> 4, d4 = (pc & 15) * 4;
            Ks[sr * 65 + d4] = kq[t][0]; Ks[sr * 65 + d4 + 1] = kq[t][1]; Ks[sr * 65 + d4 + 2] = kq[t][2]; Ks[sr * 65 + d4 + 3] = kq[t][3];
            *(LAS f32x4*)(Vs + sr * 64 + d4) = vq[t]; }
        Ks[(128 + (tid >> 6)) * 65 + (tid & 63)] = bf2f(kn); Vs[(128 + (tid >> 6)) * 64 + (tid & 63)] = bf2f(vn);
        *(LAS f32x4*)(Qs + qr_ * 64 + qd4) = (f32x4){bflo(qv.x), bfhi(qv.x), bflo(qv.y), bfhi(qv.y)};
    }
    __syncthreads();
    float linv[4];
#pragma unroll
    for (int rr = 0; rr < 4; ++rr) {
        const int r = 4 * w + rr, g = r >> 3, a = r & 7, hh = kvh * 4 + g;
        const float slope = exp2f(-0.5f * (float)(hh + 1)), sink = p.in[I_SINK][hh];
        float sc[3]; float m = sink;
#pragma unroll
        for (int t = 0; t < 3; ++t) {
            const int s = lane + 64 * t; sc[t] = -INFINITY;
            if (s < 136) {
                float dot = 0.f;
                for (int d = 0; d < 64; ++d) dot += Qs[r * 64 + d] * Ks[s * 65 + d];
                const int dist = 128 + a - s;
                if (dist >= 0 && dist <= 128) sc[t] = dot * 0.125f - slope * (float)dist;
            }
            m = fmaxf(m, sc[t]);
        }
        m = wave_max(m);
        float l = 0.f;
#pragma unroll
        for (int t = 0; t < 3; ++t) { const int s = lane + 64 * t; const float e = __expf(sc[t] - m); if (s < 136) { Ps[r * 136 + s] = e; l += e; } }
        l = wave_sum(l) + __expf(sink - m);
        linv[rr] = 1.0f / l;
    }
    __syncthreads();
#pragma unroll
    for (int rr = 0; rr < 4; ++rr) {
        const int r = 4 * w + rr, g = r >> 3, a = r & 7, hh = kvh * 4 + g;
        float o = 0.f;
        for (int s = 0; s < 136; ++s) o += Ps[r * 136 + s] * Vs[s * 64 + lane];
        OA[(size_t)(NP + n * 8 + a) * 1024 + hh * 64 + lane] = (bf16_t)(cvt_pk_bf16(o * linv[rr], 0.f) & 0xffffu);
    }
    __syncthreads();
}

__device__ __forceinline__ void sret_unit(const Params& p, LAS unsigned char* lds, int u) {
    const int tid = threadIdx.x, lane = tid & 63, w = tid >> 6;
    const int h = u & 7, n = u >> 3;
    const bf16_t* PROJ = (const bf16_t*)(p.ws + WS_PROJ);
    bf16_t* ORb = (bf16_t*)(p.ws + WS_OR);
    LAS float* qT = (LAS float*)lds;
    LAS float* kT = qT + 1024;
    LAS float* vS = kT + 1024;
    LAS float* SCP = vS + 2048;
    LAS float* PART = SCP + 512;
    const float l2g = log2_gamma(h);
    const float g8 = exp2f(8.0f * l2g), gm8 = exp2f(-8.0f * l2g);
    const size_t rbase = (size_t)(NP + n * 8);
    const int e4 = lane * 4;
    const float* S0 = p.in[I_ST] + ((size_t)(n * 8 + h) * 128) * 256 + e4;
    float* S1 = p.out + O_SRS + ((size_t)(n * 8 + h) * 128) * 256 + e4;
    f32x4 S[16];
#pragma unroll
    for (int it = 0; it < 16; ++it) S[it] = *(const f32x4*)(S0 + (size_t)(w + 8 * it) * 256);
    {
        bf16_t qv[2], kv[2];
#pragma unroll
        for (int t = 0; t < 2; ++t) { const int idx = tid + 512 * t, i = idx >> 7, d = idx & 127; const bf16_t* r = PROJ + (rbase + i) * DIN + h * 128 + d; qv[t] = r[C_QR]; kv[t] = r[C_KR]; }
        const u32x2 v2 = *(const u32x2*)(PROJ + (rbase + w) * DIN + C_VR + h * 256 + e4);
#pragma unroll
        for (int t = 0; t < 2; ++t) { const int idx = tid + 512 * t, i = idx >> 7, d = idx & 127;
            qT[d * 8 + i] = bf2f(qv[t]) * exp2f((float)(i + 1) * l2g); kT[d * 8 + i] = bf2f(kv[t]) * exp2f((float)(7 - i) * l2g); }
        *(LAS f32x4*)(vS + w * 256 + e4) = (f32x4){bflo(v2.x), bfhi(v2.x), bflo(v2.y), bfhi(v2.y)};
    }
    __syncthreads();
    {
        const int i = lane >> 3, j = lane & 7; float sc = 0.f;
#pragma unroll
        for (int dd = 0; dd < 16; ++dd) { const int d = 16 * w + dd; sc += qT[d * 8 + i] * kT[d * 8 + j]; }
        SCP[w * 64 + lane] = sc;
    }
    f32x4 vv[8], ya[8];
#pragma unroll
    for (int j = 0; j < 8; ++j) { vv[j] = *(const LAS f32x4*)(vS + j * 256 + e4); ya[j] = (f32x4){0.f, 0.f, 0.f, 0.f}; }
#pragma unroll
    for (int it = 0; it < 16; ++it) {
        const int d = w + 8 * it;
        const f32x4 qa = *(const LAS f32x4*)(qT + d * 8), qb = *(const LAS f32x4*)(qT + d * 8 + 4);
        const f32x4 ka = *(const LAS f32x4*)(kT + d * 8), kb = *(const LAS f32x4*)(kT + d * 8 + 4);
        f32x4 sn = S[it] * g8;
        sn += vv[0] * ka[0]; sn += vv[1] * ka[1]; sn += vv[2] * ka[2]; sn += vv[3] * ka[3];
        sn += vv[4] * kb[0]; sn += vv[5] * kb[1]; sn += vv[6] * kb[2]; sn += vv[7] * kb[3];
        *(f32x4*)(S1 + (size_t)d * 256) = sn;
        ya[0] += S[it] * qa[0]; ya[1] += S[it] * qa[1]; ya[2] += S[it] * qa[2]; ya[3] += S[it] * qa[3];
        ya[4] += S[it] * qb[0]; ya[5] += S[it] * qb[1]; ya[6] += S[it] * qb[2]; ya[7] += S[it] * qb[3];
    }
#pragma unroll
    for (int i = 0; i < 8; ++i) *(LAS f32x4*)(PART + (w * 8 + i) * 256 + e4) = ya[i];
    __syncthreads();
    {
        const int i = w;
        f32x4 y = {0.f, 0.f, 0.f, 0.f};
#pragma unroll
        for (int ww = 0; ww < 8; ++ww) y += *(const LAS f32x4*)(PART + (ww * 8 + i) * 256 + e4);
#pragma unroll
        for (int j = 0; j < 8; ++j) {
            float sc = 0.f;
#pragma unroll
            for (int ww = 0; ww < 8; ++ww) sc += SCP[ww * 64 + i * 8 + j];
            if (j <= i) y += vv[j] * (sc * gm8);
        }
        const float ss = wave_sum((y[0] * y[0] + y[1] * y[1]) + (y[2] * y[2] + y[3] * y[3]));
        const float rstd = rsqrtf(ss * (1.0f / 256.0f) + EPS);
        const u32x2 gv = *(const u32x2*)(PROJ + (rbase + i) * DIN + C_GR + h * 256 + e4);
        u32x2 wv; wv.x = cvt_pk_bf16(y[0] * rstd * bflo(gv.x), y[1] * rstd * bfhi(gv.x)); wv.y = cvt_pk_bf16(y[2] * rstd * bflo(gv.y), y[3] * rstd * bfhi(gv.y));
        *(u32x2*)(ORb + (rbase + i) * D + h * 256 + e4) = wv;
    }
    __syncthreads();
}

__device__ __forceinline__ void phase_mix1(const Params& p, LAS unsigned char* lds) {
    const int G = gridDim.x;
    for (int u = blockIdx.x; u < 512; u += G) kv_unit(p, lds, u);
    for (int u = blockIdx.x; u < 256; u += G) attn_unit(p, lds, u);
    for (int u = blockIdx.x; u < 512; u += G) sattn_unit(p, lds, u);
    for (int u = blockIdx.x; u < 1024; u += G) sret_unit(p, lds, u);
    const bf16_t* PROJ = (const bf16_t*)(p.ws + WS_PROJ);
    const int gt = blockIdx.x * 512 + threadIdx.x, NGT = G * 512;
    for (int i = gt; i < 2 * 65536 / 4; i += NGT) {
        const int which = i >> 14, r = i & 16383, bw = r >> 6, c4 = (r & 63) * 4, b = bw >> 7, wdx = bw & 127;
        const u32x2 v = *(const u32x2*)(PROJ + (size_t)(b * 4096 + 3968 + wdx) * DIN + (which ? C_VA : C_KA) + c4);
        *(f32x4*)(p.out + (which ? O_VWP : O_KWP) + (size_t)bw * 256 + c4) = (f32x4){bflo(v.x), bfhi(v.x), bflo(v.y), bfhi(v.y)};
    }
    for (int i0 = gt; i0 < 2 * 4194304 / 4; i0 += 4 * NGT) {
        f32x4 o[4];
#pragma unroll
        for (int t = 0; t < 4; ++t) {
            const int i = i0 + t * NGT;
            if (i < 2 * 4194304 / 4) {
                const int which = i >> 20, r = i & 1048575, nw = r >> 6, c4 = (r & 63) * 4, n = nw >> 7, wdx = nw & 127;
                if (wdx < 120) o[t] = *(const f32x4*)((which ? p.in[I_CV] : p.in[I_CK]) + ((size_t)(n * 128 + wdx + 8)) * 256 + c4);
                else { const u32x2 v = *(const u32x2*)(PROJ + (size_t)(NP + n * 8 + (wdx - 120)) * DIN + (which ? C_VA : C_KA) + c4); o[t] = (f32x4){bflo(v.x), bfhi(v.x), bflo(v.y), bfhi(v.y)}; }
            }
        }
#pragma unroll
        for (int t = 0; t < 4; ++t) {
            const int i = i0 + t * NGT;
            if (i < 2 * 4194304 / 4) { const int which = i >> 20, r = i & 1048575, nw = r >> 6, c4 = (r & 63) * 4; *(f32x4*)(p.out + (which ? O_VWS : O_KWS) + (size_t)nw * 256 + c4) = o[t]; }
        }
    }
}

__device__ __forceinline__ void phase_scan(const Params& p) {
    const float* KVT = (const float*)(p.ws + WS_F);
    bf16_t* SPT = (bf16_t*)(p.ws + WS_SPT);
    const int gt = blockIdx.x * 512 + threadIdx.x, NGT = gridDim.x * 512;
    for (int it = gt; it < 16 * 8192; it += NGT) {
        const int bh = it >> 13, rem = it & 8191, e = rem >> 5, d4 = (rem & 31) * 4, h = bh & 7;
        const float g128 = exp2f(128.0f * log2_gamma(h));
        f32x4 S = {0.f, 0.f, 0.f, 0.f};
        const size_t off = (size_t)e * 128 + d4;
        f32x4 kvr[32];
#pragma unroll
        for (int c = 0; c < 32; ++c) kvr[c] = *(const f32x4*)(KVT + (size_t)(bh * 32 + c) * 32768 + off);
#pragma unroll
        for (int c = 0; c < 32; ++c) {
            const size_t uo = (size_t)(bh * 32 + c) * 32768 + off;
            u32x2 wv; wv.x = cvt_pk_bf16(S[0], S[1]); wv.y = cvt_pk_bf16(S[2], S[3]);
            *(u32x2*)(SPT + uo) = wv;
            S = S * g128 + kvr[c];
        }
        float* so = p.out + O_SRP + (size_t)bh * 32768 + e;
        so[(size_t)(d4 + 0) * 256] = S[0]; so[(size_t)(d4 + 1) * 256] = S[1]; so[(size_t)(d4 + 2) * 256] = S[2]; so[(size_t)(d4 + 3) * 256] = S[3];
    }
}

__device__ __forceinline__ void phase_ret3(const Params& p) {
    const int tid = threadIdx.x, lane = tid & 63, w = tid >> 6, fr = lane & 15, fq = lane >> 4;
    const bf16_t* PROJ = (const bf16_t*)(p.ws + WS_PROJ);
    bf16_t* ORb = (bf16_t*)(p.ws + WS_OR);
    for (int u = blockIdx.x; u < 512; u += gridDim.x) {
        const int c = u & 31, bh = u >> 5, h = bh & 7, b = bh >> 3;
        const int row0 = b * 4096 + c * 128, i0 = 16 * w, irow = row0 + i0 + fr;
        const float l2g = log2_gamma(h);
        const bf16_t* SPTu = (const bf16_t*)(p.ws + WS_SPT) + (size_t)u * 32768;
        const bf16_t* VTu = (const bf16_t*)(p.ws + WS_VT) + (size_t)u * 32768;
        bf16x8 Qf[4];
        { const bf16_t* qp = PROJ + (size_t)irow * DIN + C_QR + h * 128 + fq * 8;
#pragma unroll
          for (int kc = 0; kc < 4; ++kc) Qf[kc] = *(const bf16x8*)(qp + kc * 32); }
        f32x4 sa[8];
#pragma unroll
        for (int jt = 0; jt < 8; ++jt) {
            sa[jt] = (f32x4){0.f, 0.f, 0.f, 0.f};
            if (jt <= w) {
                const bf16_t* kp = PROJ + (size_t)(row0 + 16 * jt + fr) * DIN + C_KR + h * 128 + fq * 8;
#pragma unroll
                for (int kc = 0; kc < 4; ++kc) sa[jt] = mfma16(*(const bf16x8*)(kp + kc * 32), Qf[kc], sa[jt]);
            }
        }
        const int ii = i0 + fr;
#pragma unroll
        for (int jt = 0; jt < 8; ++jt)
#pragma unroll
            for (int jj = 0; jj < 4; ++jj) { const int dj = ii - (16 * jt + 4 * fq + jj); sa[jt][jj] = dj >= 0 ? sa[jt][jj] * exp2f((float)dj * l2g) : 0.f; }
        union { bf16x8 v; u32x4 q; } Pf[4];
#pragma unroll
        for (int cc = 0; cc < 4; ++cc) {
            Pf[cc].q.x = cvt_pk_bf16(sa[2 * cc][0], sa[2 * cc][1]); Pf[cc].q.y = cvt_pk_bf16(sa[2 * cc][2], sa[2 * cc][3]);
            Pf[cc].q.z = cvt_pk_bf16(sa[2 * cc + 1][0], sa[2 * cc + 1][1]); Pf[cc].q.w = cvt_pk_bf16(sa[2 * cc + 1][2], sa[2 * cc + 1][3]);
        }
        const float qw = exp2f((float)(ii + 1) * l2g);
        f32x4 y[16];
#pragma unroll
        for (int et = 0; et < 16; ++et) {
            f32x4 a = {0.f, 0.f, 0.f, 0.f};
            const bf16_t* sp = SPTu + (16 * et + fr) * 128 + fq * 8;
#pragma unroll
            for (int kc = 0; kc < 4; ++kc) a = mfma16(*(const bf16x8*)(sp + kc * 32), Qf[kc], a);
            a = a * qw;
            const bf16_t* vp = VTu + (16 * et + fr) * 128 + 4 * fq;
#pragma unroll
            for (int cc = 0; cc < 4; ++cc) {
                if (2 * cc <= w) {
                    union { bf16x8 v; u32x2 hh[2]; } af;
                    af.hh[0] = *(const u32x2*)(vp + 32 * cc); af.hh[1] = *(const u32x2*)(vp + 32 * cc + 16);
                    a = mfma16(af.v, Pf[cc].v, a);
                }
            }
            y[et] = a;
        }
        float ss = 0.f;
#pragma unroll
        for (int et = 0; et < 16; ++et) ss += (y[et][0] * y[et][0] + y[et][1] * y[et][1]) + (y[et][2] * y[et][2] + y[et][3] * y[et][3]);
        ss += __shfl_xor(ss, 16); ss += __shfl_xor(ss, 32);
        const float rstd = rsqrtf(ss * (1.0f / 256.0f) + EPS);
        const bf16_t* gp = PROJ + (size_t)irow * DIN + C_GR + h * 256 + 4 * fq;
        bf16_t* op = ORb + (size_t)irow * D + h * 256 + 4 * fq;
        u32x2 gvr[16];
#pragma unroll
        for (int et = 0; et < 16; ++et) gvr[et] = *(const u32x2*)(gp + 16 * et);
#pragma unroll
        for (int et = 0; et < 16; ++et) {
            const u32x2 gv = gvr[et];
            u32x2 wv; wv.x = cvt_pk_bf16(y[et][0] * rstd * bflo(gv.x), y[et][1] * rstd * bfhi(gv.x)); wv.y = cvt_pk_bf16(y[et][2] * rstd * bflo(gv.y), y[et][3] * rstd * bfhi(gv.y));
            *(u32x2*)(op + 16 * et) = wv;
        }
    }
}

#define XB_TMO      128
#define XB_XCNT(j)  (256  + 64 * (j))
#define XB_XSUB(j)  (1280 + 64 * (j))
#define XB_XGEN(j)  (2304 + 64 * (j))
#define XB_TOP      3328
#define XB_TOPGEN   3392
#define XCD_BAR_WORDS 3456
#define XB_SPIN_CAP (1u << 18)

__device__ __forceinline__ unsigned xb_ld(unsigned* p)              { return __hip_atomic_load(p, __ATOMIC_RELAXED, __HIP_MEMORY_SCOPE_AGENT); }
__device__ __forceinline__ unsigned xb_add(unsigned* p, unsigned v) { return __hip_atomic_fetch_add(p, v, __ATOMIC_RELAXED, __HIP_MEMORY_SCOPE_AGENT); }
__device__ __forceinline__ unsigned xb_xcc_id() { return (unsigned)__builtin_amdgcn_s_getreg((3 << 11) | 20) & 0xFu; }
#define XB_SPIN(cond, bar) do { unsigned _sp = 0; while (cond) { __builtin_amdgcn_s_sleep(1); \
    if ((++_sp & 255u) == 0u) { if (xb_ld(&(bar)[XB_TMO])) break; if (_sp > XB_SPIN_CAP) { atomicAdd(&(bar)[XB_TMO], 1u); break; } } } } while (0)

struct XcdBarrier {
    unsigned* bar; unsigned x;
    volatile LAS unsigned* st;
};

__device__ __forceinline__ XcdBarrier xcd_barrier_post(unsigned* bar, volatile LAS unsigned* st) {
    XcdBarrier b; b.bar = bar; b.x = xb_xcc_id(); b.st = st;
    if (threadIdx.x == 0) (void)xb_add(&bar[XB_XCNT(b.x)], 1u);
    return b;
}
__device__ __forceinline__ void xcd_barrier_complete(unsigned* bar, unsigned x, unsigned& nloc, unsigned& nx) {
    const unsigned G = gridDim.x * gridDim.y * gridDim.z;
    unsigned sum, cnt, mine, sp = 0u;
    for (;;) {
        sum = 0u; cnt = 0u; mine = 0u;
#pragma unroll
        for (unsigned j = 0; j < 16; ++j) { const unsigned c = xb_ld(&bar[XB_XCNT(j)]); sum += c; cnt += (c > 0u) ? 1u : 0u; mine = (j == x) ? c : mine; }
        if (sum == G) break;
        __builtin_amdgcn_s_sleep(1);
        if ((++sp & 255u) == 0u) { if (xb_ld(&bar[XB_TMO])) break; if (sp > XB_SPIN_CAP) { atomicAdd(&bar[XB_TMO], 1u); break; } }
    }
    nloc = mine > 0u ? mine : 1u; nx = cnt > 0u ? cnt : 1u;
}

__device__ __forceinline__ void xcd_barrier(const XcdBarrier& b) {
    asm volatile("s_waitcnt vmcnt(0)" ::: "memory");
    __syncthreads();
    if (threadIdx.x == 0) {
        unsigned* bar = b.bar;
        __builtin_amdgcn_s_waitcnt(0);
        unsigned nloc = b.st[0], nx = b.st[1];
        if (nloc == 0u) { xcd_barrier_complete(bar, b.x, nloc, nx); b.st[0] = nloc; b.st[1] = nx; }
        const unsigned old = xb_add(&bar[XB_XSUB(b.x)], 1u);
        const unsigned gen = old / nloc;
        if (old + 1u == (gen + 1u) * nloc) {
            __builtin_amdgcn_fence(__ATOMIC_RELEASE, "agent");
            asm volatile("s_waitcnt vmcnt(0)" ::: "memory");
            const unsigned og = xb_add(&bar[XB_TOP], 1u);
            const unsigned tg = og / nx;
            if (og + 1u == (tg + 1u) * nx) xb_add(&bar[XB_TOPGEN], 1u);
            else XB_SPIN(xb_ld(&bar[XB_TOPGEN]) == tg, bar);
            __builtin_amdgcn_fence(__ATOMIC_ACQUIRE, "agent");
            xb_add(&bar[XB_XGEN(b.x)], 1u);
            asm volatile("s_waitcnt vmcnt(0)" ::: "memory");
        } else {
            XB_SPIN(xb_ld(&bar[XB_XGEN(b.x)]) == gen, bar);
            __builtin_amdgcn_fence(__ATOMIC_ACQUIRE, "agent");
            asm volatile("s_waitcnt vmcnt(0)" ::: "memory");
        }
    }
    __syncthreads();
}


__device__ __forceinline__ void gemm_part(const Params& p, LAS unsigned char* lds, int which) {
    unsigned char* ws = p.ws;
    EpiPart E; E.P01 = (bf16_t*)(ws + WS_F); E.P23 = (bf16_t*)(ws + WS_PART23);
    const bf16_t* A; const bf16_t* Bt; int K;
    if (which == 1) { A = (const bf16_t*)(ws + WS_PROJ); Bt = (const bf16_t*)(ws + WS_WD1); K = DFF; }
    else if (which == 2) { A = (const bf16_t*)(ws + WS_HB); Bt = (const bf16_t*)(ws + WS_WO); K = D; }
    else { A = (const bf16_t*)(ws + WS_PROJ); Bt = (const bf16_t*)(ws + WS_WD2); K = DFF; }
    run_gemm(lds, A, Bt, MT, D, K, E, 4);
}
__device__ __forceinline__ void gemm_gu(const Params& p, LAS unsigned char* lds, int which) {
    unsigned char* ws = p.ws;
    EpiSwiGLU E; E.O = (bf16_t*)(ws + WS_PROJ);
    run_gemm(lds, (const bf16_t*)(ws + WS_HB), (const bf16_t*)(ws + (which == 0 ? WS_WGU1 : WS_WGU2)), MT, 2 * DFF, D, E);
}
__device__ __forceinline__ void gemm_win(const Params& p, LAS unsigned char* lds) {
    unsigned char* ws = p.ws;
    EpiWin E; E.O = (bf16_t*)(ws + WS_PROJ); E.rc = (const float*)(ws + WS_ROTC); E.rs = (const float*)(ws + WS_ROTS);
    run_gemm(lds, (const bf16_t*)(ws + WS_HB), (const bf16_t*)(ws + WS_WIN), MT, DIN, D, E);
}
__device__ __forceinline__ void gemm_papr(const Params& p, LAS unsigned char* lds) {
    unsigned char* ws = p.ws;
    EpiPa E1; E1.T = (float*)(ws + WS_F); E1.P = (const bf16_t*)(ws + WS_PROJ);
    run_gemm(lds, (const bf16_t*)(ws + WS_OA), (const bf16_t*)(ws + WS_WPA), MT, D, 1024, E1);
    EpiPr E2; E2.T = (const float*)(ws + WS_F); E2.P = (const bf16_t*)(ws + WS_PROJ); E2.O = (bf16_t*)(ws + WS_HB);
    run_gemm(lds, (const bf16_t*)(ws + WS_OR), (const bf16_t*)(ws + WS_WPR), MT, D, D, E2);
}

#ifndef XSYNC
#define XSYNC 0
#endif
#ifndef DUPMASK
#define DUPMASK 0
#endif
#ifndef PHMASK
#define PHMASK 0xFFFF
#endif
#define PHASE(k, body) if (((PHMASK >> (k)) & 1) && p.ph_lo <= (k) && (k) < p.ph_hi) { if ((k) > p.ph_lo) { xcd_barrier(xb); for (int _x = 0; _x < XSYNC; ++_x) xcd_barrier(xb); } body; if ((DUPMASK >> (k)) & 1) { xcd_barrier(xb); body; } }
__global__ __launch_bounds__(512, 2) void mega(Params p) {
    extern __shared__ __attribute__((aligned(16))) unsigned char shm[];
    LAS unsigned char* lds = (LAS unsigned char*)shm;
    cg::grid_group grid = cg::this_grid();
    if (p.ph_lo < 0) grid.sync();
    volatile LAS unsigned* xst = (volatile LAS unsigned*)(lds + LDS_BYTES - 16);
    if (threadIdx.x == 0) { xst[0] = 0u; xst[1] = 0u; }
    __syncthreads();
    const XcdBarrier xb = xcd_barrier_post((unsigned*)p.ws, xst);
    PHASE(PH_PREP, phase_prep(p, lds))
    PHASE(PH_ADA, phase_ada(p, lds))
    PHASE(PH_ROW0, phase_row<0>(p))
    PHASE(PH_GU1, (gemm_gu(p, lds, 0), tail_tjobs(p, lds, 36 * 44, 2, 3), tail_tjobs(p, lds, 36 * 44, 7, 8)))
    PHASE(PH_D1, (gemm_part(p, lds, 1), tail_tjobs(p, lds, 36 * 8 * 4, 4, 7), tail_tjobs(p, lds, 36 * 8 * 4, 3, 4, 8832)))
    PHASE(PH_ROW1, phase_row<1>(p))
    PHASE(PH_WIN, (gemm_win(p, lds), tail_tjobs(p, lds, 36 * 46, 8, 9)))
    PHASE(PH_MIX1, phase_mix1(p, lds))
    PHASE(PH_SCAN, phase_scan(p))
    PHASE(PH_RET3, phase_ret3(p))
    PHASE(PH_PAPR, (gemm_papr(p, lds), tail_tjobs(p, lds, 36 * 8, 9, 10)))
    PHASE(PH_WO, gemm_part(p, lds, 2))
    PHASE(PH_ROW2, phase_row<2>(p))
    PHASE(PH_GU2, gemm_gu(p, lds, 1))
    PHASE(PH_D2, gemm_part(p, lds, 3))
    PHASE(PH_ROW3, phase_row<3>(p))
}

extern "C" void kernel_launch(void* const* d_in, const int* in_sizes, int n_in, void* d_out, int out_size, void* d_ws, size_t ws_size, hipStream_t stream) {
    static int grid = 0;
    if (grid == 0) {
        if (n_in != 22 || ws_size < WS_END) { fprintf(stderr, "kernel_launch: need 22 inputs and %zu bytes of workspace (got %d, %zu)\n", (size_t)WS_END, n_in, ws_size); grid = -1; return; }
        int dev = 0, cus = 0, per_cu = 0;
        (void)hipGetDevice(&dev);
        (void)hipDeviceGetAttribute(&cus, hipDeviceAttributeMultiprocessorCount, dev);
        if (hipFuncSetAttribute((const void*)mega, hipFuncAttributeMaxDynamicSharedMemorySize, LDS_BYTES) != hipSuccess) { fprintf(stderr, "kernel_launch: hipFuncSetAttribute failed\n"); grid = -1; return; }
        if (hipOccupancyMaxActiveBlocksPerMultiprocessor(&per_cu, (const void*)mega, 512, LDS_BYTES) != hipSuccess || per_cu < 1) { fprintf(stderr, "kernel_launch: occupancy query says %d\n", per_cu); per_cu = 1; }
        (void)hipGetLastError();
        grid = cus;
        if (grid <= 0) grid = 256;
    }
    if (grid < 0) return;
    if (hipMemsetAsync(d_ws, 0, XCD_BAR_WORDS * sizeof(unsigned), stream) != hipSuccess) { fprintf(stderr, "kernel_launch: memset of the barrier words failed\n"); return; }
    Params p{};
    for (int i = 0; i < 22; ++i) p.in[i] = (const float*)d_in[i];
    p.out = (float*)d_out; p.ws = (unsigned char*)d_ws;
#if MK_SPLIT
    for (int ph = 0; ph < NPH; ++ph) {
        p.ph_lo = ph; p.ph_hi = ph + 1;
        void* args[] = {&p};
        hipError_t e = hipLaunchCooperativeKernel((const void*)mega, dim3(grid), dim3(512), args, LDS_BYTES, stream);
        if (e != hipSuccess) { fprintf(stderr, "cooperative launch failed: %s (grid %d)\n", hipGetErrorString(e), grid); break; }
    }
#else
    p.ph_lo = 0; p.ph_hi = NPH;
    void* args[] = {&p};
    hipError_t e = hipLaunchCooperativeKernel((const void*)mega, dim3(grid), dim3(512), args, LDS_BYTES, stream);
    if (e != hipSuccess) fprintf(stderr, "cooperative launch failed: %s (grid %d)\n", hipGetErrorString(e), grid);
#endif
}
```

```cpp
#include <hip/hip_runtime.h>
#include <hip/hip_cooperative_groups.h>
#include <cstdio>
#include <cstdint>
namespace cg = cooperative_groups;

#ifndef MK_SPLIT
#define MK_SPLIT 0
#endif

namespace pg8 {
#define PG8_LAS __attribute__((address_space(3)))
typedef unsigned short bf16_t;
typedef short bf16x8 __attribute__((ext_vector_type(8)));
typedef float f32x4 __attribute__((ext_vector_type(4)));
typedef unsigned u32x4 __attribute__((ext_vector_type(4)));
typedef unsigned u32x2 __attribute__((ext_vector_type(2)));
constexpr int BM = 256, BK = 64, HALF = 128, HTB = HALF * BK * 2  , STAGE_BYTES = 8 * HTB, NXCD = 8, WGM = 8;

__host__ __device__ __forceinline__ int lds_byte(int r, int c) { const int st = (r >> 4) * 2 + (c >> 5), rr = r & 15, cc = c & 31, ob = rr * 64 + cc * 2; return st * 1024 + (ob ^ (((ob >> 9) & 1) << 5)); }
__host__ __device__ __forceinline__ void stage_rc(int b, int& R, int& C) { const int st = b / 1024, sb = b % 1024, swz = sb ^ (((sb >> 9) & 1) << 5); R = (st >> 1) * 16 + swz / 64; C = (st & 1) * 32 + (swz % 64) / 2; }
__host__ __device__ __forceinline__ int perm32(int rho) { const int n = rho >> 4, i = rho & 15; return 8 * (i >> 2) + 4 * n + (i & 3); }

struct Unit { int pm, pn, ks; };
struct Gemm { const bf16_t* A; const bf16_t* Bt; int M, N, K, ld; };

struct StaticOrder {
    int nM, nN, nwg, G, c, ns;
    __host__ __device__ void init(int M, int N, int G_, int c_, int ns_ = 1) { nM = M / BM; nN = N / BM; nwg = nM * nN; G = G_; c = c_; ns = ns_; }
    __host__ __device__ bool next(int i, Unit& u) const {
        const long L = (long)i * G + c; if (L >= (long)nwg * ns) return false;
        u.ks = (int)(L / nwg);
        int wgid = (int)(L - (long)u.ks * nwg); { const int q = nwg / NXCD, r = nwg % NXCD, xcd = wgid % NXCD, off = wgid / NXCD; wgid = (xcd < r ? xcd * (q + 1) : r * (q + 1) + (xcd - r) * q) + off; }
        const int nig = WGM * nN, gid = wgid / nig, fm = gid * WGM, gsz = (nM - fm) < WGM ? (nM - fm) : WGM;
        u.pm = fm + ((wgid % nig) % gsz); u.pn = (wgid % nig) / gsz; return true;
    }
    __device__ __forceinline__ void a_ready(const Unit&) const {}
    __device__ __forceinline__ void done(const Unit&) const {}
};

typedef float f32x2_cv __attribute__((ext_vector_type(2)));
typedef __bf16 bf16x2_cv __attribute__((ext_vector_type(2)));
__device__ __forceinline__ unsigned cvt_pk_bf16(float lo, float hi) { const f32x2_cv v = {lo, hi}; const bf16x2_cv b = __builtin_convertvector(v, bf16x2_cv); return __builtin_bit_cast(unsigned, b); }

template <class Epi, class Sched>
__device__ __forceinline__ void gemm_phase(PG8_LAS unsigned char* lds, const Gemm g, const Sched& S, const Epi& E) {
    int tid_ = threadIdx.x; asm volatile("" : "+v"(tid_));
    const int tid = tid_, wid = __builtin_amdgcn_readfirstlane(tid >> 6), lane = tid & 63, wr = wid >> 2, wc = wid & 3, fr = lane & 15, fq = lane >> 4;
    const int K = g.ld, nt = g.K / BK;
    unsigned voffA[2], voffB[2];
#pragma unroll
    for (int i = 0; i < 2; ++i) { int R, C; stage_rc(tid * 16 + i * 8192, R, C); const int Rb = Epi::PERM ? ((R & ~31) + perm32(R & 31)) : R;
        voffA[i] = (unsigned)(R * K + C) * 2u; voffB[i] = (unsigned)(Rb * K + C) * 2u; }
    const size_t kstep = (size_t)(BK * 2);
    const size_t hstep = (size_t)HALF * K * 2;
    const size_t tstep = 2 * hstep;
    const unsigned ldsw = (unsigned)wid * 1024u;
    const int aoff = lds_byte(wr * 64 + fr, fq * 8), boff = lds_byte(wc * 32 + fr, fq * 8);
#define PG8_SA(b, h) (((b) * 2 + (h)) * HTB)
#define PG8_SB(b, h) ((4 + (b) * 2 + (h)) * HTB)
#define PG8_STAGE(bufoff, gbase, voff) do { _Pragma("unroll") for (int _i = 0; _i < 2; ++_i) \
        __builtin_amdgcn_global_load_lds((const unsigned*)((const char*)(gbase) + (voff)[_i]), (PG8_LAS unsigned*)(lds + (bufoff) + ldsw + _i * 8192), 16, 0, 0); } while (0)
#define PG8_LDA(dst, b, h) do { _Pragma("unroll") for (int m = 0; m < 4; ++m) _Pragma("unroll") for (int k = 0; k < 2; ++k) dst[m][k] = *(const PG8_LAS bf16x8*)(lds + PG8_SA(b, h) + aoff + m * 2048 + k * 1024); } while (0)
#define PG8_LDB(dst, b, h) do { _Pragma("unroll") for (int n = 0; n < 2; ++n) _Pragma("unroll") for (int k = 0; k < 2; ++k) dst[n][k] = *(const PG8_LAS bf16x8*)(lds + PG8_SB(b, h) + boff + n * 2048 + k * 1024); } while (0)
#define PG8_MMA(ai, bj, At, Bt) do { __builtin_amdgcn_s_setprio(1); _Pragma("unroll") for (int m = 0; m < 4; ++m) _Pragma("unroll") for (int n = 0; n < 2; ++n) _Pragma("unroll") for (int k = 0; k < 2; ++k) \
        acc[ai][bj][m][n] = __builtin_amdgcn_mfma_f32_16x16x32_bf16(Bt[n][k], At[m][k], acc[ai][bj][m][n], 0, 0, 0); __builtin_amdgcn_s_setprio(0); } while (0)
#define PG8_WAIT_V(n) asm volatile("s_waitcnt vmcnt(" #n ")" ::: "memory")
#define PG8_WAIT_L(n) asm volatile("s_waitcnt lgkmcnt(" #n ")" ::: "memory")
#define PG8_BAR __builtin_amdgcn_s_barrier()
#define PG8_SCHED __builtin_amdgcn_sched_barrier(0)
    Unit cur, nxt; int ui = 0;
    if (!S.next(0, cur)) return;
    f32x4 acc[2][2][4][2];
#pragma unroll
    for (int a = 0; a < 2; ++a)
#pragma unroll
        for (int b = 0; b < 2; ++b)
#pragma unroll
            for (int m = 0; m < 4; ++m)
#pragma unroll
                for (int n = 0; n < 2; ++n) acc[a][b][m][n] = (f32x4){0.f, 0.f, 0.f, 0.f};
    bf16x8 At[4][2], B0[2][2], B1[2][2];
    const size_t ksb = (size_t)g.K * 2;
    const char* cA = (const char*)g.A + (size_t)cur.pm * tstep + (size_t)cur.ks * ksb; const char* cB = (const char*)g.Bt + (size_t)cur.pn * tstep + (size_t)cur.ks * ksb;
    S.a_ready(cur);
    PG8_STAGE(PG8_SB(0, 0), cB, voffB); PG8_STAGE(PG8_SB(0, 1), cB + hstep, voffB); PG8_STAGE(PG8_SA(0, 0), cA, voffA); PG8_STAGE(PG8_SA(0, 1), cA + hstep, voffA);
    if (wr == 1) PG8_BAR;
    PG8_WAIT_V(2); PG8_BAR;
    PG8_STAGE(PG8_SB(1, 0), cB + kstep, voffB); PG8_STAGE(PG8_SA(1, 0), cA + kstep, voffA); PG8_STAGE(PG8_SB(1, 1), cB + hstep + kstep, voffB);
    PG8_WAIT_V(6); PG8_BAR;
    for (;;) {
        const bool has_next = S.next(ui + 1, nxt);
        const char* nA = has_next ? (const char*)g.A + (size_t)nxt.pm * tstep + (size_t)nxt.ks * ksb : cA; const char* nB = has_next ? (const char*)g.Bt + (size_t)nxt.pn * tstep + (size_t)nxt.ks * ksb : cB;
        for (int t = 0; t < nt; t += 2) {
            const bool last = (t == nt - 2);
            const char* a1 = cA + (size_t)(t + 1) * kstep;
            const char* a2 = last ? nA : cA + (size_t)(t + 2) * kstep; const char* b2 = last ? nB : cB + (size_t)(t + 2) * kstep;
            const char* a3 = a2 + kstep; const char* b3 = b2 + kstep;
            if (last && has_next) S.a_ready(nxt);
            PG8_LDB(B0, 0, 0); PG8_LDB(B1, 0, 1); PG8_SCHED; PG8_LDA(At, 0, 0); PG8_STAGE(PG8_SA(1, 1), a1 + hstep, voffA);
            PG8_WAIT_V(8); PG8_WAIT_L(0); PG8_BAR; PG8_MMA(0, 0, At, B0); PG8_MMA(0, 1, At, B1); PG8_BAR; PG8_SCHED;
            PG8_LDA(At, 0, 1); PG8_STAGE(PG8_SB(0, 0), b2, voffB); PG8_STAGE(PG8_SB(0, 1), b2 + hstep, voffB); PG8_STAGE(PG8_SA(0, 0), a2, voffA);
            PG8_WAIT_V(8); PG8_WAIT_L(0); PG8_BAR; PG8_MMA(1, 0, At, B0); PG8_MMA(1, 1, At, B1); PG8_BAR; PG8_SCHED;
            PG8_LDB(B0, 1, 0); PG8_LDB(B1, 1, 1); PG8_SCHED; PG8_LDA(At, 1, 0); PG8_STAGE(PG8_SA(0, 1), a2 + hstep, voffA);
            PG8_WAIT_V(8); PG8_WAIT_L(0); PG8_BAR; PG8_MMA(0, 0, At, B0); PG8_MMA(0, 1, At, B1); PG8_BAR; PG8_SCHED;
            PG8_LDA(At, 1, 1); PG8_STAGE(PG8_SB(1, 0), b3, voffB); PG8_STAGE(PG8_SB(1, 1), b3 + hstep, voffB); PG8_STAGE(PG8_SA(1, 0), a3, voffA);
            PG8_WAIT_V(8); PG8_WAIT_L(0); PG8_BAR; PG8_MMA(1, 0, At, B0); PG8_MMA(1, 1, At, B1); PG8_BAR; PG8_SCHED;
        }
        if (wr == 0) PG8_BAR;
        if constexpr (!Epi::AFTER_DRAIN) { E(acc, cur, wr, wc, fr, fq); S.done(cur); }
        if (!has_next) break;
#pragma unroll
        for (int a = 0; a < 2; ++a)
#pragma unroll
            for (int b = 0; b < 2; ++b)
#pragma unroll
                for (int m = 0; m < 4; ++m)
#pragma unroll
                    for (int n = 0; n < 2; ++n) acc[a][b][m][n] = (f32x4){0.f, 0.f, 0.f, 0.f};
        cur = nxt; cA = nA; cB = nB; ++ui;
        if (wr == 1) PG8_BAR;
    }
    PG8_WAIT_V(0);
    PG8_BAR;
    if constexpr (Epi::AFTER_DRAIN) { E.fused(acc, cur, wr, wc, fr, fq, lds, wid, lane); S.done(cur); }
#undef PG8_SA
#undef PG8_SB
#undef PG8_STAGE
#undef PG8_LDA
#undef PG8_LDB
#undef PG8_MMA
#undef PG8_WAIT_V
#undef PG8_WAIT_L
#undef PG8_BAR
#undef PG8_SCHED
}
}

using pg8::bf16_t; using pg8::bf16x8; using pg8::f32x4; using pg8::u32x4; using pg8::u32x2; using pg8::cvt_pk_bf16;
#define LAS __attribute__((address_space(3)))
#define LDS_WAIT() asm volatile("s_waitcnt lgkmcnt(0)" ::: "memory")

constexpr int D = 2048, NP = 8192, NS = 1024, MT = 9216, DFF = 5632, DIN = 11776, NADA = 18432;
constexpr int C_QA = 0, C_KA = 1024, C_VA = 1280, C_QR = 1536, C_KR = 2560, C_VR = 3584, C_GR = 5632, C_GA = 7680, C_GB = 9728;
constexpr float EPS = 1e-6f;
constexpr int LDS_BYTES = 147456;
constexpr int NPH = 16;
enum { PH_PREP = 0, PH_ADA, PH_ROW0, PH_GU1, PH_D1, PH_ROW1, PH_WIN, PH_MIX1, PH_SCAN, PH_RET3, PH_PAPR, PH_WO, PH_ROW2, PH_GU2, PH_D2, PH_ROW3 };

constexpr size_t al256(size_t x) { return (x + 255) & ~(size_t)255; }
constexpr size_t SZ_WGU = (size_t)2 * DFF * D * 2, SZ_WD = (size_t)D * DFF * 2, SZ_WIN = (size_t)DIN * D * 2, SZ_WPA = (size_t)D * 1024 * 2, SZ_WPR = (size_t)D * D * 2, SZ_WO = (size_t)D * D * 2;
constexpr size_t WS_WGU1 = 16384;
constexpr size_t WS_WD1 = WS_WGU1 + SZ_WGU;
constexpr size_t WS_WIN = WS_WD1 + SZ_WD;
constexpr size_t WS_WPA = WS_WIN + SZ_WIN;
constexpr size_t WS_WPR = WS_WPA + SZ_WPA;
constexpr size_t WS_WO = WS_WPR + SZ_WPR;
constexpr size_t WS_WGU2 = WS_WO + SZ_WO;
constexpr size_t WS_WD2 = WS_WGU2 + SZ_WGU;
constexpr size_t WS_MOD = WS_WD2 + SZ_WD;
constexpr size_t WS_CS = WS_MOD + (size_t)256 * NADA * 4;
constexpr size_t WS_ROTC = WS_CS + (size_t)256 * D * 2;
constexpr size_t WS_ROTS = WS_ROTC + al256((size_t)4104 * 64 * 4);
constexpr size_t WS_HB = WS_ROTS + al256((size_t)4104 * 64 * 4);
constexpr size_t WS_F = WS_HB + (size_t)MT * D * 2;
constexpr size_t WS_PROJ = WS_F + (size_t)MT * D * 4;
constexpr size_t WS_PART23 = WS_PROJ + (size_t)MT * DFF * 2;
constexpr size_t WS_OA = WS_PROJ + (size_t)MT * DIN * 2;
constexpr size_t WS_OR = WS_OA + (size_t)MT * 1024 * 2;
constexpr size_t WS_SPT = WS_OR + (size_t)MT * D * 2;
constexpr size_t WS_VT = WS_SPT + (size_t)512 * 32768 * 2;
constexpr size_t WS_END = WS_VT + (size_t)512 * 32768 * 2;

constexpr size_t O_Y = 0, O_KWP = (size_t)MT * D, O_VWP = O_KWP + 65536, O_SRP = O_VWP + 65536, O_KWS = O_SRP + 524288, O_VWS = O_KWS + 4194304, O_SRS = O_VWS + 4194304;

struct Params {
    const float* in[22];
    float* out;
    unsigned char* ws;
    int ph_lo, ph_hi;
};
enum { I_XP = 0, I_XS, I_CK, I_CV, I_ST, I_CP, I_CSM, I_WADA, I_BADA, I_NPRE, I_NPOST, I_WIN, I_SINK, I_WPA, I_WPR, I_WO, I_F1G, I_F1U, I_F1D, I_F2G, I_F2U, I_F2D };

__device__ __forceinline__ float bf2f(unsigned short b) { return __uint_as_float(((unsigned)b) << 16); }
__device__ __forceinline__ float bflo(unsigned w) { return __uint_as_float(w << 16); }
__device__ __forceinline__ float bfhi(unsigned w) { return __uint_as_float(w & 0xffff0000u); }
__device__ __forceinline__ float wave_sum(float v) {
#pragma unroll
    for (int o = 1; o < 64; o <<= 1) v += __shfl_xor(v, o);
    return v;
}
__device__ __forceinline__ float wave_max(float v) {
#pragma unroll
    for (int o = 1; o < 64; o <<= 1) v = fmaxf(v, __shfl_xor(v, o));
    return v;
}
__device__ __forceinline__ float silu_f(float x) { return x * __builtin_amdgcn_rcpf(1.0f + __expf(-x)); }
__device__ __forceinline__ float sigm_f(float x) { return __builtin_amdgcn_rcpf(1.0f + __expf(-x)); }
__device__ __forceinline__ float log2_gamma(int h) { return log2f(1.0f - exp2f(-5.0f - (float)h)); }
__device__ __forceinline__ f32x4 mfma16(bf16x8 a, bf16x8 b, f32x4 c) { return __builtin_amdgcn_mfma_f32_16x16x32_bf16(a, b, c, 0, 0, 0); }

struct EpiF32 {
    static constexpr bool PERM = false, AFTER_DRAIN = false;
    float* C; int ldc; const float* bias;
    __device__ __forceinline__ void operator()(const f32x4 (&acc)[2][2][4][2], const pg8::Unit& u, int wr, int wc, int fr, int fq) const {
        const int row0 = u.pm * 256 + wr * 64 + fr, col0 = u.pn * 256 + wc * 32 + 4 * fq;
        f32x4 bv[2][2];
#pragma unroll
        for (int bj = 0; bj < 2; ++bj)
#pragma unroll
            for (int n = 0; n < 2; ++n) bv[bj][n] = bias ? *(const f32x4*)(bias + col0 + bj * 128 + n * 16) : (f32x4){0.f, 0.f, 0.f, 0.f};
#pragma unroll
        for (int ai = 0; ai < 2; ++ai)
#pragma unroll
            for (int m = 0; m < 4; ++m) { float* rowp = C + (size_t)(row0 + ai * 128 + m * 16) * ldc + col0;
#pragma unroll
                for (int bj = 0; bj < 2; ++bj)
#pragma unroll
                    for (int n = 0; n < 2; ++n) *(f32x4*)(rowp + bj * 128 + n * 16) = acc[ai][bj][m][n] + bv[bj][n]; }
    }
};
struct EpiPart {
    static constexpr bool PERM = true, AFTER_DRAIN = false;
    bf16_t* P01; bf16_t* P23;
    __device__ __forceinline__ void operator()(const f32x4 (&acc)[2][2][4][2], const pg8::Unit& u, int wr, int wc, int fr, int fq) const {
        bf16_t* O = (u.ks < 2 ? P01 : P23) + (size_t)(u.ks & 1) * MT * D;
        const int row0 = u.pm * 256 + wr * 64 + fr, col0 = u.pn * 256 + wc * 32 + 8 * fq;
#pragma unroll
        for (int ai = 0; ai < 2; ++ai)
#pragma unroll
            for (int m = 0; m < 4; ++m) {
                bf16_t* rowp = O + (size_t)(row0 + ai * 128 + m * 16) * D + col0;
#pragma unroll
                for (int bj = 0; bj < 2; ++bj) {
                    const f32x4 v0 = acc[ai][bj][m][0], v1 = acc[ai][bj][m][1];
                    u32x4 w; w.x = cvt_pk_bf16(v0[0], v0[1]); w.y = cvt_pk_bf16(v0[2], v0[3]); w.z = cvt_pk_bf16(v1[0], v1[1]); w.w = cvt_pk_bf16(v1[2], v1[3]);
                    *(u32x4*)(rowp + bj * 128) = w;
                }
            }
    }
};
struct EpiSwiGLU {
    static constexpr bool PERM = true, AFTER_DRAIN = false;
    bf16_t* O;
    __device__ __forceinline__ void operator()(const f32x4 (&acc)[2][2][4][2], const pg8::Unit& u, int wr, int wc, int fr, int fq) const {
        const int row0 = u.pm * 256 + wr * 64 + fr, col0 = u.pn * 128 + wc * 32 + 8 * fq;
#pragma unroll
        for (int ai = 0; ai < 2; ++ai)
#pragma unroll
            for (int m = 0; m < 4; ++m) {
                bf16_t* rowp = O + (size_t)(row0 + ai * 128 + m * 16) * DFF + col0;
                const f32x4 g0 = acc[ai][0][m][0], g1 = acc[ai][0][m][1], u0 = acc[ai][1][m][0], u1 = acc[ai][1][m][1];
                u32x4 w;
                w.x = cvt_pk_bf16(silu_f(g0[0]) * u0[0], silu_f(g0[1]) * u0[1]); w.y = cvt_pk_bf16(silu_f(g0[2]) * u0[2], silu_f(g0[3]) * u0[3]);
                w.z = cvt_pk_bf16(silu_f(g1[0]) * u1[0], silu_f(g1[1]) * u1[1]); w.w = cvt_pk_bf16(silu_f(g1[2]) * u1[2], silu_f(g1[3]) * u1[3]);
                *(u32x4*)rowp = w;
            }
    }
};
struct EpiWin {
    static constexpr bool PERM = true, AFTER_DRAIN = false;
    bf16_t* O; const float* rc; const float* rs;
    __device__ __forceinline__ void operator()(const f32x4 (&acc)[2][2][4][2], const pg8::Unit& u, int wr, int wc, int fr, int fq) const {
        const int pn = u.pn, row0 = u.pm * 256 + wr * 64 + fr;
        if (pn >= 6 && pn < 14) {
            const int slice = (pn - 6) >> 2, tt = (pn - 6) & 3, head = 2 * tt + (wc >> 1), d0 = 32 * (wc & 1) + 8 * fq;
            const int colbase = C_QR + slice * 1024 + head * 128 + d0;
            const float sc = slice ? 0.08838834764831845f : 1.0f;
#pragma unroll
            for (int ai = 0; ai < 2; ++ai)
#pragma unroll
                for (int m = 0; m < 4; ++m) {
                    const int row = row0 + ai * 128 + m * 16;
                    const int pidx = row < NP ? (row & 4095) : 4096 + ((row - NP) & 7);
                    const f32x4 c0 = *(const f32x4*)(rc + pidx * 64 + d0), c1 = *(const f32x4*)(rc + pidx * 64 + d0 + 4);
                    const f32x4 s0 = *(const f32x4*)(rs + pidx * 64 + d0), s1 = *(const f32x4*)(rs + pidx * 64 + d0 + 4);
                    const f32x4 a0 = acc[ai][0][m][0] * sc, a1 = acc[ai][0][m][1] * sc, b0 = acc[ai][1][m][0] * sc, b1 = acc[ai][1][m][1] * sc;
                    const f32x4 p0 = a0 * c0 - b0 * s0, p1 = a1 * c1 - b1 * s1, q0 = a0 * s0 + b0 * c0, q1 = a1 * s1 + b1 * c1;
                    u32x4 w1, w2;
                    w1.x = cvt_pk_bf16(p0[0], p0[1]); w1.y = cvt_pk_bf16(p0[2], p0[3]); w1.z = cvt_pk_bf16(p1[0], p1[1]); w1.w = cvt_pk_bf16(p1[2], p1[3]);
                    w2.x = cvt_pk_bf16(q0[0], q0[1]); w2.y = cvt_pk_bf16(q0[2], q0[3]); w2.z = cvt_pk_bf16(q1[0], q1[1]); w2.w = cvt_pk_bf16(q1[2], q1[3]);
                    bf16_t* rowp = O + (size_t)row * DIN + colbase;
                    *(u32x4*)rowp = w1; *(u32x4*)(rowp + 64) = w2;
                }
        } else {
            const int mode = pn < 22 ? 0 : (pn < 30 ? 1 : 2);
            const int col0 = pn * 256 + wc * 32 + 8 * fq;
#pragma unroll
            for (int ai = 0; ai < 2; ++ai)
#pragma unroll
                for (int m = 0; m < 4; ++m) {
                    bf16_t* rowp = O + (size_t)(row0 + ai * 128 + m * 16) * DIN + col0;
#pragma unroll
                    for (int bj = 0; bj < 2; ++bj) {
                        f32x4 v0 = acc[ai][bj][m][0], v1 = acc[ai][bj][m][1];
                        if (mode == 1) {
#pragma unroll
                            for (int j = 0; j < 4; ++j) { v0[j] = silu_f(v0[j]); v1[j] = silu_f(v1[j]); }
                        } else if (mode == 2) {
#pragma unroll
                            for (int j = 0; j < 4; ++j) { v0[j] = sigm_f(v0[j]); v1[j] = sigm_f(v1[j]); }
                        }
                        u32x4 w; w.x = cvt_pk_bf16(v0[0], v0[1]); w.y = cvt_pk_bf16(v0[2], v0[3]); w.z = cvt_pk_bf16(v1[0], v1[1]); w.w = cvt_pk_bf16(v1[2], v1[3]);
                        *(u32x4*)(rowp + bj * 128) = w;
                    }
                }
        }
    }
};
struct EpiPa {
    static constexpr bool PERM = true, AFTER_DRAIN = false;
    float* T; const bf16_t* P;
    __device__ __forceinline__ void operator()(const f32x4 (&acc)[2][2][4][2], const pg8::Unit& u, int wr, int wc, int fr, int fq) const {
        const int row0 = u.pm * 256 + wr * 64 + fr, col0 = u.pn * 256 + wc * 32 + 8 * fq;
#pragma unroll
        for (int ai = 0; ai < 2; ++ai) {
            u32x4 gq[4][2];
#pragma unroll
            for (int m = 0; m < 4; ++m)
#pragma unroll
                for (int bj = 0; bj < 2; ++bj) gq[m][bj] = *(const u32x4*)(P + (size_t)(row0 + ai * 128 + m * 16) * DIN + C_GA + col0 + bj * 128);
#pragma unroll
            for (int m = 0; m < 4; ++m) {
                const int row = row0 + ai * 128 + m * 16;
#pragma unroll
                for (int bj = 0; bj < 2; ++bj) {
                    const u32x4 g = gq[m][bj];
                    f32x4 v0 = acc[ai][bj][m][0], v1 = acc[ai][bj][m][1];
                    v0[0] *= bflo(g.x); v0[1] *= bfhi(g.x); v0[2] *= bflo(g.y); v0[3] *= bfhi(g.y);
                    v1[0] *= bflo(g.z); v1[1] *= bfhi(g.z); v1[2] *= bflo(g.w); v1[3] *= bfhi(g.w);
                    float* tp = T + (size_t)row * D + col0 + bj * 128;
                    *(f32x4*)tp = v0; *(f32x4*)(tp + 4) = v1;
                }
            }
        }
    }
};
struct EpiPr {
    static constexpr bool PERM = true, AFTER_DRAIN = false;
    const float* T; const bf16_t* P; bf16_t* O;
    __device__ __forceinline__ void operator()(const f32x4 (&acc)[2][2][4][2], const pg8::Unit& u, int wr, int wc, int fr, int fq) const {
        const int row0 = u.pm * 256 + wr * 64 + fr, col0 = u.pn * 256 + wc * 32 + 8 * fq;
#pragma unroll
        for (int ai = 0; ai < 2; ++ai)
#pragma unroll
            for (int mp = 0; mp < 2; ++mp) {
                u32x4 gq[2][2]; f32x4 t0[2][2], t1[2][2];
#pragma unroll
                for (int mi = 0; mi < 2; ++mi)
#pragma unroll
                    for (int bj = 0; bj < 2; ++bj) {
                        const int row = row0 + ai * 128 + (2 * mp + mi) * 16;
                        gq[mi][bj] = *(const u32x4*)(P + (size_t)row * DIN + C_GB + col0 + bj * 128);
                        const float* tp = T + (size_t)row * D + col0 + bj * 128;
                        t0[mi][bj] = *(const f32x4*)tp; t1[mi][bj] = *(const f32x4*)(tp + 4);
                    }
#pragma unroll
                for (int mi = 0; mi < 2; ++mi)
#pragma unroll
                    for (int bj = 0; bj < 2; ++bj) {
                        const int m = 2 * mp + mi, row = row0 + ai * 128 + m * 16;
                        const u32x4 g = gq[mi][bj]; const f32x4 a0 = t0[mi][bj], a1 = t1[mi][bj];
                        f32x4 v0 = acc[ai][bj][m][0], v1 = acc[ai][bj][m][1];
                        v0[0] = a0[0] + v0[0] * bflo(g.x); v0[1] = a0[1] + v0[1] * bfhi(g.x); v0[2] = a0[2] + v0[2] * bflo(g.y); v0[3] = a0[3] + v0[3] * bfhi(g.y);
                        v1[0] = a1[0] + v1[0] * bflo(g.z); v1[1] = a1[1] + v1[1] * bfhi(g.z); v1[2] = a1[2] + v1[2] * bflo(g.w); v1[3] = a1[3] + v1[3] * bfhi(g.w);
                        u32x4 w; w.x = cvt_pk_bf16(v0[0], v0[1]); w.y = cvt_pk_bf16(v0[2], v0[3]); w.z = cvt_pk_bf16(v1[0], v1[1]); w.w = cvt_pk_bf16(v1[2], v1[3]);
                        *(u32x4*)(O + (size_t)row * D + col0 + bj * 128) = w;
                    }
            }
    }
};

template <class Epi>
__device__ __forceinline__ void run_gemm(LAS unsigned char* lds, const bf16_t* A, const bf16_t* Bt, int M, int N, int K, const Epi& E, int ns = 1) {
    pg8::Gemm g; g.A = A; g.Bt = Bt; g.M = M; g.N = N; g.K = K / ns; g.ld = K;
    pg8::StaticOrder S; S.init(M, N, (int)gridDim.x, (int)blockIdx.x, ns);
    pg8::gemm_phase<Epi, pg8::StaticOrder>(lds, g, S, E);
}

__device__ __forceinline__ void transpose_item(const float* __restrict__ W, int K, int N, bf16_t* WT, int k0, int n0, int drow, LAS float* scr, int lane) {
#pragma unroll 8
    for (int i = 0; i < 32; ++i) { const int kk = 2 * i + (lane >> 5); scr[kk * 33 + (lane & 31)] = W[(size_t)(k0 + kk) * N + n0 + (lane & 31)]; }
    LDS_WAIT();
    const int c = lane & 7;
#pragma unroll
    for (int j = 0; j < 4; ++j) { const int n = (lane >> 3) + 8 * j; const LAS float* s = scr + (8 * c) * 33 + n;
        u32x4 o; o.x = cvt_pk_bf16(s[0 * 33], s[1 * 33]); o.y = cvt_pk_bf16(s[2 * 33], s[3 * 33]); o.z = cvt_pk_bf16(s[4 * 33], s[5 * 33]); o.w = cvt_pk_bf16(s[6 * 33], s[7 * 33]);
        *(u32x4*)(WT + (size_t)(drow + n) * K + k0 + 8 * c) = o; }
    LDS_WAIT();
}
__device__ __forceinline__ int map_gu(int n0, int up) { return 256 * (n0 >> 7) + (n0 & 127) + (up ? 128 : 0); }
__device__ __forceinline__ int map_win(int n0) {
    if (n0 < C_QR || n0 >= C_VR) return n0;
    const int s = n0 - C_QR, slice = s >> 10, within = s & 1023, h = within >> 7, half = (within >> 6) & 1, d0 = within & 63;
    return C_QR + slice * 1024 + (h >> 1) * 256 + half * 128 + (h & 1) * 64 + d0;
}
__device__ __forceinline__ int tjob_items(int j) {
    return (j == 0 || j == 1 || j == 7 || j == 8) ? (D / 64) * (DFF / 32) : (j == 2 || j == 9) ? (DFF / 64) * (D / 32) : j == 3 ? (D / 64) * (DIN / 32) : j == 4 ? (1024 / 64) * (D / 32) : (D / 64) * (D / 32);
}
__device__ __forceinline__ void run_tjobs(const Params& p, LAS unsigned char* lds, int jlo, int jhi, int widx, int nw, int skip = 0, int limit = 0x7fffffff) {
    const int lane = threadIdx.x & 63, wave = threadIdx.x >> 6;
    LAS float* scr = (LAS float*)(lds + wave * 8704);
    unsigned char* ws = p.ws;
    int total = 0;
    for (int j = jlo; j < jhi; ++j) total += tjob_items(j);
    if (total > skip + limit) total = skip + limit;
    for (int it = skip + widx; it < total; it += nw) {
        int r = it, j = jlo;
        while (r >= tjob_items(j)) { r -= tjob_items(j); ++j; }
        const float* W; int K, N; bf16_t* WT; int kind;
        switch (j) {
        case 0: W = p.in[I_F1G]; K = D; N = DFF; WT = (bf16_t*)(ws + WS_WGU1); kind = 1; break;
        case 1: W = p.in[I_F1U]; K = D; N = DFF; WT = (bf16_t*)(ws + WS_WGU1); kind = 2; break;
        case 2: W = p.in[I_F1D]; K = DFF; N = D; WT = (bf16_t*)(ws + WS_WD1); kind = 0; break;
        case 3: W = p.in[I_WIN]; K = D; N = DIN; WT = (bf16_t*)(ws + WS_WIN); kind = 3; break;
        case 4: W = p.in[I_WPA]; K = 1024; N = D; WT = (bf16_t*)(ws + WS_WPA); kind = 0; break;
        case 5: W = p.in[I_WPR]; K = D; N = D; WT = (bf16_t*)(ws + WS_WPR); kind = 0; break;
        case 6: W = p.in[I_WO]; K = D; N = D; WT = (bf16_t*)(ws + WS_WO); kind = 0; break;
        case 7: W = p.in[I_F2G]; K = D; N = DFF; WT = (bf16_t*)(ws + WS_WGU2); kind = 1; break;
        case 8: W = p.in[I_F2U]; K = D; N = DFF; WT = (bf16_t*)(ws + WS_WGU2); kind = 2; break;
        default: W = p.in[I_F2D]; K = DFF; N = D; WT = (bf16_t*)(ws + WS_WD2); kind = 0; break;
        }
        const int nblk = N / 32, kb = r / nblk, nb = r - kb * nblk, k0 = 64 * kb, n0 = 32 * nb;
        const int drow = kind == 0 ? n0 : (kind == 3 ? map_win(n0) : map_gu(n0, kind == 2));
        transpose_item(W, K, N, WT, k0, n0, drow, scr, lane);
    }
}
__device__ __forceinline__ void tail_tjobs(const Params& p, LAS unsigned char* lds, int nunits, int jlo, int jhi, int skip = 0, int limit = 0x7fffffff) {
    const int G = gridDim.x, rem = nunits % G, c = blockIdx.x;
    if (rem == 0) { run_tjobs(p, lds, jlo, jhi, c * 8 + (threadIdx.x >> 6), G * 8, skip, limit); return; }
    if (c >= rem) run_tjobs(p, lds, jlo, jhi, (c - rem) * 8 + (threadIdx.x >> 6), (G - rem) * 8, skip, limit);
}
__device__ __forceinline__ void phase_prep(const Params& p, LAS unsigned char* lds) {
    const int tid = threadIdx.x, wave = tid >> 6;
    unsigned char* ws = p.ws;
    const int gt = blockIdx.x * 512 + tid, NGT = gridDim.x * 512;
    bf16_t* CS = (bf16_t*)(ws + WS_CS);
    for (int i = gt; i < 256 * D / 4; i += NGT) {
        const int r = i >> 9, k = (i & 511) * 4;
        u32x2 w = {0u, 0u};
        if (r < 130) {
            const float* c = r < 2 ? p.in[I_CP] + (size_t)r * D : p.in[I_CSM] + (size_t)(r - 2) * D;
            const f32x4 v = *(const f32x4*)(c + k);
            w.x = cvt_pk_bf16(silu_f(v[0]), silu_f(v[1])); w.y = cvt_pk_bf16(silu_f(v[2]), silu_f(v[3]));
        }
        *(u32x2*)(CS + (size_t)r * D + k) = w;
    }
    float* rc = (float*)(ws + WS_ROTC); float* rs = (float*)(ws + WS_ROTS);
    for (int i = gt; i < 4104 * 64; i += NGT) {
        const int pi = i >> 6, d = i & 63;
        const float pos = pi < 4096 ? (float)pi : (float)(16384 + (pi - 4096));
        const float inv = (float)exp(-((double)d / 63.0) * 9.210340371976184);
        const float ang = pos * inv;
        double rev = (double)ang * 0.15915494309189535; rev -= rint(rev);
        const float rf = (float)rev;
        rc[i] = __builtin_amdgcn_cosf(rf); rs[i] = __builtin_amdgcn_sinf(rf);
    }
    run_tjobs(p, lds, 0, 2, blockIdx.x * 8 + wave, gridDim.x * 8);
}
__device__ __forceinline__ void phase_ada(const Params& p, LAS unsigned char* lds) {
    const int tid = threadIdx.x, lane = tid & 63, wave = tid >> 6, fr = lane & 15, fq = lane >> 4;
    const int gw = blockIdx.x * 8 + wave, NGW = gridDim.x * 8;
    constexpr int NT = NADA / 16;
    const int nblk_ada = (NT + 7) / 8;
    if ((int)blockIdx.x >= nblk_ada) { run_tjobs(p, lds, 3, 4, (blockIdx.x - nblk_ada) * 8 + wave, ((int)gridDim.x - nblk_ada) * 8, 0, 8832); return; }
    const bf16_t* CS = (const bf16_t*)(p.ws + WS_CS);
    float* MOD = (float*)(p.ws + WS_MOD);
    const float* W = p.in[I_WADA];
    LAS bf16_t* As = (LAS bf16_t*)lds;
    {
        const int t = gw;
        const int n = 16 * (t < NT ? t : NT - 1) + fr;
        f32x4 acc[9];
#pragma unroll
        for (int mt = 0; mt < 9; ++mt) acc[mt] = (f32x4){0.f, 0.f, 0.f, 0.f};
#define ADA_LOAD(wv, g8_) do { const float* wp_ = W + (size_t)(256 * (g8_) + 8 * fq) * NADA + n; \
        _Pragma("unroll") for (int c = 0; c < 8; ++c) _Pragma("unroll") for (int i = 0; i < 8; ++i) wv[c][i] = wp_[(size_t)(32 * c + i) * NADA]; } while (0)
#define ADA_GROUP(wv, g8_) do { \
        u32x4 av_[9]; \
        _Pragma("unroll") for (int tt = 0; tt < 9; ++tt) { const int pc = tid + 512 * tt, r = pc >> 5, c8 = (pc & 31) * 8; av_[tt] = *(const u32x4*)(CS + (size_t)r * D + 256 * (g8_) + c8); } \
        __syncthreads(); \
        _Pragma("unroll") for (int tt = 0; tt < 9; ++tt) { const int pc = tid + 512 * tt, r = pc >> 5, c8 = (pc & 31) * 8; *(LAS u32x4*)(As + r * 264 + c8) = av_[tt]; } \
        __syncthreads(); \
        _Pragma("unroll") for (int c = 0; c < 8; ++c) { \
            union { bf16x8 v; u32x4 q; } bf; \
            bf.q.x = cvt_pk_bf16(wv[c][0], wv[c][1]); bf.q.y = cvt_pk_bf16(wv[c][2], wv[c][3]); bf.q.z = cvt_pk_bf16(wv[c][4], wv[c][5]); bf.q.w = cvt_pk_bf16(wv[c][6], wv[c][7]); \
            const LAS bf16_t* ap = As + fr * 264 + 32 * c + 8 * fq; \
            _Pragma("unroll") for (int mt = 0; mt < 9; ++mt) acc[mt] = mfma16(*(const LAS bf16x8*)(ap + (16 * mt) * 264), bf.v, acc[mt]); } } while (0)
        float wa[8][8], wb[8][8];
        ADA_LOAD(wa, 0);
#pragma unroll 1
        for (int g8 = 0; g8 < 8; g8 += 2) {
            ADA_LOAD(wb, g8 + 1);
            ADA_GROUP(wa, g8);
            if (g8 + 2 < 8) ADA_LOAD(wa, g8 + 2);
            ADA_GROUP(wb, g8 + 1);
        }
#undef ADA_LOAD
#undef ADA_GROUP
        const int sec = n >> 11, i3 = sec / 3, j3 = sec - 3 * i3, cc = n & 2047;
        const float bias = p.in[I_BADA][n];
        float mul = 1.0f, add = bias;
        if (j3 == 1) { mul = p.in[I_NPRE][i3 * D + cc]; add = bias + 1.0f; }
        else if (j3 == 2) mul = p.in[I_NPOST][i3 * D + cc] * (i3 == 1 ? 1.0f : 0.5f);
#pragma unroll
        for (int mt = 0; mt < 9; ++mt)
#pragma unroll
            for (int jj = 0; jj < 4; ++jj) { const int m = 16 * mt + 4 * fq + jj; if (m < 130 && t < NT) MOD[(size_t)m * NADA + n] = (acc[mt][jj] + add) * mul; }
    }
}

template <int KIND>
__device__ __forceinline__ void phase_row(const Params& p) {
    const int tid = threadIdx.x, lane = tid & 63, wave = tid >> 6;
    const int gw = blockIdx.x * 8 + wave, NGW = gridDim.x * 8;
    const float* MOD = (const float*)(p.ws + WS_MOD);
    const bf16_t* P01 = (const bf16_t*)(p.ws + WS_F);
    const bf16_t* P23 = (const bf16_t*)(p.ws + WS_PART23);
    bf16_t* HB = (bf16_t*)(p.ws + WS_HB);
    float* X = p.out;
#pragma unroll 1
    for (int row = gw; row < MT; row += NGW) {
        const int mrow = row < NP ? (row >> 12) : 2 + ((row - NP) >> 3);
        const float* mod = MOD + (size_t)mrow * NADA;
        const float* xin = row < NP ? p.in[I_XP] + (size_t)row * D : p.in[I_XS] + (size_t)(row - NP) * D;
        const float* xs = (KIND <= 1) ? xin : X + (size_t)row * D;
        f32x4 v[8], b1[8], b2[8];
#pragma unroll
        for (int j = 0; j < 8; ++j) v[j] = *(const f32x4*)(xs + 4 * (lane + 64 * j));
        __builtin_amdgcn_sched_barrier(0);
        if (KIND == 0) {
#pragma unroll
            for (int j = 0; j < 8; ++j) { b1[j] = *(const f32x4*)(mod + (KIND * 3 + 1) * D + 4 * (lane + 64 * j)); b2[j] = *(const f32x4*)(mod + (KIND * 3) * D + 4 * (lane + 64 * j)); }
        }
        if (KIND > 0) {
            u32x2 pr[4][8]; f32x4 a1[8];
#pragma unroll
            for (int j = 0; j < 8; ++j) {
                const size_t o = (size_t)row * D + 4 * (lane + 64 * j);
                pr[0][j] = *(const u32x2*)(P01 + o); pr[1][j] = *(const u32x2*)(P01 + (size_t)MT * D + o);
                pr[2][j] = *(const u32x2*)(P23 + o); pr[3][j] = *(const u32x2*)(P23 + (size_t)MT * D + o);
                a1[j] = *(const f32x4*)(mod + ((KIND - 1) * 3 + 2) * D + 4 * (lane + 64 * j));
            }
            __builtin_amdgcn_sched_barrier(0);
            f32x4 f[8]; float ss = 0.f;
#pragma unroll
            for (int j = 0; j < 8; ++j) {
                f[j][0] = (bflo(pr[0][j].x) + bflo(pr[1][j].x)) + (bflo(pr[2][j].x) + bflo(pr[3][j].x));
                f[j][1] = (bfhi(pr[0][j].x) + bfhi(pr[1][j].x)) + (bfhi(pr[2][j].x) + bfhi(pr[3][j].x));
                f[j][2] = (bflo(pr[0][j].y) + bflo(pr[1][j].y)) + (bflo(pr[2][j].y) + bflo(pr[3][j].y));
                f[j][3] = (bfhi(pr[0][j].y) + bfhi(pr[1][j].y)) + (bfhi(pr[2][j].y) + bfhi(pr[3][j].y));
                ss += (f[j][0] * f[j][0] + f[j][1] * f[j][1]) + (f[j][2] * f[j][2] + f[j][3] * f[j][3]);
            }
            __builtin_amdgcn_sched_barrier(0);
            if (KIND < 3) {
#pragma unroll
                for (int j = 0; j < 8; ++j) { b1[j] = *(const f32x4*)(mod + (KIND * 3 + 1) * D + 4 * (lane + 64 * j)); b2[j] = *(const f32x4*)(mod + (KIND * 3) * D + 4 * (lane + 64 * j)); }
            }
            __builtin_amdgcn_sched_barrier(0);
            const float rstd = rsqrtf(wave_sum(ss) * (1.0f / D) + EPS);
#pragma unroll
            for (int j = 0; j < 8; ++j) {
                v[j] = v[j] + (f[j] * rstd) * a1[j];
                *(f32x4*)(X + (size_t)row * D + 4 * (lane + 64 * j)) = v[j];
            }
        }
        __builtin_amdgcn_sched_barrier(0);
        if (KIND < 3) {
            float ss = 0.f;
#pragma unroll
            for (int j = 0; j < 8; ++j) ss += (v[j][0] * v[j][0] + v[j][1] * v[j][1]) + (v[j][2] * v[j][2] + v[j][3] * v[j][3]);
            const float rstd = rsqrtf(wave_sum(ss) * (1.0f / D) + EPS);
#pragma unroll
            for (int j = 0; j < 8; ++j) {
                const f32x4 h = (v[j] * rstd) * b1[j] + b2[j];
                u32x2 w; w.x = cvt_pk_bf16(h[0], h[1]); w.y = cvt_pk_bf16(h[2], h[3]);
                *(u32x2*)(HB + (size_t)row * D + 4 * (lane + 64 * j)) = w;
            }
        }
    }
}

__device__ __forceinline__ void kv_unit(const Params& p, LAS unsigned char* lds, int u) {
    const int tid = threadIdx.x, lane = tid & 63, w = tid >> 6, fr = lane & 15, fq = lane >> 4;
    const int c = u & 31, bh = u >> 5, h = bh & 7, b = bh >> 3;
    const int row0 = b * 4096 + c * 128;
    const bf16_t* PROJ = (const bf16_t*)(p.ws + WS_PROJ);
    const bf16_t* Kg = PROJ + (size_t)row0 * DIN + C_KR + h * 128;
    const bf16_t* Vg = PROJ + (size_t)row0 * DIN + C_VR + h * 256;
    LAS bf16_t* Kt = (LAS bf16_t*)lds;
    LAS bf16_t* Vt = (LAS bf16_t*)(lds + 34816);
    const float l2g = log2_gamma(h);
    {
        const int j = tid & 127, cgp = tid >> 7;
        const float kw = exp2f((float)(127 - j) * l2g);
#pragma unroll
        for (int it = 0; it < 4; ++it) {
            const int ch = cgp + 4 * it;
            const u32x4 v = *(const u32x4*)(Kg + (size_t)j * DIN + ch * 8);
            const unsigned a0 = cvt_pk_bf16(bflo(v.x) * kw, bfhi(v.x) * kw), a1 = cvt_pk_bf16(bflo(v.y) * kw, bfhi(v.y) * kw), a2 = cvt_pk_bf16(bflo(v.z) * kw, bfhi(v.z) * kw), a3 = cvt_pk_bf16(bflo(v.w) * kw, bfhi(v.w) * kw);
            LAS bf16_t* dst = Kt + (ch * 8) * 136 + j;
            dst[0 * 136] = (bf16_t)a0; dst[1 * 136] = (bf16_t)(a0 >> 16); dst[2 * 136] = (bf16_t)a1; dst[3 * 136] = (bf16_t)(a1 >> 16);
            dst[4 * 136] = (bf16_t)a2; dst[5 * 136] = (bf16_t)(a2 >> 16); dst[6 * 136] = (bf16_t)a3; dst[7 * 136] = (bf16_t)(a3 >> 16);
        }
#pragma unroll
        for (int it = 0; it < 8; ++it) {
            const int ch = cgp + 4 * it;
            const u32x4 v = *(const u32x4*)(Vg + (size_t)j * DIN + ch * 8);
            LAS bf16_t* dst = Vt + (ch * 8) * 136 + j;
            dst[0 * 136] = (bf16_t)v.x; dst[1 * 136] = (bf16_t)(v.x >> 16); dst[2 * 136] = (bf16_t)v.y; dst[3 * 136] = (bf16_t)(v.y >> 16);
            dst[4 * 136] = (bf16_t)v.z; dst[5 * 136] = (bf16_t)(v.z >> 16); dst[6 * 136] = (bf16_t)v.w; dst[7 * 136] = (bf16_t)(v.w >> 16);
        }
    }
    __syncthreads();
    {
        bf16_t* VTg = (bf16_t*)(p.ws + WS_VT) + (size_t)u * 32768;
#pragma unroll
        for (int it = 0; it < 8; ++it) { const int piece = tid + 512 * it, e = piece >> 4, jc = piece & 15;
            *(u32x4*)(VTg + e * 128 + jc * 8) = *(const LAS u32x4*)(Vt + e * 136 + jc * 8); }
    }
    f32x4 acc[8][2];
#pragma unroll
    for (int mt = 0; mt < 8; ++mt) { acc[mt][0] = (f32x4){0.f, 0.f, 0.f, 0.f}; acc[mt][1] = (f32x4){0.f, 0.f, 0.f, 0.f}; }
#pragma unroll
    for (int kc = 0; kc < 4; ++kc) {
        const bf16x8 b0 = *(const LAS bf16x8*)(Vt + (32 * w + fr) * 136 + kc * 32 + fq * 8);
        const bf16x8 b1 = *(const LAS bf16x8*)(Vt + (32 * w + 16 + fr) * 136 + kc * 32 + fq * 8);
#pragma unroll
        for (int mt = 0; mt < 8; ++mt) {
            const bf16x8 a = *(const LAS bf16x8*)(Kt + (16 * mt + fr) * 136 + kc * 32 + fq * 8);
            acc[mt][0] = mfma16(a, b0, acc[mt][0]); acc[mt][1] = mfma16(a, b1, acc[mt][1]);
        }
    }
    float* KVT = (float*)(p.ws + WS_F) + (size_t)u * 32768;
#pragma unroll
    for (int nt = 0; nt < 2; ++nt)
#pragma unroll
        for (int mt = 0; mt < 8; ++mt) *(f32x4*)(KVT + (32 * w + 16 * nt + fr) * 128 + 16 * mt + 4 * fq) = acc[mt][nt];
    __syncthreads();
}

__device__ __forceinline__ void attn_unit(const Params& p, LAS unsigned char* lds, int u) {
    const int tid = threadIdx.x, lane = tid & 63, w = tid >> 6, fr = lane & 15, fq = lane >> 4;
    const int kvh = u & 3, qb = (u >> 2) & 31, b = u >> 7;
    const int rowq0 = b * 4096 + qb * 128, rowk0 = rowq0 - 128;
    const bf16_t* PROJ = (const bf16_t*)(p.ws + WS_PROJ);
    bf16_t* OA = (bf16_t*)(p.ws + WS_OA);
    LAS bf16_t* Vt = (LAS bf16_t*)lds;
    {
        const int s = tid & 255, hf = tid >> 8;
        const bool ok = (qb > 0) || (s >= 128);
#pragma unroll
        for (int it = 0; it < 4; ++it) {
            const int ch = hf * 4 + it;
            u32x4 v = {0u, 0u, 0u, 0u};
            if (ok) v = *(const u32x4*)(PROJ + (size_t)(rowk0 + s) * DIN + C_VA + kvh * 64 + ch * 8);
            LAS bf16_t* dst = Vt + (ch * 8) * 296 + s;
            dst[0 * 296] = (bf16_t)v.x; dst[1 * 296] = (bf16_t)(v.x >> 16); dst[2 * 296] = (bf16_t)v.y; dst[3 * 296] = (bf16_t)(v.y >> 16);
            dst[4 * 296] = (bf16_t)v.z; dst[5 * 296] = (bf16_t)(v.z >> 16); dst[6 * 296] = (bf16_t)v.w; dst[7 * 296] = (bf16_t)(v.w >> 16);
        }
        const int d = tid >> 3, k4 = (tid & 7) * 4;
        *(LAS u32x2*)(Vt + d * 296 + 256 + k4) = (u32x2){0u, 0u};
    }
    __syncthreads();
    const int g = w >> 1, hh = kvh * 4 + g;
    const float slope = exp2f(-0.5f * (float)(hh + 1));
    const float sink = p.in[I_SINK][hh];
#pragma unroll 1
    for (int qt = 0; qt < 4; ++qt) {
        const int a0 = (w & 1) * 64 + 16 * qt, a = a0 + fr, kt0 = a0 >> 4;
        const bf16_t* qp = PROJ + (size_t)(rowq0 + a) * DIN + C_QA + hh * 64 + fq * 8;
        const bf16x8 q0 = *(const bf16x8*)qp, q1 = *(const bf16x8*)(qp + 32);
        f32x4 s[10];
#pragma unroll
        for (int kt = 0; kt < 10; ++kt) {
            const int sidx = 16 * (kt0 + kt) + fr;
            int krow = rowk0 + sidx;
            if (sidx > 255) krow = rowq0;
            if (krow < 0) krow = 0;
            const bf16_t* kp = PROJ + (size_t)krow * DIN + C_KA + kvh * 64 + fq * 8;
            const bf16x8 k0 = *(const bf16x8*)kp, k1 = *(const bf16x8*)(kp + 32);
            f32x4 z = {0.f, 0.f, 0.f, 0.f};
            z = mfma16(k0, q0, z); s[kt] = mfma16(k1, q1, z);
        }
        float m = sink;
#pragma unroll
        for (int kt = 0; kt < 10; ++kt)
#pragma unroll
            for (int jj = 0; jj < 4; ++jj) {
                const int sidx = 16 * (kt0 + kt) + 4 * fq + jj, dist = 128 + a - sidx;
                const bool valid = dist >= 0 && dist <= 128 && (qb > 0 || sidx >= 128);
                const float sc = valid ? s[kt][jj] * 0.125f - slope * (float)dist : -INFINITY;
                s[kt][jj] = sc; m = fmaxf(m, sc);
            }
        m = fmaxf(m, __shfl_xor(m, 16)); m = fmaxf(m, __shfl_xor(m, 32));
        float l = 0.f;
#pragma unroll
        for (int kt = 0; kt < 10; ++kt)
#pragma unroll
            for (int jj = 0; jj < 4; ++jj) { const float e = __expf(s[kt][jj] - m); s[kt][jj] = e; l += e; }
        l += __shfl_xor(l, 16); l += __shfl_xor(l, 32);
        l += __expf(sink - m);
        f32x4 o[4];
#pragma unroll
        for (int dt = 0; dt < 4; ++dt) o[dt] = (f32x4){0.f, 0.f, 0.f, 0.f};
#pragma unroll
        for (int cc = 0; cc < 5; ++cc) {
            union { bf16x8 v; u32x4 w; } pf;
            pf.w.x = cvt_pk_bf16(s[2 * cc][0], s[2 * cc][1]); pf.w.y = cvt_pk_bf16(s[2 * cc][2], s[2 * cc][3]);
            pf.w.z = cvt_pk_bf16(s[2 * cc + 1][0], s[2 * cc + 1][1]); pf.w.w = cvt_pk_bf16(s[2 * cc + 1][2], s[2 * cc + 1][3]);
#pragma unroll
            for (int dt = 0; dt < 4; ++dt) {
                const LAS bf16_t* vp = Vt + (16 * dt + fr) * 296 + 16 * (kt0 + 2 * cc) + 4 * fq;
                union { bf16x8 v; u32x2 h[2]; } af;
                af.h[0] = *(const LAS u32x2*)vp; af.h[1] = *(const LAS u32x2*)(vp + 16);
                o[dt] = mfma16(af.v, pf.v, o[dt]);
            }
        }
        const float inv = 1.0f / l;
        bf16_t* op = OA + (size_t)(rowq0 + a) * 1024 + hh * 64 + 4 * fq;
#pragma unroll
        for (int dt = 0; dt < 4; ++dt) { u32x2 wv; wv.x = cvt_pk_bf16(o[dt][0] * inv, o[dt][1] * inv); wv.y = cvt_pk_bf16(o[dt][2] * inv, o[dt][3] * inv); *(u32x2*)(op + 16 * dt) = wv; }
    }
    __syncthreads();
}

__device__ __forceinline__ void sattn_unit(const Params& p, LAS unsigned char* lds, int u) {
    const int tid = threadIdx.x, lane = tid & 63, w = tid >> 6;
    const int kvh = u & 3, n = u >> 2;
    const bf16_t* PROJ = (const bf16_t*)(p.ws + WS_PROJ);
    bf16_t* OA = (bf16_t*)(p.ws + WS_OA);
    LAS float* Ks = (LAS float*)lds;
    LAS float* Vs = Ks + 136 * 65;
    LAS float* Qs = Vs + 136 * 64;
    LAS float* Ps = Qs + 2048;
    const float* ck = p.in[I_CK]; const float* cv = p.in[I_CV];
    {
        f32x4 kq[4], vq[4];
#pragma unroll
        for (int t = 0; t < 4; ++t) { const int pc = tid + 512 * t, sr = pc >> 4, d4 = (pc & 15) * 4; const size_t o = ((size_t)(n * 128 + sr)) * 256 + kvh * 64 + d4;
            kq[t] = *(const f32x4*)(ck + o); vq[t] = *(const f32x4*)(cv + o); }
        const bf16_t* rn = PROJ + (size_t)(NP + n * 8 + (tid >> 6)) * DIN + kvh * 64 + (tid & 63);
        const bf16_t kn = rn[C_KA], vn = rn[C_VA];
        const int qr_ = tid >> 4, qd4 = (tid & 15) * 4, qg = qr_ >> 3, qa = qr_ & 7;
        const u32x2 qv = *(const u32x2*)(PROJ + (size_t)(NP + n * 8 + qa) * DIN + C_QA + (kvh * 4 + qg) * 64 + qd4);
#pragma unroll
        for (int t = 0; t < 4; ++t) { const int pc = tid + 512 * t, sr = pc >> 4, d4 = (pc & 15) * 4;
            Ks[sr * 65 + d4] = kq[t][0]; Ks[sr * 65 + d4 + 1] = kq[t][1]; Ks[sr * 65 + d4 + 2] = kq[t][2]; Ks[sr * 65 + d4 + 3] = kq[t][3];
            *(LAS f32x4*)(Vs + sr * 64 + d4) = vq[t]; }
        Ks[(128 + (tid >> 6)) * 65 + (tid & 63)] = bf2f(kn); Vs[(128 + (tid >> 6)) * 64 + (tid & 63)] = bf2f(vn);
        *(LAS f32x4*)(Qs + qr_ * 64 + qd4) = (f32x4){bflo(qv.x), bfhi(qv.x), bflo(qv.y), bfhi(qv.y)};
    }
    __syncthreads();
    float linv[4];
#pragma unroll
    for (int rr = 0; rr < 4; ++rr) {
        const int r = 4 * w + rr, g = r >> 3, a = r & 7, hh = kvh * 4 + g;
        const float slope = exp2f(-0.5f * (float)(hh + 1)), sink = p.in[I_SINK][hh];
        float sc[3]; float m = sink;
#pragma unroll
        for (int t = 0; t < 3; ++t) {
            const int s = lane + 64 * t; sc[t] = -INFINITY;
            if (s < 136) {
                float dot = 0.f;
                for (int d = 0; d < 64; ++d) dot += Qs[r * 64 + d] * Ks[s * 65 + d];
                const int dist = 128 + a - s;
                if (dist >= 0 && dist <= 128) sc[t] = dot * 0.125f - slope * (float)dist;
            }
            m = fmaxf(m, sc[t]);
        }
        m = wave_max(m);
        float l = 0.f;
#pragma unroll
        for (int t = 0; t < 3; ++t) { const int s = lane + 64 * t; const float e = __expf(sc[t] - m); if (s < 136) { Ps[r * 136 + s] = e; l += e; } }
        l = wave_sum(l) + __expf(sink - m);
        linv[rr] = 1.0f / l;
    }
    __syncthreads();
#pragma unroll
    for (int rr = 0; rr < 4; ++rr) {
        const int r = 4 * w + rr, g = r >> 3, a = r & 7, hh = kvh * 4 + g;
        float o = 0.f;
        for (int s = 0; s < 136; ++s) o += Ps[r * 136 + s] * Vs[s * 64 + lane];
        OA[(size_t)(NP + n * 8 + a) * 1024 + hh * 64 + lane] = (bf16_t)(cvt_pk_bf16(o * linv[rr], 0.f) & 0xffffu);
    }
    __syncthreads();
}

__device__ __forceinline__ void sret_unit(const Params& p, LAS unsigned char* lds, int u) {
    const int tid = threadIdx.x, lane = tid & 63, w = tid >> 6;
    const int h = u & 7, n = u >> 3;
    const bf16_t* PROJ = (const bf16_t*)(p.ws + WS_PROJ);
    bf16_t* ORb = (bf16_t*)(p.ws + WS_OR);
    LAS float* qT = (LAS float*)lds;
    LAS float* kT = qT + 1024;
    LAS float* vS = kT + 1024;
    LAS float* SCP = vS + 2048;
    LAS float* PART = SCP + 512;
    const float l2g = log2_gamma(h);
    const float g8 = exp2f(8.0f * l2g), gm8 = exp2f(-8.0f * l2g);
    const size_t rbase = (size_t)(NP + n * 8);
    const int e4 = lane * 4;
    const float* S0 = p.in[I_ST] + ((size_t)(n * 8 + h) * 128) * 256 + e4;
    float* S1 = p.out + O_SRS + ((size_t)(n * 8 + h) * 128) * 256 + e4;
    f32x4 S[16];
#pragma unroll
    for (int it = 0; it < 16; ++it) S[it] = *(const f32x4*)(S0 + (size_t)(w + 8 * it) * 256);
    {
        bf16_t qv[2], kv[2];
#pragma unroll
        for (int t = 0; t < 2; ++t) { const int idx = tid + 512 * t, i = idx >> 7, d = idx & 127; const bf16_t* r = PROJ + (rbase + i) * DIN + h * 128 + d; qv[t] = r[C_QR]; kv[t] = r[C_KR]; }
        const u32x2 v2 = *(const u32x2*)(PROJ + (rbase + w) * DIN + C_VR + h * 256 + e4);
#pragma unroll
        for (int t = 0; t < 2; ++t) { const int idx = tid + 512 * t, i = idx >> 7, d = idx & 127;
            qT[d * 8 + i] = bf2f(qv[t]) * exp2f((float)(i + 1) * l2g); kT[d * 8 + i] = bf2f(kv[t]) * exp2f((float)(7 - i) * l2g); }
        *(LAS f32x4*)(vS + w * 256 + e4) = (f32x4){bflo(v2.x), bfhi(v2.x), bflo(v2.y), bfhi(v2.y)};
    }
    __syncthreads();
    {
        const int i = lane >> 3, j = lane & 7; float sc = 0.f;
#pragma unroll
        for (int dd = 0; dd < 16; ++dd) { const int d = 16 * w + dd; sc += qT[d * 8 + i] * kT[d * 8 + j]; }
        SCP[w * 64 + lane] = sc;
    }
    f32x4 vv[8], ya[8];
#pragma unroll
    for (int j = 0; j < 8; ++j) { vv[j] = *(const LAS f32x4*)(vS + j * 256 + e4); ya[j] = (f32x4){0.f, 0.f, 0.f, 0.f}; }
#pragma unroll
    for (int it = 0; it < 16; ++it) {
        const int d = w + 8 * it;
        const f32x4 qa = *(const LAS f32x4*)(qT + d * 8), qb = *(const LAS f32x4*)(qT + d * 8 + 4);
        const f32x4 ka = *(const LAS f32x4*)(kT + d * 8), kb = *(const LAS f32x4*)(kT + d * 8 + 4);
        f32x4 sn = S[it] * g8;
        sn += vv[0] * ka[0]; sn += vv[1] * ka[1]; sn += vv[2] * ka[2]; sn += vv[3] * ka[3];
        sn += vv[4] * kb[0]; sn += vv[5] * kb[1]; sn += vv[6] * kb[2]; sn += vv[7] * kb[3];
        *(f32x4*)(S1 + (size_t)d * 256) = sn;
        ya[0] += S[it] * qa[0]; ya[1] += S[it] * qa[1]; ya[2] += S[it] * qa[2]; ya[3] += S[it] * qa[3];
        ya[4] += S[it] * qb[0]; ya[5] += S[it] * qb[1]; ya[6] += S[it] * qb[2]; ya[7] += S[it] * qb[3];
    }
#pragma unroll
    for (int i = 0; i < 8; ++i) *(LAS f32x4*)(PART + (w * 8 + i) * 256 + e4) = ya[i];
    __syncthreads();
    {
        const int i = w;
        f32x4 y = {0.f, 0.f, 0.f, 0.f};
#pragma unroll
        for (int ww = 0; ww < 8; ++ww) y += *(const LAS f32x4*)(PART + (ww * 8 + i) * 256 + e4);
#pragma unroll
        for (int j = 0; j < 8; ++j) {
            float sc = 0.f;
#pragma unroll
            for (int ww = 0; ww < 8; ++ww) sc += SCP[ww * 64 + i * 8 + j];
            if (j <= i) y += vv[j] * (sc * gm8);
        }
        const float ss = wave_sum((y[0] * y[0] + y[1] * y[1]) + (y[2] * y[2] + y[3] * y[3]));
        const float rstd = rsqrtf(ss * (1.0f / 256.0f) + EPS);
        const u32x2 gv = *(const u32x2*)(PROJ + (rbase + i) * DIN + C_GR + h * 256 + e4);
        u32x2 wv; wv.x = cvt_pk_bf16(y[0] * rstd * bflo(gv.x), y[1] * rstd * bfhi(gv.x)); wv.y = cvt_pk_bf16(y[2] * rstd * bflo(gv.y), y[3] * rstd * bfhi(gv.y));
        *(u32x2*)(ORb + (rbase + i) * D + h * 256 + e4) = wv;
    }
    __syncthreads();
}

__device__ __forceinline__ void phase_mix1(const Params& p, LAS unsigned char* lds) {
    const int G = gridDim.x;
    for (int u = blockIdx.x; u < 512; u += G) kv_unit(p, lds, u);
    for (int u = blockIdx.x; u < 256; u += G) attn_unit(p, lds, u);
    for (int u = blockIdx.x; u < 512; u += G) sattn_unit(p, lds, u);
    for (int u = blockIdx.x; u < 1024; u += G) sret_unit(p, lds, u);
    const bf16_t* PROJ = (const bf16_t*)(p.ws + WS_PROJ);
    const int gt = blockIdx.x * 512 + threadIdx.x, NGT = G * 512;
    for (int i = gt; i < 2 * 65536 / 4; i += NGT) {
        const int which = i >> 14, r = i & 16383, bw = r >> 6, c4 = (r & 63) * 4, b = bw >> 7, wdx = bw & 127;
        const u32x2 v = *(const u32x2*)(PROJ + (size_t)(b * 4096 + 3968 + wdx) * DIN + (which ? C_VA : C_KA) + c4);
        *(f32x4*)(p.out + (which ? O_VWP : O_KWP) + (size_t)bw * 256 + c4) = (f32x4){bflo(v.x), bfhi(v.x), bflo(v.y), bfhi(v.y)};
    }
    for (int i0 = gt; i0 < 2 * 4194304 / 4; i0 += 4 * NGT) {
        f32x4 o[4];
#pragma unroll
        for (int t = 0; t < 4; ++t) {
            const int i = i0 + t * NGT;
            if (i < 2 * 4194304 / 4) {
                const int which = i >> 20, r = i & 1048575, nw = r >> 6, c4 = (r & 63) * 4, n = nw >> 7, wdx = nw & 127;
                if (wdx < 120) o[t] = *(const f32x4*)((which ? p.in[I_CV] : p.in[I_CK]) + ((size_t)(n * 128 + wdx + 8)) * 256 + c4);
                else { const u32x2 v = *(const u32x2*)(PROJ + (size_t)(NP + n * 8 + (wdx - 120)) * DIN + (which ? C_VA : C_KA) + c4); o[t] = (f32x4){bflo(v.x), bfhi(v.x), bflo(v.y), bfhi(v.y)}; }
            }
        }
#pragma unroll
        for (int t = 0; t < 4; ++t) {
            const int i = i0 + t * NGT;
            if (i < 2 * 4194304 / 4) { const int which = i >> 20, r = i & 1048575, nw = r >> 6, c4 = (r & 63) * 4; *(f32x4*)(p.out + (which ? O_VWS : O_KWS) + (size_t)nw * 256 + c4) = o[t]; }
        }
    }
}

__device__ __forceinline__ void phase_scan(const Params& p) {
    const float* KVT = (const float*)(p.ws + WS_F);
    bf16_t* SPT = (bf16_t*)(p.ws + WS_SPT);
    const int gt = blockIdx.x * 512 + threadIdx.x, NGT = gridDim.x * 512;
    for (int it = gt; it < 16 * 8192; it += NGT) {
        const int bh = it >> 13, rem = it & 8191, e = rem >> 5, d4 = (rem & 31) * 4, h = bh & 7;
        const float g128 = exp2f(128.0f * log2_gamma(h));
        f32x4 S = {0.f, 0.f, 0.f, 0.f};
        const size_t off = (size_t)e * 128 + d4;
        f32x4 kvr[32];
#pragma unroll
        for (int c = 0; c < 32; ++c) kvr[c] = *(const f32x4*)(KVT + (size_t)(bh * 32 + c) * 32768 + off);
#pragma unroll
        for (int c = 0; c < 32; ++c) {
            const size_t uo = (size_t)(bh * 32 + c) * 32768 + off;
            u32x2 wv; wv.x = cvt_pk_bf16(S[0], S[1]); wv.y = cvt_pk_bf16(S[2], S[3]);
            *(u32x2*)(SPT + uo) = wv;
            S = S * g128 + kvr[c];
        }
        float* so = p.out + O_SRP + (size_t)bh * 32768 + e;
        so[(size_t)(d4 + 0) * 256] = S[0]; so[(size_t)(d4 + 1) * 256] = S[1]; so[(size_t)(d4 + 2) * 256] = S[2]; so[(size_t)(d4 + 3) * 256] = S[3];
    }
}

__device__ __forceinline__ void phase_ret3(const Params& p) {
    const int tid = threadIdx.x, lane = tid & 63, w = tid >> 6, fr = lane & 15, fq = lane >> 4;
    const bf16_t* PROJ = (const bf16_t*)(p.ws + WS_PROJ);
    bf16_t* ORb = (bf16_t*)(p.ws + WS_OR);
    for (int u = blockIdx.x; u < 512; u += gridDim.x) {
        const int c = u & 31, bh = u >> 5, h = bh & 7, b = bh >> 3;
        const int row0 = b * 4096 + c * 128, i0 = 16 * w, irow = row0 + i0 + fr;
        const float l2g = log2_gamma(h);
        const bf16_t* SPTu = (const bf16_t*)(p.ws + WS_SPT) + (size_t)u * 32768;
        const bf16_t* VTu = (const bf16_t*)(p.ws + WS_VT) + (size_t)u * 32768;
        bf16x8 Qf[4];
        { const bf16_t* qp = PROJ + (size_t)irow * DIN + C_QR + h * 128 + fq * 8;
#pragma unroll
          for (int kc = 0; kc < 4; ++kc) Qf[kc] = *(const bf16x8*)(qp + kc * 32); }
        f32x4 sa[8];
#pragma unroll
        for (int jt = 0; jt < 8; ++jt) {
            sa[jt] = (f32x4){0.f, 0.f, 0.f, 0.f};
            if (jt <= w) {
                const bf16_t* kp = PROJ + (size_t)(row0 + 16 * jt + fr) * DIN + C_KR + h * 128 + fq * 8;
#pragma unroll
                for (int kc = 0; kc < 4; ++kc) sa[jt] = mfma16(*(const bf16x8*)(kp + kc * 32), Qf[kc], sa[jt]);
            }
        }
        const int ii = i0 + fr;
#pragma unroll
        for (int jt = 0; jt < 8; ++jt)
#pragma unroll
            for (int jj = 0; jj < 4; ++jj) { const int dj = ii - (16 * jt + 4 * fq + jj); sa[jt][jj] = dj >= 0 ? sa[jt][jj] * exp2f((float)dj * l2g) : 0.f; }
        union { bf16x8 v; u32x4 q; } Pf[4];
#pragma unroll
        for (int cc = 0; cc < 4; ++cc) {
            Pf[cc].q.x = cvt_pk_bf16(sa[2 * cc][0], sa[2 * cc][1]); Pf[cc].q.y = cvt_pk_bf16(sa[2 * cc][2], sa[2 * cc][3]);
            Pf[cc].q.z = cvt_pk_bf16(sa[2 * cc + 1][0], sa[2 * cc + 1][1]); Pf[cc].q.w = cvt_pk_bf16(sa[2 * cc + 1][2], sa[2 * cc + 1][3]);
        }
        const float qw = exp2f((float)(ii + 1) * l2g);
        f32x4 y[16];
#pragma unroll
        for (int et = 0; et < 16; ++et) {
            f32x4 a = {0.f, 0.f, 0.f, 0.f};
            const bf16_t* sp = SPTu + (16 * et + fr) * 128 + fq * 8;
#pragma unroll
            for (int kc = 0; kc < 4; ++kc) a = mfma16(*(const bf16x8*)(sp + kc * 32), Qf[kc], a);
            a = a * qw;
            const bf16_t* vp = VTu + (16 * et + fr) * 128 + 4 * fq;
#pragma unroll
            for (int cc = 0; cc < 4; ++cc) {
                if (2 * cc <= w) {
                    union { bf16x8 v; u32x2 hh[2]; } af;
                    af.hh[0] = *(const u32x2*)(vp + 32 * cc); af.hh[1] = *(const u32x2*)(vp + 32 * cc + 16);
                    a = mfma16(af.v, Pf[cc].v, a);
                }
            }
            y[et] = a;
        }
        float ss = 0.f;
#pragma unroll
        for (int et = 0; et < 16; ++et) ss += (y[et][0] * y[et][0] + y[et][1] * y[et][1]) + (y[et][2] * y[et][2] + y[et][3] * y[et][3]);
        ss += __shfl_xor(ss, 16); ss += __shfl_xor(ss, 32);
        const float rstd = rsqrtf(ss * (1.0f / 256.0f) + EPS);
        const bf16_t* gp = PROJ + (size_t)irow * DIN + C_GR + h * 256 + 4 * fq;
        bf16_t* op = ORb + (size_t)irow * D + h * 256 + 4 * fq;
        u32x2 gvr[16];
#pragma unroll
        for (int et = 0; et < 16; ++et) gvr[et] = *(const u32x2*)(gp + 16 * et);
#pragma unroll
        for (int et = 0; et < 16; ++et) {
            const u32x2 gv = gvr[et];
            u32x2 wv; wv.x = cvt_pk_bf16(y[et][0] * rstd * bflo(gv.x), y[et][1] * rstd * bfhi(gv.x)); wv.y = cvt_pk_bf16(y[et][2] * rstd * bflo(gv.y), y[et][3] * rstd * bfhi(gv.y));
            *(u32x2*)(op + 16 * et) = wv;
        }
    }
}

#define XB_TMO      128
#define XB_XCNT(j)  (256  + 64 * (j))
#define XB_XSUB(j)  (1280 + 64 * (j))
#define XB_XGEN(j)  (2304 + 64 * (j))
#define XB_TOP      3328
#define XB_TOPGEN   3392
#define XCD_BAR_WORDS 3456
#define XB_SPIN_CAP (1u << 18)

__device__ __forceinline__ unsigned xb_ld(unsigned* p)              { return __hip_atomic_load(p, __ATOMIC_RELAXED, __HIP_MEMORY_SCOPE_AGENT); }
__device__ __forceinline__ unsigned xb_add(unsigned* p, unsigned v) { return __hip_atomic_fetch_add(p, v, __ATOMIC_RELAXED, __HIP_MEMORY_SCOPE_AGENT); }
__device__ __forceinline__ unsigned xb_xcc_id() { return (unsigned)__builtin_amdgcn_s_getreg((3 << 11) | 20) & 0xFu; }
#define XB_SPIN(cond, bar) do { unsigned _sp = 0; while (cond) { __builtin_amdgcn_s_sleep(1); \
    if ((++_sp & 255u) == 0u) { if (xb_ld(&(bar)[XB_TMO])) break; if (_sp > XB_SPIN_CAP) { atomicAdd(&(bar)[XB_TMO], 1u); break; } } } } while (0)

struct XcdBarrier {
    unsigned* bar; unsigned x;
    volatile LAS unsigned* st;
};

__device__ __forceinline__ XcdBarrier xcd_barrier_post(unsigned* bar, volatile LAS unsigned* st) {
    XcdBarrier b; b.bar = bar; b.x = xb_xcc_id(); b.st = st;
    if (threadIdx.x == 0) (void)xb_add(&bar[XB_XCNT(b.x)], 1u);
    return b;
}
__device__ __forceinline__ void xcd_barrier_complete(unsigned* bar, unsigned x, unsigned& nloc, unsigned& nx) {
    const unsigned G = gridDim.x * gridDim.y * gridDim.z;
    unsigned sum, cnt, mine, sp = 0u;
    for (;;) {
        sum = 0u; cnt = 0u; mine = 0u;
#pragma unroll
        for (unsigned j = 0; j < 16; ++j) { const unsigned c = xb_ld(&bar[XB_XCNT(j)]); sum += c; cnt += (c > 0u) ? 1u : 0u; mine = (j == x) ? c : mine; }
        if (sum == G) break;
        __builtin_amdgcn_s_sleep(1);
        if ((++sp & 255u) == 0u) { if (xb_ld(&bar[XB_TMO])) break; if (sp > XB_SPIN_CAP) { atomicAdd(&bar[XB_TMO], 1u); break; } }
    }
    nloc = mine > 0u ? mine : 1u; nx = cnt > 0u ? cnt : 1u;
}

__device__ __forceinline__ void xcd_barrier(const XcdBarrier& b) {
    asm volatile("s_waitcnt vmcnt(0)" ::: "memory");
    __syncthreads();
    if (threadIdx.x == 0) {
        unsigned* bar = b.bar;
        __builtin_amdgcn_s_waitcnt(0);
        unsigned nloc = b.st[0], nx = b.st[1];
        if (nloc == 0u) { xcd_barrier_complete(bar, b.x, nloc, nx); b.st[0] = nloc; b.st[1] = nx; }
        const unsigned old = xb_add(&bar[XB_XSUB(b.x)], 1u);
        const unsigned gen = old / nloc;
        if (old + 1u == (gen + 1u) * nloc) {
            __builtin_amdgcn_fence(__ATOMIC_RELEASE, "agent");
            asm volatile("s_waitcnt vmcnt(0)" ::: "memory");
            const unsigned og = xb_add(&bar[XB_TOP], 1u);
            const unsigned tg = og / nx;
            if (og + 1u == (tg + 1u) * nx) xb_add(&bar[XB_TOPGEN], 1u);
            else XB_SPIN(xb_ld(&bar[XB_TOPGEN]) == tg, bar);
            __builtin_amdgcn_fence(__ATOMIC_ACQUIRE, "agent");
            xb_add(&bar[XB_XGEN(b.x)], 1u);
            asm volatile("s_waitcnt vmcnt(0)" ::: "memory");
        } else {
            XB_SPIN(xb_ld(&bar[XB_XGEN(b.x)]) == gen, bar);
            __builtin_amdgcn_fence(__ATOMIC_ACQUIRE, "agent");
            asm volatile("s_waitcnt vmcnt(0)" ::: "memory");
        }
    }
    __syncthreads();
}


__device__ __forceinline__ void gemm_part(const Params& p, LAS unsigned char* lds, int which) {
    unsigned char* ws = p.ws;
    EpiPart E; E.P01 = (bf16_t*)(ws + WS_F); E.P23 = (bf16_t*)(ws + WS_PART23);
    const bf16_t* A; const bf16_t* Bt; int K;
    if (which == 1) { A = (const bf16_t*)(ws + WS_PROJ); Bt = (const bf16_t*)(ws + WS_WD1); K = DFF; }
    else if (which == 2) { A = (const bf16_t*)(ws + WS_HB); Bt = (const bf16_t*)(ws + WS_WO); K = D; }
    else { A = (const bf16_t*)(ws + WS_PROJ); Bt = (const bf16_t*)(ws + WS_WD2); K = DFF; }
    run_gemm(lds, A, Bt, MT, D, K, E, 4);
}
__device__ __forceinline__ void gemm_gu(const Params& p, LAS unsigned char* lds, int which) {
    unsigned char* ws = p.ws;
    EpiSwiGLU E; E.O = (bf16_t*)(ws + WS_PROJ);
    run_gemm(lds, (const bf16_t*)(ws + WS_HB), (const bf16_t*)(ws + (which == 0 ? WS_WGU1 : WS_WGU2)), MT, 2 * DFF, D, E);
}
__device__ __forceinline__ void gemm_win(const Params& p, LAS unsigned char* lds) {
    unsigned char* ws = p.ws;
    EpiWin E; E.O = (bf16_t*)(ws + WS_PROJ); E.rc = (const float*)(ws + WS_ROTC); E.rs = (const float*)(ws + WS_ROTS);
    run_gemm(lds, (const bf16_t*)(ws + WS_HB), (const bf16_t*)(ws + WS_WIN), MT, DIN, D, E);
}
__device__ __forceinline__ void gemm_papr(const Params& p, LAS unsigned char* lds) {
    unsigned char* ws = p.ws;
    EpiPa E1; E1.T = (float*)(ws + WS_F); E1.P = (const bf16_t*)(ws + WS_PROJ);
    run_gemm(lds, (const bf16_t*)(ws + WS_OA), (const bf16_t*)(ws + WS_WPA), MT, D, 1024, E1);
    EpiPr E2; E2.T = (const float*)(ws + WS_F); E2.P = (const bf16_t*)(ws + WS_PROJ); E2.O = (bf16_t*)(ws + WS_HB);
    run_gemm(lds, (const bf16_t*)(ws + WS_OR), (const bf16_t*)(ws + WS_WPR), MT, D, D, E2);
}

#ifndef XSYNC
#define XSYNC 0
#endif
#ifndef DUPMASK
#define DUPMASK 0
#endif
#ifndef PHMASK
#define PHMASK 0xFFFF
#endif
#define PHASE(k, body) if (((PHMASK >> (k)) & 1) && p.ph_lo <= (k) && (k) < p.ph_hi) { if ((k) > p.ph_lo) { xcd_barrier(xb); for (int _x = 0; _x < XSYNC; ++_x) xcd_barrier(xb); } body; if ((DUPMASK >> (k)) & 1) { xcd_barrier(xb); body; } }
__global__ __launch_bounds__(512, 2) void mega(Params p) {
    extern __shared__ __attribute__((aligned(16))) unsigned char shm[];
    LAS unsigned char* lds = (LAS unsigned char*)shm;
    cg::grid_group grid = cg::this_grid();
    if (p.ph_lo < 0) grid.sync();
    volatile LAS unsigned* xst = (volatile LAS unsigned*)(lds + LDS_BYTES - 16);
    if (threadIdx.x == 0) { xst[0] = 0u; xst[1] = 0u; }
    __syncthreads();
    const XcdBarrier xb = xcd_barrier_post((unsigned*)p.ws, xst);
    PHASE(PH_PREP, phase_prep(p, lds))
    PHASE(PH_ADA, phase_ada(p, lds))
    PHASE(PH_ROW0, phase_row<0>(p))
    PHASE(PH_GU1, (gemm_gu(p, lds, 0), tail_tjobs(p, lds, 36 * 44, 2, 3), tail_tjobs(p, lds, 36 * 44, 7, 8)))
    PHASE(PH_D1, (gemm_part(p, lds, 1), tail_tjobs(p, lds, 36 * 8 * 4, 4, 7), tail_tjobs(p, lds, 36 * 8 * 4, 3, 4, 8832)))
    PHASE(PH_ROW1, phase_row<1>(p))
    PHASE(PH_WIN, (gemm_win(p, lds), tail_tjobs(p, lds, 36 * 46, 8, 9)))
    PHASE(PH_MIX1, phase_mix1(p, lds))
    PHASE(PH_SCAN, phase_scan(p))
    PHASE(PH_RET3, phase_ret3(p))
    PHASE(PH_PAPR, (gemm_papr(p, lds), tail_tjobs(p, lds, 36 * 8, 9, 10)))
    PHASE(PH_WO, gemm_part(p, lds, 2))
    PHASE(PH_ROW2, phase_row<2>(p))
    PHASE(PH_GU2, gemm_gu(p, lds, 1))
    PHASE(PH_D2, gemm_part(p, lds, 3))
    PHASE(PH_ROW3, phase_row<3>(p))
}

extern "C" void kernel_launch(void* const* d_in, const int* in_sizes, int n_in, void* d_out, int out_size, void* d_ws, size_t ws_size, hipStream_t stream) {
    static int grid = 0;
    if (grid == 0) {
        if (n_in != 22 || ws_size < WS_END) { fprintf(stderr, "kernel_launch: need 22 inputs and %zu bytes of workspace (got %d, %zu)\n", (size_t)WS_END, n_in, ws_size); grid = -1; return; }
        int dev = 0, cus = 0, per_cu = 0;
        (void)hipGetDevice(&dev);
        (void)hipDeviceGetAttribute(&cus, hipDeviceAttributeMultiprocessorCount, dev);
        if (hipFuncSetAttribute((const void*)mega, hipFuncAttributeMaxDynamicSharedMemorySize, LDS_BYTES) != hipSuccess) { fprintf(stderr, "kernel_launch: hipFuncSetAttribute failed\n"); grid = -1; return; }
        if (hipOccupancyMaxActiveBlocksPerMultiprocessor(&per_cu, (const void*)mega, 512, LDS_BYTES) != hipSuccess || per_cu < 1) { fprintf(stderr, "kernel_launch: occupancy query says %d\n", per_cu); per_cu = 1; }
        (void)hipGetLastError();
        grid = cus;
        if (grid <= 0) grid = 256;
    }
    if (grid < 0) return;
    if (hipMemsetAsync(d_ws, 0, XCD_BAR_WORDS * sizeof(unsigned), stream) != hipSuccess) { fprintf(stderr, "kernel_launch: memset of the barrier words failed\n"); return; }
    Params p{};
    for (int i = 0; i < 22; ++i) p.in[i] = (const float*)d_in[i];
    p.out = (float*)d_out; p.ws = (unsigned char*)d_ws;
#if MK_SPLIT
    for (int ph = 0; ph < NPH; ++ph) {
        p.ph_lo = ph; p.ph_hi = ph + 1;
        void* args[] = {&p};
        hipError_t e = hipLaunchCooperativeKernel((const void*)mega, dim3(grid), dim3(512), args, LDS_BYTES, stream);
        if (e != hipSuccess) { fprintf(stderr, "cooperative launch failed: %s (grid %d)\n", hipGetErrorString(e), grid); break; }
    }
#else
    p.ph_lo = 0; p.ph_hi = NPH;
    void* args[] = {&p};
    hipError_t e = hipLaunchCooperativeKernel((const void*)mega, dim3(grid), dim3(512), args, LDS_BYTES, stream);
    if (e != hipSuccess) fprintf(stderr, "cooperative launch failed: %s (grid %d)\n", hipGetErrorString(e), grid);
#endif
}
```

```cpp
#include <hip/hip_runtime.h>
#include <hip/hip_cooperative_groups.h>
#include <cstdio>
#include <cstdint>
namespace cg = cooperative_groups;

#ifndef MK_SPLIT
#define MK_SPLIT 0
#endif

namespace pg8 {
#define PG8_LAS __attribute__((address_space(3)))
typedef unsigned short bf16_t;
typedef short bf16x8 __attribute__((ext_vector_type(8)));
typedef float f32x4 __attribute__((ext_vector_type(4)));
typedef unsigned u32x4 __attribute__((ext_vector_type(4)));
typedef unsigned u32x2 __attribute__((ext_vector_type(2)));
constexpr int BM = 256, BK = 64, HALF = 128, HTB = HALF * BK * 2  , STAGE_BYTES = 8 * HTB, NXCD = 8, WGM = 8;

__host__ __device__ __forceinline__ int lds_byte(int r, int c) { const int st = (r >> 4) * 2 + (c >> 5), rr = r & 15, cc = c & 31, ob = rr * 64 + cc * 2; return st * 1024 + (ob ^ (((ob >> 9) & 1) << 5)); }
__host__ __device__ __forceinline__ void stage_rc(int b, int& R, int& C) { const int st = b / 1024, sb = b % 1024, swz = sb ^ (((sb >> 9) & 1) << 5); R = (st >> 1) * 16 + swz / 64; C = (st & 1) * 32 + (swz % 64) / 2; }
__host__ __device__ __forceinline__ int perm32(int rho) { const int n = rho >> 4, i = rho & 15; return 8 * (i >> 2) + 4 * n + (i & 3); }

struct Unit { int pm, pn, ks; };
struct Gemm { const bf16_t* A; const bf16_t* Bt; int M, N, K, ld; };

struct StaticOrder {
    int nM, nN, nwg, G, c, ns;
    __host__ __device__ void init(int M, int N, int G_, int c_, int ns_ = 1) { nM = M / BM; nN = N / BM; nwg = nM * nN; G = G_; c = c_; ns = ns_; }
    __host__ __device__ bool next(int i, Unit& u) const {
        const long L = (long)i * G + c; if (L >= (long)nwg * ns) return false;
        u.ks = (int)(L / nwg);
        int wgid = (int)(L - (long)u.ks * nwg); { const int q = nwg / NXCD, r = nwg % NXCD, xcd = wgid % NXCD, off = wgid / NXCD; wgid = (xcd < r ? xcd * (q + 1) : r * (q + 1) + (xcd - r) * q) + off; }
        const int nig = WGM * nN, gid = wgid / nig, fm = gid * WGM, gsz = (nM - fm) < WGM ? (nM - fm) : WGM;
        u.pm = fm + ((wgid % nig) % gsz); u.pn = (wgid % nig) / gsz; return true;
    }
    __device__ __forceinline__ void a_ready(const Unit&) const {}
    __device__ __forceinline__ void done(const Unit&) const {}
};

typedef float f32x2_cv __attribute__((ext_vector_type(2)));
typedef __bf16 bf16x2_cv __attribute__((ext_vector_type(2)));
__device__ __forceinline__ unsigned cvt_pk_bf16(float lo, float hi) { const f32x2_cv v = {lo, hi}; const bf16x2_cv b = __builtin_convertvector(v, bf16x2_cv); return __builtin_bit_cast(unsigned, b); }

template <class Epi, class Sched>
__device__ __forceinline__ void gemm_phase(PG8_LAS unsigned char* lds, const Gemm g, const Sched& S, const Epi& E) {
    int tid_ = threadIdx.x; asm volatile("" : "+v"(tid_));
    const int tid = tid_, wid = __builtin_amdgcn_readfirstlane(tid >> 6), lane = tid & 63, wr = wid >> 2, wc = wid & 3, fr = lane & 15, fq = lane >> 4;
    const int K = g.ld, nt = g.K / BK;
    unsigned voffA[2], voffB[2];
#pragma unroll
    for (int i = 0; i < 2; ++i) { int R, C; stage_rc(tid * 16 + i * 8192, R, C); const int Rb = Epi::PERM ? ((R & ~31) + perm32(R & 31)) : R;
        voffA[i] = (unsigned)(R * K + C) * 2u; voffB[i] = (unsigned)(Rb * K + C) * 2u; }
    const size_t kstep = (size_t)(BK * 2);
    const size_t hstep = (size_t)HALF * K * 2;
    const size_t tstep = 2 * hstep;
    const unsigned ldsw = (unsigned)wid * 1024u;
    const int aoff = lds_byte(wr * 64 + fr, fq * 8), boff = lds_byte(wc * 32 + fr, fq * 8);
#define PG8_SA(b, h) (((b) * 2 + (h)) * HTB)
#define PG8_SB(b, h) ((4 + (b) * 2 + (h)) * HTB)
#define PG8_STAGE(bufoff, gbase, voff) do { _Pragma("unroll") for (int _i = 0; _i < 2; ++_i) \
        __builtin_amdgcn_global_load_lds((const unsigned*)((const char*)(gbase) + (voff)[_i]), (PG8_LAS unsigned*)(lds + (bufoff) + ldsw + _i * 8192), 16, 0, 0); } while (0)
#define PG8_LDA(dst, b, h) do { _Pragma("unroll") for (int m = 0; m < 4; ++m) _Pragma("unroll") for (int k = 0; k < 2; ++k) dst[m][k] = *(const PG8_LAS bf16x8*)(lds + PG8_SA(b, h) + aoff + m * 2048 + k * 1024); } while (0)
#define PG8_LDB(dst, b, h) do { _Pragma("unroll") for (int n = 0; n < 2; ++n) _Pragma("unroll") for (int k = 0; k < 2; ++k) dst[n][k] = *(const PG8_LAS bf16x8*)(lds + PG8_SB(b, h) + boff + n * 2048 + k * 1024); } while (0)
#define PG8_MMA(ai, bj, At, Bt) do { __builtin_amdgcn_s_setprio(1); _Pragma("unroll") for (int m = 0; m < 4; ++m) _Pragma("unroll") for (int n = 0; n < 2; ++n) _Pragma("unroll") for (int k = 0; k < 2; ++k) \
        acc[ai][bj][m][n] = __builtin_amdgcn_mfma_f32_16x16x32_bf16(Bt[n][k], At[m][k], acc[ai][bj][m][n], 0, 0, 0); __builtin_amdgcn_s_setprio(0); } while (0)
#define PG8_WAIT_V(n) asm volatile("s_waitcnt vmcnt(" #n ")" ::: "memory")
#define PG8_WAIT_L(n) asm volatile("s_waitcnt lgkmcnt(" #n ")" ::: "memory")
#define PG8_BAR __builtin_amdgcn_s_barrier()
#define PG8_SCHED __builtin_amdgcn_sched_barrier(0)
    Unit cur, nxt; int ui = 0;
    if (!S.next(0, cur)) return;
    f32x4 acc[2][2][4][2];
#pragma unroll
    for (int a = 0; a < 2; ++a)
#pragma unroll
        for (int b = 0; b < 2; ++b)
#pragma unroll
            for (int m = 0; m < 4; ++m)
#pragma unroll
                for (int n = 0; n < 2; ++n) acc[a][b][m][n] = (f32x4){0.f, 0.f, 0.f, 0.f};
    bf16x8 At[4][2], B0[2][2], B1[2][2];
    const size_t ksb = (size_t)g.K * 2;
    const char* cA = (const char*)g.A + (size_t)cur.pm * tstep + (size_t)cur.ks * ksb; const char* cB = (const char*)g.Bt + (size_t)cur.pn * tstep + (size_t)cur.ks * ksb;
    S.a_ready(cur);
    PG8_STAGE(PG8_SB(0, 0), cB, voffB); PG8_STAGE(PG8_SB(0, 1), cB + hstep, voffB); PG8_STAGE(PG8_SA(0, 0), cA, voffA); PG8_STAGE(PG8_SA(0, 1), cA + hstep, voffA);
    if (wr == 1) PG8_BAR;
    PG8_WAIT_V(2); PG8_BAR;
    PG8_STAGE(PG8_SB(1, 0), cB + kstep, voffB); PG8_STAGE(PG8_SA(1, 0), cA + kstep, voffA); PG8_STAGE(PG8_SB(1, 1), cB + hstep + kstep, voffB);
    PG8_WAIT_V(6); PG8_BAR;
    for (;;) {
        const bool has_next = S.next(ui + 1, nxt);
        const char* nA = has_next ? (const char*)g.A + (size_t)nxt.pm * tstep + (size_t)nxt.ks * ksb : cA; const char* nB = has_next ? (const char*)g.Bt + (size_t)nxt.pn * tstep + (size_t)nxt.ks * ksb : cB;
        for (int t = 0; t < nt; t += 2) {
            const bool last = (t == nt - 2);
            const char* a1 = cA + (size_t)(t + 1) * kstep;
            const char* a2 = last ? nA : cA + (size_t)(t + 2) * kstep; const char* b2 = last ? nB : cB + (size_t)(t + 2) * kstep;
            const char* a3 = a2 + kstep; const char* b3 = b2 + kstep;
            if (last && has_next) S.a_ready(nxt);
            PG8_LDB(B0, 0, 0); PG8_LDB(B1, 0, 1); PG8_SCHED; PG8_LDA(At, 0, 0); PG8_STAGE(PG8_SA(1, 1), a1 + hstep, voffA);
            PG8_WAIT_V(8); PG8_WAIT_L(0); PG8_BAR; PG8_MMA(0, 0, At, B0); PG8_MMA(0, 1, At, B1); PG8_BAR; PG8_SCHED;
            PG8_LDA(At, 0, 1); PG8_STAGE(PG8_SB(0, 0), b2, voffB); PG8_STAGE(PG8_SB(0, 1), b2 + hstep, voffB); PG8_STAGE(PG8_SA(0, 0), a2, voffA);
            PG8_WAIT_V(8); PG8_WAIT_L(0); PG8_BAR; PG8_MMA(1, 0, At, B0); PG8_MMA(1, 1, At, B1); PG8_BAR; PG8_SCHED;
            PG8_LDB(B0, 1, 0); PG8_LDB(B1, 1, 1); PG8_SCHED; PG8_LDA(At, 1, 0); PG8_STAGE(PG8_SA(0, 1), a2 + hstep, voffA);
            PG8_WAIT_V(8); PG8_WAIT_L(0); PG8_BAR; PG8_MMA(0, 0, At, B0); PG8_MMA(0, 1, At, B1); PG8_BAR; PG8_SCHED;
            PG8_LDA(At, 1, 1); PG8_STAGE(PG8_SB(1, 0), b3, voffB); PG8_STAGE(PG8_SB(1, 1), b3 + hstep, voffB); PG8_STAGE(PG8_SA(1, 0), a3, voffA);
            PG8_WAIT_V(8); PG8_WAIT_L(0); PG8_BAR; PG8_MMA(1, 0, At, B0); PG8_MMA(1, 1, At, B1); PG8_BAR; PG8_SCHED;
        }
        if (wr == 0) PG8_BAR;
        if constexpr (!Epi::AFTER_DRAIN) { E(acc, cur, wr, wc, fr, fq); S.done(cur); }
        if (!has_next) break;
#pragma unroll
        for (int a = 0; a < 2; ++a)
#pragma unroll
            for (int b = 0; b < 2; ++b)
#pragma unroll
                for (int m = 0; m < 4; ++m)
#pragma unroll
                    for (int n = 0; n < 2; ++n) acc[a][b][m][n] = (f32x4){0.f, 0.f, 0.f, 0.f};
        cur = nxt; cA = nA; cB = nB; ++ui;
        if (wr == 1) PG8_BAR;
    }
    PG8_WAIT_V(0);
    PG8_BAR;
    if constexpr (Epi::AFTER_DRAIN) { E.fused(acc, cur, wr, wc, fr, fq, lds, wid, lane); S.done(cur); }
#undef PG8_SA
#undef PG8_SB
#undef PG8_STAGE
#undef PG8_LDA
#undef PG8_LDB
#undef PG8_MMA
#undef PG8_WAIT_V
#undef PG8_WAIT_L
#undef PG8_BAR
#undef PG8_SCHED
}
}

using pg8::bf16_t; using pg8::bf16x8; using pg8::f32x4; using pg8::u32x4; using pg8::u32x2; using pg8::cvt_pk_bf16;
#define LAS __attribute__((address_space(3)))
#define LDS_WAIT() asm volatile("s_waitcnt lgkmcnt(0)" ::: "memory")

constexpr int D = 2048, NP = 8192, NS = 1024, MT = 9216, DFF = 5632, DIN = 11776, NADA = 18432;
constexpr int C_QA = 0, C_KA = 1024, C_VA = 1280, C_QR = 1536, C_KR = 2560, C_VR = 3584, C_GR = 5632, C_GA = 7680, C_GB = 9728;
constexpr float EPS = 1e-6f;
constexpr int LDS_BYTES = 147456;
constexpr int NPH = 16;
enum { PH_PREP = 0, PH_ADA, PH_ROW0, PH_GU1, PH_D1, PH_ROW1, PH_WIN, PH_MIX1, PH_SCAN, PH_RET3, PH_PAPR, PH_WO, PH_ROW2, PH_GU2, PH_D2, PH_ROW3 };

constexpr size_t al256(size_t x) { return (x + 255) & ~(size_t)255; }
constexpr size_t SZ_WGU = (size_t)2 * DFF * D * 2, SZ_WD = (size_t)D * DFF * 2, SZ_WIN = (size_t)DIN * D * 2, SZ_WPA = (size_t)D * 1024 * 2, SZ_WPR = (size_t)D * D * 2, SZ_WO = (size_t)D * D * 2;
constexpr size_t WS_WGU1 = 16384;
constexpr size_t WS_WD1 = WS_WGU1 + SZ_WGU;
constexpr size_t WS_WIN = WS_WD1 + SZ_WD;
constexpr size_t WS_WPA = WS_WIN + SZ_WIN;
constexpr size_t WS_WPR = WS_WPA + SZ_WPA;
constexpr size_t WS_WO = WS_WPR + SZ_WPR;
constexpr size_t WS_WGU2 = WS_WO + SZ_WO;
constexpr size_t WS_WD2 = WS_WGU2 + SZ_WGU;
constexpr size_t WS_MOD = WS_WD2 + SZ_WD;
constexpr size_t WS_CS = WS_MOD + (size_t)256 * NADA * 4;
constexpr size_t WS_ROTC = WS_CS + (size_t)256 * D * 2;
constexpr size_t WS_ROTS = WS_ROTC + al256((size_t)4104 * 64 * 4);
constexpr size_t WS_HB = WS_ROTS + al256((size_t)4104 * 64 * 4);
constexpr size_t WS_F = WS_HB + (size_t)MT * D * 2;
constexpr size_t WS_PROJ = WS_F + (size_t)MT * D * 4;
constexpr size_t WS_PART23 = WS_PROJ + (size_t)MT * DFF * 2;
constexpr size_t WS_OA = WS_PROJ + (size_t)MT * DIN * 2;
constexpr size_t WS_OR = WS_OA + (size_t)MT * 1024 * 2;
constexpr size_t WS_SPT = WS_OR + (size_t)MT * D * 2;
constexpr size_t WS_VT = WS_SPT + (size_t)512 * 32768 * 2;
constexpr size_t WS_END = WS_VT + (size_t)512 * 32768 * 2;

constexpr size_t O_Y = 0, O_KWP = (size_t)MT * D, O_VWP = O_KWP + 65536, O_SRP = O_VWP + 65536, O_KWS = O_SRP + 524288, O_VWS = O_KWS + 4194304, O_SRS = O_VWS + 4194304;

struct Params {
    const float* in[22];
    float* out;
    unsigned char* ws;
    int ph_lo, ph_hi;
};
enum { I_XP = 0, I_XS, I_CK, I_CV, I_ST, I_CP, I_CSM, I_WADA, I_BADA, I_NPRE, I_NPOST, I_WIN, I_SINK, I_WPA, I_WPR, I_WO, I_F1G, I_F1U, I_F1D, I_F2G, I_F2U, I_F2D };

__device__ __forceinline__ float bf2f(unsigned short b) { return __uint_as_float(((unsigned)b) << 16); }
__device__ __forceinline__ float bflo(unsigned w) { return __uint_as_float(w << 16); }
__device__ __forceinline__ float bfhi(unsigned w) { return __uint_as_float(w & 0xffff0000u); }
__device__ __forceinline__ float wave_sum(float v) {
#pragma unroll
    for (int o = 1; o < 64; o <<= 1) v += __shfl_xor(v, o);
    return v;
}
__device__ __forceinline__ float wave_max(float v) {
#pragma unroll
    for (int o = 1; o < 64; o <<= 1) v = fmaxf(v, __shfl_xor(v, o));
    return v;
}
__device__ __forceinline__ float silu_f(float x) { return x * __builtin_amdgcn_rcpf(1.0f + __expf(-x)); }
__device__ __forceinline__ float sigm_f(float x) { return __builtin_amdgcn_rcpf(1.0f + __expf(-x)); }
__device__ __forceinline__ float log2_gamma(int h) { return log2f(1.0f - exp2f(-5.0f - (float)h)); }
__device__ __forceinline__ f32x4 mfma16(bf16x8 a, bf16x8 b, f32x4 c) { return __builtin_amdgcn_mfma_f32_16x16x32_bf16(a, b, c, 0, 0, 0); }

struct EpiF32 {
    static constexpr bool PERM = false, AFTER_DRAIN = false;
    float* C; int ldc; const float* bias;
    __device__ __forceinline__ void operator()(const f32x4 (&acc)[2][2][4][2], const pg8::Unit& u, int wr, int wc, int fr, int fq) const {
        const int row0 = u.pm * 256 + wr * 64 + fr, col0 = u.pn * 256 + wc * 32 + 4 * fq;
        f32x4 bv[2][2];
#pragma unroll
        for (int bj = 0; bj < 2; ++bj)
#pragma unroll
            for (int n = 0; n < 2; ++n) bv[bj][n] = bias ? *(const f32x4*)(bias + col0 + bj * 128 + n * 16) : (f32x4){0.f, 0.f, 0.f, 0.f};
#pragma unroll
        for (int ai = 0; ai < 2; ++ai)
#pragma unroll
            for (int m = 0; m < 4; ++m) { float* rowp = C + (size_t)(row0 + ai * 128 + m * 16) * ldc + col0;
#pragma unroll
                for (int bj = 0; bj < 2; ++bj)
#pragma unroll
                    for (int n = 0; n < 2; ++n) *(f32x4*)(rowp + bj * 128 + n * 16) = acc[ai][bj][m][n] + bv[bj][n]; }
    }
};
struct EpiPart {
    static constexpr bool PERM = true, AFTER_DRAIN = false;
    bf16_t* P01; bf16_t* P23;
    __device__ __forceinline__ void operator()(const f32x4 (&acc)[2][2][4][2], const pg8::Unit& u, int wr, int wc, int fr, int fq) const {
        bf16_t* O = (u.ks < 2 ? P01 : P23) + (size_t)(u.ks & 1) * MT * D;
        const int row0 = u.pm * 256 + wr * 64 + fr, col0 = u.pn * 256 + wc * 32 + 8 * fq;
#pragma unroll
        for (int ai = 0; ai < 2; ++ai)
#pragma unroll
            for (int m = 0; m < 4; ++m) {
                bf16_t* rowp = O + (size_t)(row0 + ai * 128 + m * 16) * D + col0;
#pragma unroll
                for (int bj = 0; bj < 2; ++bj) {
                    const f32x4 v0 = acc[ai][bj][m][0], v1 = acc[ai][bj][m][1];
                    u32x4 w; w.x = cvt_pk_bf16(v0[0], v0[1]); w.y = cvt_pk_bf16(v0[2], v0[3]); w.z = cvt_pk_bf16(v1[0], v1[1]); w.w = cvt_pk_bf16(v1[2], v1[3]);
                    *(u32x4*)(rowp + bj * 128) = w;
                }
            }
    }
};
struct EpiSwiGLU {
    static constexpr bool PERM = true, AFTER_DRAIN = false;
    bf16_t* O;
    __device__ __forceinline__ void operator()(const f32x4 (&acc)[2][2][4][2], const pg8::Unit& u, int wr, int wc, int fr, int fq) const {
        const int row0 = u.pm * 256 + wr * 64 + fr, col0 = u.pn * 128 + wc * 32 + 8 * fq;
#pragma unroll
        for (int ai = 0; ai < 2; ++ai)
#pragma unroll
            for (int m = 0; m < 4; ++m) {
                bf16_t* rowp = O + (size_t)(row0 + ai * 128 + m * 16) * DFF + col0;
                const f32x4 g0 = acc[ai][0][m][0], g1 = acc[ai][0][m][1], u0 = acc[ai][1][m][0], u1 = acc[ai][1][m][1];
                u32x4 w;
                w.x = cvt_pk_bf16(silu_f(g0[0]) * u0[0], silu_f(g0[1]) * u0[1]); w.y = cvt_pk_bf16(silu_f(g0[2]) * u0[2], silu_f(g0[3]) * u0[3]);
                w.z = cvt_pk_bf16(silu_f(g1[0]) * u1[0], silu_f(g1[1]) * u1[1]); w.w = cvt_pk_bf16(silu_f(g1[2]) * u1[2], silu_f(g1[3]) * u1[3]);
                *(u32x4*)rowp = w;
            }
    }
};
struct EpiWin {
    static constexpr bool PERM = true, AFTER_DRAIN = false;
    bf16_t* O; const float* rc; const float* rs;
    __device__ __forceinline__ void operator()(const f32x4 (&acc)[2][2][4][2], const pg8::Unit& u, int wr, int wc, int fr, int fq) const {
        const int pn = u.pn, row0 = u.pm * 256 + wr * 64 + fr;
        if (pn >= 6 && pn < 14) {
            const int slice = (pn - 6) >> 2, tt = (pn - 6) & 3, head = 2 * tt + (wc >> 1), d0 = 32 * (wc & 1) + 8 * fq;
            const int colbase = C_QR + slice * 1024 + head * 128 + d0;
            const float sc = slice ? 0.08838834764831845f : 1.0f;
#pragma unroll
            for (int ai = 0; ai < 2; ++ai)
#pragma unroll
                for (int m = 0; m < 4; ++m) {
                    const int row = row0 + ai * 128 + m * 16;
                    const int pidx = row < NP ? (row & 4095) : 4096 + ((row - NP) & 7);
                    const f32x4 c0 = *(const f32x4*)(rc + pidx * 64 + d0), c1 = *(const f32x4*)(rc + pidx * 64 + d0 + 4);
                    const f32x4 s0 = *(const f32x4*)(rs + pidx * 64 + d0), s1 = *(const f32x4*)(rs + pidx * 64 + d0 + 4);
                    const f32x4 a0 = acc[ai][0][m][0] * sc, a1 = acc[ai][0][m][1] * sc, b0 = acc[ai][1][m][0] * sc, b1 = acc[ai][1][m][1] * sc;
                    const f32x4 p0 = a0 * c0 - b0 * s0, p1 = a1 * c1 - b1 * s1, q0 = a0 * s0 + b0 * c0, q1 = a1 * s1 + b1 * c1;
                    u32x4 w1, w2;
                    w1.x = cvt_pk_bf16(p0[0], p0[1]); w1.y = cvt_pk_bf16(p0[2], p0[3]); w1.z = cvt_pk_bf16(p1[0], p1[1]); w1.w = cvt_pk_bf16(p1[2], p1[3]);
                    w2.x = cvt_pk_bf16(q0[0], q0[1]); w2.y = cvt_pk_bf16(q0[2], q0[3]); w2.z = cvt_pk_bf16(q1[0], q1[1]); w2.w = cvt_pk_bf16(q1[2], q1[3]);
                    bf16_t* rowp = O + (size_t)row * DIN + colbase;
                    *(u32x4*)rowp = w1; *(u32x4*)(rowp + 64) = w2;
                }
        } else {
            const int mode = pn < 22 ? 0 : (pn < 30 ? 1 : 2);
            const int col0 = pn * 256 + wc * 32 + 8 * fq;
#pragma unroll
            for (int ai = 0; ai < 2; ++ai)
#pragma unroll
                for (int m = 0; m < 4; ++m) {
                    bf16_t* rowp = O + (size_t)(row0 + ai * 128 + m * 16) * DIN + col0;
#pragma unroll
                    for (int bj = 0; bj < 2; ++bj) {
                        f32x4 v0 = acc[ai][bj][m][0], v1 = acc[ai][bj][m][1];
                        if (mode == 1) {
#pragma unroll
                            for (int j = 0; j < 4; ++j) { v0[j] = silu_f(v0[j]); v1[j] = silu_f(v1[j]); }
                        } else if (mode == 2) {
#pragma unroll
                            for (int j = 0; j < 4; ++j) { v0[j] = sigm_f(v0[j]); v1[j] = sigm_f(v1[j]); }
                        }
                        u32x4 w; w.x = cvt_pk_bf16(v0[0], v0[1]); w.y = cvt_pk_bf16(v0[2], v0[3]); w.z = cvt_pk_bf16(v1[0], v1[1]); w.w = cvt_pk_bf16(v1[2], v1[3]);
                        *(u32x4*)(rowp + bj * 128) = w;
                    }
                }
        }
    }
};
struct EpiPa {
    static constexpr bool PERM = true, AFTER_DRAIN = false;
    float* T; const bf16_t* P;
    __device__ __forceinline__ void operator()(const f32x4 (&acc)[2][2][4][2], const pg8::Unit& u, int wr, int wc, int fr, int fq) const {
        const int row0 = u.pm * 256 + wr * 64 + fr, col0 = u.pn * 256 + wc * 32 + 8 * fq;
#pragma unroll
        for (int ai = 0; ai < 2; ++ai) {
            u32x4 gq[4][2];
#pragma unroll
            for (int m = 0; m < 4; ++m)
#pragma unroll
                for (int bj = 0; bj < 2; ++bj) gq[m][bj] = *(const u32x4*)(P + (size_t)(row0 + ai * 128 + m * 16) * DIN + C_GA + col0 + bj * 128);
#pragma unroll
            for (int m = 0; m < 4; ++m) {
                const int row = row0 + ai * 128 + m * 16;
#pragma unroll
                for (int bj = 0; bj < 2; ++bj) {
                    const u32x4 g = gq[m][bj];
                    f32x4 v0 = acc[ai][bj][m][0], v1 = acc[ai][bj][m][1];
                    v0[0] *= bflo(g.x); v0[1] *= bfhi(g.x); v0[2] *= bflo(g.y); v0[3] *= bfhi(g.y);
                    v1[0] *= bflo(g.z); v1[1] *= bfhi(g.z); v1[2] *= bflo(g.w); v1[3] *= bfhi(g.w);
                    float* tp = T + (size_t)row * D + col0 + bj * 128;
                    *(f32x4*)tp = v0; *(f32x4*)(tp + 4) = v1;
                }
            }
        }
    }
};
struct EpiPr {
    static constexpr bool PERM = true, AFTER_DRAIN = false;
    const float* T; const bf16_t* P; bf16_t* O;
    __device__ __forceinline__ void operator()(const f32x4 (&acc)[2][2][4][2], const pg8::Unit& u, int wr, int wc, int fr, int fq) const {
        const int row0 = u.pm * 256 + wr * 64 + fr, col0 = u.pn * 256 + wc * 32 + 8 * fq;
#pragma unroll
        for (int ai = 0; ai < 2; ++ai)
#pragma unroll
            for (int mp = 0; mp < 2; ++mp) {
                u32x4 gq[2][2]; f32x4 t0[2][2], t1[2][2];
#pragma unroll
                for (int mi = 0; mi < 2; ++mi)
#pragma unroll
                    for (int bj = 0; bj < 2; ++bj) {
                        const int row = row0 + ai * 128 + (2 * mp + mi) * 16;
                        gq[mi][bj] = *(const u32x4*)(P + (size_t)row * DIN + C_GB + col0 + bj * 128);
                        const float* tp = T + (size_t)row * D + col0 + bj * 128;
                        t0[mi][bj] = *(const f32x4*)tp; t1[mi][bj] = *(const f32x4*)(tp + 4);
                    }
#pragma unroll
                for (int mi = 0; mi < 2; ++mi)
#pragma unroll
                    for (int bj = 0; bj < 2; ++bj) {
                        const int m = 2 * mp + mi, row = row0 + ai * 128 + m * 16;
                        const u32x4 g = gq[mi][bj]; const f32x4 a0 = t0[mi][bj], a1 = t1[mi][bj];
                        f32x4 v0 = acc[ai][bj][m][0], v1 = acc[ai][bj][m][1];
                        v0[0] = a0[0] + v0[0] * bflo(g.x); v0[1] = a0[1] + v0[1] * bfhi(g.x); v0[2] = a0[2] + v0[2] * bflo(g.y); v0[3] = a0[3] + v0[3] * bfhi(g.y);
                        v1[0] = a1[0] + v1[0] * bflo(g.z); v1[1] = a1[1] + v1[1] * bfhi(g.z); v1[2] = a1[2] + v1[2] * bflo(g.w); v1[3] = a1[3] + v1[3] * bfhi(g.w);
                        u32x4 w; w.x = cvt_pk_bf16(v0[0], v0[1]); w.y = cvt_pk_bf16(v0[2], v0[3]); w.z = cvt_pk_bf16(v1[0], v1[1]); w.w = cvt_pk_bf16(v1[2], v1[3]);
                        *(u32x4*)(O + (size_t)row * D + col0 + bj * 128) = w;
                    }
            }
    }
};

template <class Epi>
__device__ __forceinline__ void run_gemm(LAS unsigned char* lds, const bf16_t* A, const bf16_t* Bt, int M, int N, int K, const Epi& E, int ns = 1) {
    pg8::Gemm g; g.A = A; g.Bt = Bt; g.M = M; g.N = N; g.K = K / ns; g.ld = K;
    pg8::StaticOrder S; S.init(M, N, (int)gridDim.x, (int)blockIdx.x, ns);
    pg8::gemm_phase<Epi, pg8::StaticOrder>(lds, g, S, E);
}

__device__ __forceinline__ void transpose_item(const float* __restrict__ W, int K, int N, bf16_t* WT, int k0, int n0, int drow, LAS float* scr, int lane) {
#pragma unroll 8
    for (int i = 0; i < 32; ++i) { const int kk = 2 * i + (lane >> 5); scr[kk * 33 + (lane & 31)] = W[(size_t)(k0 + kk) * N + n0 + (lane & 31)]; }
    LDS_WAIT();
    const int c = lane & 7;
#pragma unroll
    for (int j = 0; j < 4; ++j) { const int n = (lane >> 3) + 8 * j; const LAS float* s = scr + (8 * c) * 33 + n;
        u32x4 o; o.x = cvt_pk_bf16(s[0 * 33], s[1 * 33]); o.y = cvt_pk_bf16(s[2 * 33], s[3 * 33]); o.z = cvt_pk_bf16(s[4 * 33], s[5 * 33]); o.w = cvt_pk_bf16(s[6 * 33], s[7 * 33]);
        *(u32x4*)(WT + (size_t)(drow + n) * K + k0 + 8 * c) = o; }
    LDS_WAIT();
}
__device__ __forceinline__ int map_gu(int n0, int up) { return 256 * (n0 >> 7) + (n0 & 127) + (up ? 128 : 0); }
__device__ __forceinline__ int map_win(int n0) {
    if (n0 < C_QR || n0 >= C_VR) return n0;
    const int s = n0 - C_QR, slice = s >> 10, within = s & 1023, h = within >> 7, half = (within >> 6) & 1, d0 = within & 63;
    return C_QR + slice * 1024 + (h >> 1) * 256 + half * 128 + (h & 1) * 64 + d0;
}
__device__ __forceinline__ int tjob_items(int j) {
    return (j == 0 || j == 1 || j == 7 || j == 8) ? (D / 64) * (DFF / 32) : (j == 2 || j == 9) ? (DFF / 64) * (D / 32) : j == 3 ? (D / 64) * (DIN / 32) : j == 4 ? (1024 / 64) * (D / 32) : (D / 64) * (D / 32);
}
__device__ __forceinline__ void run_tjobs(const Params& p, LAS unsigned char* lds, int jlo, int jhi, int widx, int nw, int skip = 0, int limit = 0x7fffffff) {
    const int lane = threadIdx.x & 63, wave = threadIdx.x >> 6;
    LAS float* scr = (LAS float*)(lds + wave * 8704);
    unsigned char* ws = p.ws;
    int total = 0;
    for (int j = jlo; j < jhi; ++j) total += tjob_items(j);
    if (total > skip + limit) total = skip + limit;
    struct TItem { const float* W; bf16_t* WT; int K, N, k0, n0, drow; };
    auto decode = [&](int it) {
        int r = it, j = jlo;
        while (r >= tjob_items(j)) { r -= tjob_items(j); ++j; }
        TItem t; int kind;
        switch (j) {
        case 0: t.W = p.in[I_F1G]; t.K = D; t.N = DFF; t.WT = (bf16_t*)(ws + WS_WGU1); kind = 1; break;
        case 1: t.W = p.in[I_F1U]; t.K = D; t.N = DFF; t.WT = (bf16_t*)(ws + WS_WGU1); kind = 2; break;
        case 2: t.W = p.in[I_F1D]; t.K = DFF; t.N = D; t.WT = (bf16_t*)(ws + WS_WD1); kind = 0; break;
        case 3: t.W = p.in[I_WIN]; t.K = D; t.N = DIN; t.WT = (bf16_t*)(ws + WS_WIN); kind = 3; break;
        case 4: t.W = p.in[I_WPA]; t.K = 1024; t.N = D; t.WT = (bf16_t*)(ws + WS_WPA); kind = 0; break;
        case 5: t.W = p.in[I_WPR]; t.K = D; t.N = D; t.WT = (bf16_t*)(ws + WS_WPR); kind = 0; break;
        case 6: t.W = p.in[I_WO]; t.K = D; t.N = D; t.WT = (bf16_t*)(ws + WS_WO); kind = 0; break;
        case 7: t.W = p.in[I_F2G]; t.K = D; t.N = DFF; t.WT = (bf16_t*)(ws + WS_WGU2); kind = 1; break;
        case 8: t.W = p.in[I_F2U]; t.K = D; t.N = DFF; t.WT = (bf16_t*)(ws + WS_WGU2); kind = 2; break;
        default: t.W = p.in[I_F2D]; t.K = DFF; t.N = D; t.WT = (bf16_t*)(ws + WS_WD2); kind = 0; break;
        }
        const int nblk = t.N / 32, kb = r / nblk, nb = r - kb * nblk;
        t.k0 = 64 * kb; t.n0 = 32 * nb;
        t.drow = kind == 0 ? t.n0 : (kind == 3 ? map_win(t.n0) : map_gu(t.n0, kind == 2));
        return t;
    };
    int it = skip + widx;
    if (it >= total) return;
    TItem cur = decode(it);
    float tv[32];
#pragma unroll
    for (int i = 0; i < 32; ++i) { const int kk = 2 * i + (lane >> 5); tv[i] = cur.W[(size_t)(cur.k0 + kk) * cur.N + cur.n0 + (lane & 31)]; }
    for (;;) {
        const int nit = it + nw; const bool more = nit < total;
        TItem nxt = cur; float tn[32];
        if (more) {
            nxt = decode(nit);
#pragma unroll
            for (int i = 0; i < 32; ++i) { const int kk = 2 * i + (lane >> 5); tn[i] = nxt.W[(size_t)(nxt.k0 + kk) * nxt.N + nxt.n0 + (lane & 31)]; }
        }
#pragma unroll
        for (int i = 0; i < 32; ++i) { const int kk = 2 * i + (lane >> 5); scr[kk * 33 + (lane & 31)] = tv[i]; }
        LDS_WAIT();
        {
            const int c = lane & 7;
#pragma unroll
            for (int j = 0; j < 4; ++j) { const int n = (lane >> 3) + 8 * j; const LAS float* s = scr + (8 * c) * 33 + n;
                u32x4 o; o.x = cvt_pk_bf16(s[0 * 33], s[1 * 33]); o.y = cvt_pk_bf16(s[2 * 33], s[3 * 33]); o.z = cvt_pk_bf16(s[4 * 33], s[5 * 33]); o.w = cvt_pk_bf16(s[6 * 33], s[7 * 33]);
                *(u32x4*)(cur.WT + (size_t)(cur.drow + n) * cur.K + cur.k0 + 8 * c) = o; }
        }
        LDS_WAIT();
        if (!more) break;
        cur = nxt; it = nit;
#pragma unroll
        for (int i = 0; i < 32; ++i) tv[i] = tn[i];
    }
}
__device__ __forceinline__ void tail_tjobs(const Params& p, LAS unsigned char* lds, int nunits, int jlo, int jhi, int skip = 0, int limit = 0x7fffffff) {
    const int G = gridDim.x, rem = nunits % G, c = blockIdx.x;
    if (rem == 0) { run_tjobs(p, lds, jlo, jhi, c * 8 + (threadIdx.x >> 6), G * 8, skip, limit); return; }
    if (c >= rem) run_tjobs(p, lds, jlo, jhi, (c - rem) * 8 + (threadIdx.x >> 6), (G - rem) * 8, skip, limit);
}
__device__ __forceinline__ void phase_prep(const Params& p, LAS unsigned char* lds) {
    const int tid = threadIdx.x, wave = tid >> 6;
    unsigned char* ws = p.ws;
    const int gt = blockIdx.x * 512 + tid, NGT = gridDim.x * 512;
    bf16_t* CS = (bf16_t*)(ws + WS_CS);
    for (int i = gt; i < 256 * D / 4; i += NGT) {
        const int r = i >> 9, k = (i & 511) * 4;
        u32x2 w = {0u, 0u};
        if (r < 130) {
            const float* c = r < 2 ? p.in[I_CP] + (size_t)r * D : p.in[I_CSM] + (size_t)(r - 2) * D;
            const f32x4 v = *(const f32x4*)(c + k);
            w.x = cvt_pk_bf16(silu_f(v[0]), silu_f(v[1])); w.y = cvt_pk_bf16(silu_f(v[2]), silu_f(v[3]));
        }
        *(u32x2*)(CS + (size_t)r * D + k) = w;
    }
    float* rc = (float*)(ws + WS_ROTC); float* rs = (float*)(ws + WS_ROTS);
    for (int i = gt; i < 4104 * 64; i += NGT) {
        const int pi = i >> 6, d = i & 63;
        const float pos = pi < 4096 ? (float)pi : (float)(16384 + (pi - 4096));
        const float inv = (float)exp(-((double)d / 63.0) * 9.210340371976184);
        const float ang = pos * inv;
        double rev = (double)ang * 0.15915494309189535; rev -= rint(rev);
        const float rf = (float)rev;
        rc[i] = __builtin_amdgcn_cosf(rf); rs[i] = __builtin_amdgcn_sinf(rf);
    }
    run_tjobs(p, lds, 0, 2, blockIdx.x * 8 + wave, gridDim.x * 8);
}
__device__ __forceinline__ void phase_ada(const Params& p, LAS unsigned char* lds) {
    const int tid = threadIdx.x, lane = tid & 63, wave = tid >> 6, fr = lane & 15, fq = lane >> 4;
    const int gw = blockIdx.x * 8 + wave, NGW = gridDim.x * 8;
    constexpr int NT = NADA / 16;
    const int nblk_ada = (NT + 7) / 8;
    if ((int)blockIdx.x >= nblk_ada) { run_tjobs(p, lds, 3, 4, (blockIdx.x - nblk_ada) * 8 + wave, ((int)gridDim.x - nblk_ada) * 8, 0, 8832); return; }
    const bf16_t* CS = (const bf16_t*)(p.ws + WS_CS);
    float* MOD = (float*)(p.ws + WS_MOD);
    const float* W = p.in[I_WADA];
    LAS bf16_t* As = (LAS bf16_t*)lds;
    {
        const int t = gw;
        const int n = 16 * (t < NT ? t : NT - 1) + fr;
        f32x4 acc[9];
#pragma unroll
        for (int mt = 0; mt < 9; ++mt) acc[mt] = (f32x4){0.f, 0.f, 0.f, 0.f};
#define ADA_LOAD(wv, g8_) do { const float* wp_ = W + (size_t)(256 * (g8_) + 8 * fq) * NADA + n; \
        _Pragma("unroll") for (int c = 0; c < 8; ++c) _Pragma("unroll") for (int i = 0; i < 8; ++i) wv[c][i] = wp_[(size_t)(32 * c + i) * NADA]; } while (0)
#define ADA_GROUP(wv, g8_) do { \
        u32x4 av_[9]; \
        _Pragma("unroll") for (int tt = 0; tt < 9; ++tt) { const int pc = tid + 512 * tt, r = pc >> 5, c8 = (pc & 31) * 8; av_[tt] = *(const u32x4*)(CS + (size_t)r * D + 256 * (g8_) + c8); } \
        __syncthreads(); \
        _Pragma("unroll") for (int tt = 0; tt < 9; ++tt) { const int pc = tid + 512 * tt, r = pc >> 5, c8 = (pc & 31) * 8; *(LAS u32x4*)(As + r * 264 + c8) = av_[tt]; } \
        __syncthreads(); \
        _Pragma("unroll") for (int c = 0; c < 8; ++c) { \
            union { bf16x8 v; u32x4 q; } bf; \
            bf.q.x = cvt_pk_bf16(wv[c][0], wv[c][1]); bf.q.y = cvt_pk_bf16(wv[c][2], wv[c][3]); bf.q.z = cvt_pk_bf16(wv[c][4], wv[c][5]); bf.q.w = cvt_pk_bf16(wv[c][6], wv[c][7]); \
            const LAS bf16_t* ap = As + fr * 264 + 32 * c + 8 * fq; \
            _Pragma("unroll") for (int mt = 0; mt < 9; ++mt) acc[mt] = mfma16(*(const LAS bf16x8*)(ap + (16 * mt) * 264), bf.v, acc[mt]); } } while (0)
        float wa[8][8], wb[8][8];
        ADA_LOAD(wa, 0);
#pragma unroll 1
        for (int g8 = 0; g8 < 8; g8 += 2) {
            ADA_LOAD(wb, g8 + 1);
            ADA_GROUP(wa, g8);
            if (g8 + 2 < 8) ADA_LOAD(wa, g8 + 2);
            ADA_GROUP(wb, g8 + 1);
        }
#undef ADA_LOAD
#undef ADA_GROUP
        const int sec = n >> 11, i3 = sec / 3, j3 = sec - 3 * i3, cc = n & 2047;
        const float bias = p.in[I_BADA][n];
        float mul = 1.0f, add = bias;
        if (j3 == 1) { mul = p.in[I_NPRE][i3 * D + cc]; add = bias + 1.0f; }
        else if (j3 == 2) mul = p.in[I_NPOST][i3 * D + cc] * (i3 == 1 ? 1.0f : 0.5f);
#pragma unroll
        for (int mt = 0; mt < 9; ++mt)
#pragma unroll
            for (int jj = 0; jj < 4; ++jj) { const int m = 16 * mt + 4 * fq + jj; if (m < 130 && t < NT) MOD[(size_t)m * NADA + n] = (acc[mt][jj] + add) * mul; }
    }
}

template <int KIND>
__device__ __forceinline__ void phase_row(const Params& p) {
    const int tid = threadIdx.x, lane = tid & 63, wave = tid >> 6;
    const int gw = blockIdx.x * 8 + wave, NGW = gridDim.x * 8;
    const float* MOD = (const float*)(p.ws + WS_MOD);
    const bf16_t* P01 = (const bf16_t*)(p.ws + WS_F);
    const bf16_t* P23 = (const bf16_t*)(p.ws + WS_PART23);
    bf16_t* HB = (bf16_t*)(p.ws + WS_HB);
    float* X = p.out;
#pragma unroll 1
    for (int row = gw; row < MT; row += NGW) {
        const int mrow = row < NP ? (row >> 12) : 2 + ((row - NP) >> 3);
        const float* mod = MOD + (size_t)mrow * NADA;
        const float* xin = row < NP ? p.in[I_XP] + (size_t)row * D : p.in[I_XS] + (size_t)(row - NP) * D;
        const float* xs = (KIND <= 1) ? xin : X + (size_t)row * D;
        f32x4 v[8], b1[8], b2[8];
#pragma unroll
        for (int j = 0; j < 8; ++j) v[j] = *(const f32x4*)(xs + 4 * (lane + 64 * j));
        __builtin_amdgcn_sched_barrier(0);
        if (KIND == 0) {
#pragma unroll
            for (int j = 0; j < 8; ++j) { b1[j] = *(const f32x4*)(mod + (KIND * 3 + 1) * D + 4 * (lane + 64 * j)); b2[j] = *(const f32x4*)(mod + (KIND * 3) * D + 4 * (lane + 64 * j)); }
        }
        if (KIND > 0) {
            u32x2 pr[4][8]; f32x4 a1[8];
#pragma unroll
            for (int j = 0; j < 8; ++j) {
                const size_t o = (size_t)row * D + 4 * (lane + 64 * j);
                pr[0][j] = *(const u32x2*)(P01 + o); pr[1][j] = *(const u32x2*)(P01 + (size_t)MT * D + o);
                pr[2][j] = *(const u32x2*)(P23 + o); pr[3][j] = *(const u32x2*)(P23 + (size_t)MT * D + o);
                a1[j] = *(const f32x4*)(mod + ((KIND - 1) * 3 + 2) * D + 4 * (lane + 64 * j));
            }
            __builtin_amdgcn_sched_barrier(0);
            f32x4 f[8]; float ss = 0.f;
#pragma unroll
            for (int j = 0; j < 8; ++j) {
                f[j][0] = (bflo(pr[0][j].x) + bflo(pr[1][j].x)) + (bflo(pr[2][j].x) + bflo(pr[3][j].x));
                f[j][1] = (bfhi(pr[0][j].x) + bfhi(pr[1][j].x)) + (bfhi(pr[2][j].x) + bfhi(pr[3][j].x));
                f[j][2] = (bflo(pr[0][j].y) + bflo(pr[1][j].y)) + (bflo(pr[2][j].y) + bflo(pr[3][j].y));
                f[j][3] = (bfhi(pr[0][j].y) + bfhi(pr[1][j].y)) + (bfhi(pr[2][j].y) + bfhi(pr[3][j].y));
                ss += (f[j][0] * f[j][0] + f[j][1] * f[j][1]) + (f[j][2] * f[j][2] + f[j][3] * f[j][3]);
            }
            __builtin_amdgcn_sched_barrier(0);
            if (KIND < 3) {
#pragma unroll
                for (int j = 0; j < 8; ++j) { b1[j] = *(const f32x4*)(mod + (KIND * 3 + 1) * D + 4 * (lane + 64 * j)); b2[j] = *(const f32x4*)(mod + (KIND * 3) * D + 4 * (lane + 64 * j)); }
            }
            __builtin_amdgcn_sched_barrier(0);
            const float rstd = rsqrtf(wave_sum(ss) * (1.0f / D) + EPS);
#pragma unroll
            for (int j = 0; j < 8; ++j) {
                v[j] = v[j] + (f[j] * rstd) * a1[j];
                *(f32x4*)(X + (size_t)row * D + 4 * (lane + 64 * j)) = v[j];
            }
        }
        __builtin_amdgcn_sched_barrier(0);
        if (KIND < 3) {
            float ss = 0.f;
#pragma unroll
            for (int j = 0; j < 8; ++j) ss += (v[j][0] * v[j][0] + v[j][1] * v[j][1]) + (v[j][2] * v[j][2] + v[j][3] * v[j][3]);
            const float rstd = rsqrtf(wave_sum(ss) * (1.0f / D) + EPS);
#pragma unroll
            for (int j = 0; j < 8; ++j) {
                const f32x4 h = (v[j] * rstd) * b1[j] + b2[j];
                u32x2 w; w.x = cvt_pk_bf16(h[0], h[1]); w.y = cvt_pk_bf16(h[2], h[3]);
                *(u32x2*)(HB + (size_t)row * D + 4 * (lane + 64 * j)) = w;
            }
        }
    }
}

__device__ __forceinline__ void kv_unit(const Params& p, LAS unsigned char* lds, int u) {
    const int tid = threadIdx.x, lane = tid & 63, w = tid >> 6, fr = lane & 15, fq = lane >> 4;
    const int c = u & 31, bh = u >> 5, h = bh & 7, b = bh >> 3;
    const int row0 = b * 4096 + c * 128;
    const bf16_t* PROJ = (const bf16_t*)(p.ws + WS_PROJ);
    const bf16_t* Kg = PROJ + (size_t)row0 * DIN + C_KR + h * 128;
    const bf16_t* Vg = PROJ + (size_t)row0 * DIN + C_VR + h * 256;
    LAS bf16_t* Kt = (LAS bf16_t*)lds;
    LAS bf16_t* Vt = (LAS bf16_t*)(lds + 34816);
    const float l2g = log2_gamma(h);
    {
        const int j = tid & 127, cgp = tid >> 7;
        const float kw = exp2f((float)(127 - j) * l2g);
#pragma unroll
        for (int it = 0; it < 4; ++it) {
            const int ch = cgp + 4 * it;
            const u32x4 v = *(const u32x4*)(Kg + (size_t)j * DIN + ch * 8);
            const unsigned a0 = cvt_pk_bf16(bflo(v.x) * kw, bfhi(v.x) * kw), a1 = cvt_pk_bf16(bflo(v.y) * kw, bfhi(v.y) * kw), a2 = cvt_pk_bf16(bflo(v.z) * kw, bfhi(v.z) * kw), a3 = cvt_pk_bf16(bflo(v.w) * kw, bfhi(v.w) * kw);
            LAS bf16_t* dst = Kt + (ch * 8) * 136 + j;
            dst[0 * 136] = (bf16_t)a0; dst[1 * 136] = (bf16_t)(a0 >> 16); dst[2 * 136] = (bf16_t)a1; dst[3 * 136] = (bf16_t)(a1 >> 16);
            dst[4 * 136] = (bf16_t)a2; dst[5 * 136] = (bf16_t)(a2 >> 16); dst[6 * 136] = (bf16_t)a3; dst[7 * 136] = (bf16_t)(a3 >> 16);
        }
#pragma unroll
        for (int it = 0; it < 8; ++it) {
            const int ch = cgp + 4 * it;
            const u32x4 v = *(const u32x4*)(Vg + (size_t)j * DIN + ch * 8);
            LAS bf16_t* dst = Vt + (ch * 8) * 136 + j;
            dst[0 * 136] = (bf16_t)v.x; dst[1 * 136] = (bf16_t)(v.x >> 16); dst[2 * 136] = (bf16_t)v.y; dst[3 * 136] = (bf16_t)(v.y >> 16);
            dst[4 * 136] = (bf16_t)v.z; dst[5 * 136] = (bf16_t)(v.z >> 16); dst[6 * 136] = (bf16_t)v.w; dst[7 * 136] = (bf16_t)(v.w >> 16);
        }
    }
    __syncthreads();
    {
        bf16_t* VTg = (bf16_t*)(p.ws + WS_VT) + (size_t)u * 32768;
#pragma unroll
        for (int it = 0; it < 8; ++it) { const int piece = tid + 512 * it, e = piece >> 4, jc = piece & 15;
            *(u32x4*)(VTg + e * 128 + jc * 8) = *(const LAS u32x4*)(Vt + e * 136 + jc * 8); }
    }
    f32x4 acc[8][2];
#pragma unroll
    for (int mt = 0; mt < 8; ++mt) { acc[mt][0] = (f32x4){0.f, 0.f, 0.f, 0.f}; acc[mt][1] = (f32x4){0.f, 0.f, 0.f, 0.f}; }
#pragma unroll
    for (int kc = 0; kc < 4; ++kc) {
        const bf16x8 b0 = *(const LAS bf16x8*)(Vt + (32 * w + fr) * 136 + kc * 32 + fq * 8);
        const bf16x8 b1 = *(const LAS bf16x8*)(Vt + (32 * w + 16 + fr) * 136 + kc * 32 + fq * 8);
#pragma unroll
        for (int mt = 0; mt < 8; ++mt) {
            const bf16x8 a = *(const LAS bf16x8*)(Kt + (16 * mt + fr) * 136 + kc * 32 + fq * 8);
            acc[mt][0] = mfma16(a, b0, acc[mt][0]); acc[mt][1] = mfma16(a, b1, acc[mt][1]);
        }
    }
    float* KVT = (float*)(p.ws + WS_F) + (size_t)u * 32768;
#pragma unroll
    for (int nt = 0; nt < 2; ++nt)
#pragma unroll
        for (int mt = 0; mt < 8; ++mt) *(f32x4*)(KVT + (32 * w + 16 * nt + fr) * 128 + 16 * mt + 4 * fq) = acc[mt][nt];
    __syncthreads();
}

__device__ __forceinline__ void attn_unit(const Params& p, LAS unsigned char* lds, int u) {
    const int tid = threadIdx.x, lane = tid & 63, w = tid >> 6, fr = lane & 15, fq = lane >> 4;
    const int kvh = u & 3, qb = (u >> 2) & 31, b = u >> 7;
    const int rowq0 = b * 4096 + qb * 128, rowk0 = rowq0 - 128;
    const bf16_t* PROJ = (const bf16_t*)(p.ws + WS_PROJ);
    bf16_t* OA = (bf16_t*)(p.ws + WS_OA);
    LAS bf16_t* Vt = (LAS bf16_t*)lds;
    {
        const int s = tid & 255, hf = tid >> 8;
        const bool ok = (qb > 0) || (s >= 128);
#pragma unroll
        for (int it = 0; it < 4; ++it) {
            const int ch = hf * 4 + it;
            u32x4 v = {0u, 0u, 0u, 0u};
            if (ok) v = *(const u32x4*)(PROJ + (size_t)(rowk0 + s) * DIN + C_VA + kvh * 64 + ch * 8);
            LAS bf16_t* dst = Vt + (ch * 8) * 296 + s;
            dst[0 * 296] = (bf16_t)v.x; dst[1 * 296] = (bf16_t)(v.x >> 16); dst[2 * 296] = (bf16_t)v.y; dst[3 * 296] = (bf16_t)(v.y >> 16);
            dst[4 * 296] = (bf16_t)v.z; dst[5 * 296] = (bf16_t)(v.z >> 16); dst[6 * 296] = (bf16_t)v.w; dst[7 * 296] = (bf16_t)(v.w >> 16);
        }
        const int d = tid >> 3, k4 = (tid & 7) * 4;
        *(LAS u32x2*)(Vt + d * 296 + 256 + k4) = (u32x2){0u, 0u};
    }
    __syncthreads();
    const int g = w >> 1, hh = kvh * 4 + g;
    const float slope = exp2f(-0.5f * (float)(hh + 1));
    const float sink = p.in[I_SINK][hh];
#pragma unroll 1
    for (int qt = 0; qt < 4; ++qt) {
        const int a0 = (w & 1) * 64 + 16 * qt, a = a0 + fr, kt0 = a0 >> 4;
        const bf16_t* qp = PROJ + (size_t)(rowq0 + a) * DIN + C_QA + hh * 64 + fq * 8;
        const bf16x8 q0 = *(const bf16x8*)qp, q1 = *(const bf16x8*)(qp + 32);
        f32x4 s[10];
#pragma unroll
        for (int kt = 0; kt < 10; ++kt) {
            const int sidx = 16 * (kt0 + kt) + fr;
            int krow = rowk0 + sidx;
            if (sidx > 255) krow = rowq0;
            if (krow < 0) krow = 0;
            const bf16_t* kp = PROJ + (size_t)krow * DIN + C_KA + kvh * 64 + fq * 8;
            const bf16x8 k0 = *(const bf16x8*)kp, k1 = *(const bf16x8*)(kp + 32);
            f32x4 z = {0.f, 0.f, 0.f, 0.f};
            z = mfma16(k0, q0, z); s[kt] = mfma16(k1, q1, z);
        }
        float m = sink;
#pragma unroll
        for (int kt = 0; kt < 10; ++kt)
#pragma unroll
            for (int jj = 0; jj < 4; ++jj) {
                const int sidx = 16 * (kt0 + kt) + 4 * fq + jj, dist = 128 + a - sidx;
                const bool valid = dist >= 0 && dist <= 128 && (qb > 0 || sidx >= 128);
                const float sc = valid ? s[kt][jj] * 0.125f - slope * (float)dist : -INFINITY;
                s[kt][jj] = sc; m = fmaxf(m, sc);
            }
        m = fmaxf(m, __shfl_xor(m, 16)); m = fmaxf(m, __shfl_xor(m, 32));
        float l = 0.f;
#pragma unroll
        for (int kt = 0; kt < 10; ++kt)
#pragma unroll
            for (int jj = 0; jj < 4; ++jj) { const float e = __expf(s[kt][jj] - m); s[kt][jj] = e; l += e; }
        l += __shfl_xor(l, 16); l += __shfl_xor(l, 32);
        l += __expf(sink - m);
        f32x4 o[4];
#pragma unroll
        for (int dt = 0; dt < 4; ++dt) o[dt] = (f32x4){0.f, 0.f, 0.f, 0.f};
#pragma unroll
        for (int cc = 0; cc < 5; ++cc) {
            union { bf16x8 v; u32x4 w; } pf;
            pf.w.x = cvt_pk_bf16(s[2 * cc][0], s[2 * cc][1]); pf.w.y = cvt_pk_bf16(s[2 * cc][2], s[2 * cc][3]);
            pf.w.z = cvt_pk_bf16(s[2 * cc + 1][0], s[2 * cc + 1][1]); pf.w.w = cvt_pk_bf16(s[2 * cc + 1][2], s[2 * cc + 1][3]);
#pragma unroll
            for (int dt = 0; dt < 4; ++dt) {
                const LAS bf16_t* vp = Vt + (16 * dt + fr) * 296 + 16 * (kt0 + 2 * cc) + 4 * fq;
                union { bf16x8 v; u32x2 h[2]; } af;
                af.h[0] = *(const LAS u32x2*)vp; af.h[1] = *(const LAS u32x2*)(vp + 16);
                o[dt] = mfma16(af.v, pf.v, o[dt]);
            }
        }
        const float inv = 1.0f / l;
        bf16_t* op = OA + (size_t)(rowq0 + a) * 1024 + hh * 64 + 4 * fq;
#pragma unroll
        for (int dt = 0; dt < 4; ++dt) { u32x2 wv; wv.x = cvt_pk_bf16(o[dt][0] * inv, o[dt][1] * inv); wv.y = cvt_pk_bf16(o[dt][2] * inv, o[dt][3] * inv); *(u32x2*)(op + 16 * dt) = wv; }
    }
    __syncthreads();
}

__device__ __forceinline__ void sattn_unit(const Params& p, LAS unsigned char* lds, int u) {
    const int tid = threadIdx.x, lane = tid & 63, w = tid >> 6;
    const int kvh = u & 3, n = u >> 2;
    const bf16_t* PROJ = (const bf16_t*)(p.ws + WS_PROJ);
    bf16_t* OA = (bf16_t*)(p.ws + WS_OA);
    LAS float* Ks = (LAS float*)lds;
    LAS float* Vs = Ks + 136 * 65;
    LAS float* Qs = Vs + 136 * 64;
    LAS float* Ps = Qs + 2048;
    const float* ck = p.in[I_CK]; const float* cv = p.in[I_CV];
    {
        f32x4 kq[4], vq[4];
#pragma unroll
        for (int t = 0; t < 4; ++t) { const int pc = tid + 512 * t, sr = pc >> 4, d4 = (pc & 15) * 4; const size_t o = ((size_t)(n * 128 + sr)) * 256 + kvh * 64 + d4;
            kq[t] = *(const f32x4*)(ck + o); vq[t] = *(const f32x4*)(cv + o); }
        const bf16_t* rn = PROJ + (size_t)(NP + n * 8 + (tid >> 6)) * DIN + kvh * 64 + (tid & 63);
        const bf16_t kn = rn[C_KA], vn = rn[C_VA];
        const int qr_ = tid >> 4, qd4 = (tid & 15) * 4, qg = qr_ >> 3, qa = qr_ & 7;
        const u32x2 qv = *(const u32x2*)(PROJ + (size_t)(NP + n * 8 + qa) * DIN + C_QA + (kvh * 4 + qg) * 64 + qd4);
#pragma unroll
        for (int t = 0; t < 4; ++t) { const int pc = tid + 512 * t, sr = pc >> 4, d4 = (pc & 15) * 4;
            Ks[sr * 65 + d4] = kq[t][0]; Ks[sr * 65 + d4 + 1] = kq[t][1]; Ks[sr * 65 + d4 + 2] = kq[t][2]; Ks[sr * 65 + d4 + 3] = kq[t][3];
            *(LAS f32x4*)(Vs + sr * 64 + d4) = vq[t]; }
        Ks[(128 + (tid >> 6)) * 65 + (tid & 63)] = bf2f(kn); Vs[(128 + (tid >> 6)) * 64 + (tid & 63)] = bf2f(vn);
        *(LAS f32x4*)(Qs + qr_ * 64 + qd4) = (f32x4){bflo(qv.x), bfhi(qv.x), bflo(qv.y), bfhi(qv.y)};
    }
    __syncthreads();
    float linv[4];
#pragma unroll
    for (int rr = 0; rr < 4; ++rr) {
        const int r = 4 * w + rr, g = r >> 3, a = r & 7, hh = kvh * 4 + g;
        const float slope = exp2f(-0.5f * (float)(hh + 1)), sink = p.in[I_SINK][hh];
        float sc[3]; float m = sink;
#pragma unroll
        for (int t = 0; t < 3; ++t) {
            const int s = lane + 64 * t; sc[t] = -INFINITY;
            if (s < 136) {
                float dot = 0.f;
                for (int d = 0; d < 64; ++d) dot += Qs[r * 64 + d] * Ks[s * 65 + d];
                const int dist = 128 + a - s;
                if (dist >= 0 && dist <= 128) sc[t] = dot * 0.125f - slope * (float)dist;
            }
            m = fmaxf(m, sc[t]);
        }
        m = wave_max(m);
        float l = 0.f;
#pragma unroll
        for (int t = 0; t < 3; ++t) { const int s = lane + 64 * t; const float e = __expf(sc[t] - m); if (s < 136) { Ps[r * 136 + s] = e; l += e; } }
        l = wave_sum(l) + __expf(sink - m);
        linv[rr] = 1.0f / l;
    }
    __syncthreads();
#pragma unroll
    for (int rr = 0; rr < 4; ++rr) {
        const int r = 4 * w + rr, g = r >> 3, a = r & 7, hh = kvh * 4 + g;
        float o = 0.f;
        for (int s = 0; s < 136; ++s) o += Ps[r * 136 + s] * Vs[s * 64 + lane];
        OA[(size_t)(NP + n * 8 + a) * 1024 + hh * 64 + lane] = (bf16_t)(cvt_pk_bf16(o * linv[rr], 0.f) & 0xffffu);
    }
    __syncthreads();
}

__device__ __forceinline__ void sret_unit(const Params& p, LAS unsigned char* lds, int u) {
    const int tid = threadIdx.x, lane = tid & 63, w = tid >> 6;
    const int h = u & 7, n = u >> 3;
    const bf16_t* PROJ = (const bf16_t*)(p.ws + WS_PROJ);
    bf16_t* ORb = (bf16_t*)(p.ws + WS_OR);
    LAS float* qT = (LAS float*)lds;
    LAS float* kT = qT + 1024;
    LAS float* vS = kT + 1024;
    LAS float* SCP = vS + 2048;
    LAS float* PART = SCP + 512;
    const float l2g = log2_gamma(h);
    const float g8 = exp2f(8.0f * l2g), gm8 = exp2f(-8.0f * l2g);
    const size_t rbase = (size_t)(NP + n * 8);
    const int e4 = lane * 4;
    const float* S0 = p.in[I_ST] + ((size_t)(n * 8 + h) * 128) * 256 + e4;
    float* S1 = p.out + O_SRS + ((size_t)(n * 8 + h) * 128) * 256 + e4;
    f32x4 S[16];
#pragma unroll
    for (int it = 0; it < 16; ++it) S[it] = *(const f32x4*)(S0 + (size_t)(w + 8 * it) * 256);
    {
        bf16_t qv[2], kv[2];
#pragma unroll
        for (int t = 0; t < 2; ++t) { const int idx = tid + 512 * t, i = idx >> 7, d = idx & 127; const bf16_t* r = PROJ + (rbase + i) * DIN + h * 128 + d; qv[t] = r[C_QR]; kv[t] = r[C_KR]; }
        const u32x2 v2 = *(const u32x2*)(PROJ + (rbase + w) * DIN + C_VR + h * 256 + e4);
#pragma unroll
        for (int t = 0; t < 2; ++t) { const int idx = tid + 512 * t, i = idx >> 7, d = idx & 127;
            qT[d * 8 + i] = bf2f(qv[t]) * exp2f((float)(i + 1) * l2g); kT[d * 8 + i] = bf2f(kv[t]) * exp2f((float)(7 - i) * l2g); }
        *(LAS f32x4*)(vS + w * 256 + e4) = (f32x4){bflo(v2.x), bfhi(v2.x), bflo(v2.y), bfhi(v2.y)};
    }
    __syncthreads();
    {
        const int i = lane >> 3, j = lane & 7; float sc = 0.f;
#pragma unroll
        for (int dd = 0; dd < 16; ++dd) { const int d = 16 * w + dd; sc += qT[d * 8 + i] * kT[d * 8 + j]; }
        SCP[w * 64 + lane] = sc;
    }
    f32x4 vv[8], ya[8];
#pragma unroll
    for (int j = 0; j < 8; ++j) { vv[j] = *(const LAS f32x4*)(vS + j * 256 + e4); ya[j] = (f32x4){0.f, 0.f, 0.f, 0.f}; }
#pragma unroll
    for (int it = 0; it < 16; ++it) {
        const int d = w + 8 * it;
        const f32x4 qa = *(const LAS f32x4*)(qT + d * 8), qb = *(const LAS f32x4*)(qT + d * 8 + 4);
        const f32x4 ka = *(const LAS f32x4*)(kT + d * 8), kb = *(const LAS f32x4*)(kT + d * 8 + 4);
        f32x4 sn = S[it] * g8;
        sn += vv[0] * ka[0]; sn += vv[1] * ka[1]; sn += vv[2] * ka[2]; sn += vv[3] * ka[3];
        sn += vv[4] * kb[0]; sn += vv[5] * kb[1]; sn += vv[6] * kb[2]; sn += vv[7] * kb[3];
        *(f32x4*)(S1 + (size_t)d * 256) = sn;
        ya[0] += S[it] * qa[0]; ya[1] += S[it] * qa[1]; ya[2] += S[it] * qa[2]; ya[3] += S[it] * qa[3];
        ya[4] += S[it] * qb[0]; ya[5] += S[it] * qb[1]; ya[6] += S[it] * qb[2]; ya[7] += S[it] * qb[3];
    }
#pragma unroll
    for (int i = 0; i < 8; ++i) *(LAS f32x4*)(PART + (w * 8 + i) * 256 + e4) = ya[i];
    __syncthreads();
    {
        const int i = w;
        f32x4 y = {0.f, 0.f, 0.f, 0.f};
#pragma unroll
        for (int ww = 0; ww < 8; ++ww) y += *(const LAS f32x4*)(PART + (ww * 8 + i) * 256 + e4);
#pragma unroll
        for (int j = 0; j < 8; ++j) {
            float sc = 0.f;
#pragma unroll
            for (int ww = 0; ww < 8; ++ww) sc += SCP[ww * 64 + i * 8 + j];
            if (j <= i) y += vv[j] * (sc * gm8);
        }
        const float ss = wave_sum((y[0] * y[0] + y[1] * y[1]) + (y[2] * y[2] + y[3] * y[3]));
        const float rstd = rsqrtf(ss * (1.0f / 256.0f) + EPS);
        const u32x2 gv = *(const u32x2*)(PROJ + (rbase + i) * DIN + C_GR + h * 256 + e4);
        u32x2 wv; wv.x = cvt_pk_bf16(y[0] * rstd * bflo(gv.x), y[1] * rstd * bfhi(gv.x)); wv.y = cvt_pk_bf16(y[2] * rstd * bflo(gv.y), y[3] * rstd * bfhi(gv.y));
        *(u32x2*)(ORb + (rbase + i) * D + h * 256 + e4) = wv;
    }
    __syncthreads();
}

__device__ __forceinline__ void phase_mix1(const Params& p, LAS unsigned char* lds) {
    const int G = gridDim.x;
    for (int u = blockIdx.x; u < 512; u += G) kv_unit(p, lds, u);
    for (int u = blockIdx.x; u < 256; u += G) attn_unit(p, lds, u);
    for (int u = blockIdx.x; u < 512; u += G) sattn_unit(p, lds, u);
    for (int u = blockIdx.x; u < 1024; u += G) sret_unit(p, lds, u);
    const bf16_t* PROJ = (const bf16_t*)(p.ws + WS_PROJ);
    const int gt = blockIdx.x * 512 + threadIdx.x, NGT = G * 512;
    for (int i = gt; i < 2 * 65536 / 4; i += NGT) {
        const int which = i >> 14, r = i & 16383, bw = r >> 6, c4 = (r & 63) * 4, b = bw >> 7, wdx = bw & 127;
        const u32x2 v = *(const u32x2*)(PROJ + (size_t)(b * 4096 + 3968 + wdx) * DIN + (which ? C_VA : C_KA) + c4);
        *(f32x4*)(p.out + (which ? O_VWP : O_KWP) + (size_t)bw * 256 + c4) = (f32x4){bflo(v.x), bfhi(v.x), bflo(v.y), bfhi(v.y)};
    }
    for (int i0 = gt; i0 < 2 * 4194304 / 4; i0 += 4 * NGT) {
        f32x4 o[4];
#pragma unroll
        for (int t = 0; t < 4; ++t) {
            const int i = i0 + t * NGT;
            if (i < 2 * 4194304 / 4) {
                const int which = i >> 20, r = i & 1048575, nw = r >> 6, c4 = (r & 63) * 4, n = nw >> 7, wdx = nw & 127;
                if (wdx < 120) o[t] = *(const f32x4*)((which ? p.in[I_CV] : p.in[I_CK]) + ((size_t)(n * 128 + wdx + 8)) * 256 + c4);
                else { const u32x2 v = *(const u32x2*)(PROJ + (size_t)(NP + n * 8 + (wdx - 120)) * DIN + (which ? C_VA : C_KA) + c4); o[t] = (f32x4){bflo(v.x), bfhi(v.x), bflo(v.y), bfhi(v.y)}; }
            }
        }
#pragma unroll
        for (int t = 0; t < 4; ++t) {
            const int i = i0 + t * NGT;
            if (i < 2 * 4194304 / 4) { const int which = i >> 20, r = i & 1048575, nw = r >> 6, c4 = (r & 63) * 4; *(f32x4*)(p.out + (which ? O_VWS : O_KWS) + (size_t)nw * 256 + c4) = o[t]; }
        }
    }
}

__device__ __forceinline__ void phase_scan(const Params& p) {
    const float* KVT = (const float*)(p.ws + WS_F);
    bf16_t* SPT = (bf16_t*)(p.ws + WS_SPT);
    const int gt = blockIdx.x * 512 + threadIdx.x, NGT = gridDim.x * 512;
    for (int it = gt; it < 16 * 8192; it += NGT) {
        const int bh = it >> 13, rem = it & 8191, e = rem >> 5, d4 = (rem & 31) * 4, h = bh & 7;
        const float g128 = exp2f(128.0f * log2_gamma(h));
        f32x4 S = {0.f, 0.f, 0.f, 0.f};
        const size_t off = (size_t)e * 128 + d4;
        f32x4 kvr[32];
#pragma unroll
        for (int c = 0; c < 32; ++c) kvr[c] = *(const f32x4*)(KVT + (size_t)(bh * 32 + c) * 32768 + off);
#pragma unroll
        for (int c = 0; c < 32; ++c) {
            const size_t uo = (size_t)(bh * 32 + c) * 32768 + off;
            u32x2 wv; wv.x = cvt_pk_bf16(S[0], S[1]); wv.y = cvt_pk_bf16(S[2], S[3]);
            *(u32x2*)(SPT + uo) = wv;
            S = S * g128 + kvr[c];
        }
        float* so = p.out + O_SRP + (size_t)bh * 32768 + e;
        so[(size_t)(d4 + 0) * 256] = S[0]; so[(size_t)(d4 + 1) * 256] = S[1]; so[(size_t)(d4 + 2) * 256] = S[2]; so[(size_t)(d4 + 3) * 256] = S[3];
    }
}

__device__ __forceinline__ void phase_ret3(const Params& p) {
    const int tid = threadIdx.x, lane = tid & 63, w = tid >> 6, fr = lane & 15, fq = lane >> 4;
    const bf16_t* PROJ = (const bf16_t*)(p.ws + WS_PROJ);
    bf16_t* ORb = (bf16_t*)(p.ws + WS_OR);
    for (int u = blockIdx.x; u < 512; u += gridDim.x) {
        const int c = u & 31, bh = u >> 5, h = bh & 7, b = bh >> 3;
        const int row0 = b * 4096 + c * 128, i0 = 16 * w, irow = row0 + i0 + fr;
        const float l2g = log2_gamma(h);
        const bf16_t* SPTu = (const bf16_t*)(p.ws + WS_SPT) + (size_t)u * 32768;
        const bf16_t* VTu = (const bf16_t*)(p.ws + WS_VT) + (size_t)u * 32768;
        bf16x8 Qf[4];
        { const bf16_t* qp = PROJ + (size_t)irow * DIN + C_QR + h * 128 + fq * 8;
#pragma unroll
          for (int kc = 0; kc < 4; ++kc) Qf[kc] = *(const bf16x8*)(qp + kc * 32); }
        f32x4 sa[8];
#pragma unroll
        for (int jt = 0; jt < 8; ++jt) {
            sa[jt] = (f32x4){0.f, 0.f, 0.f, 0.f};
            if (jt <= w) {
                const bf16_t* kp = PROJ + (size_t)(row0 + 16 * jt + fr) * DIN + C_KR + h * 128 + fq * 8;
#pragma unroll
                for (int kc = 0; kc < 4; ++kc) sa[jt] = mfma16(*(const bf16x8*)(kp + kc * 32), Qf[kc], sa[jt]);
            }
        }
        const int ii = i0 + fr;
#pragma unroll
        for (int jt = 0; jt < 8; ++jt)
#pragma unroll
            for (int jj = 0; jj < 4; ++jj) { const int dj = ii - (16 * jt + 4 * fq + jj); sa[jt][jj] = dj >= 0 ? sa[jt][jj] * exp2f((float)dj * l2g) : 0.f; }
        union { bf16x8 v; u32x4 q; } Pf[4];
#pragma unroll
        for (int cc = 0; cc < 4; ++cc) {
            Pf[cc].q.x = cvt_pk_bf16(sa[2 * cc][0], sa[2 * cc][1]); Pf[cc].q.y = cvt_pk_bf16(sa[2 * cc][2], sa[2 * cc][3]);
            Pf[cc].q.z = cvt_pk_bf16(sa[2 * cc + 1][0], sa[2 * cc + 1][1]); Pf[cc].q.w = cvt_pk_bf16(sa[2 * cc + 1][2], sa[2 * cc + 1][3]);
        }
        const float qw = exp2f((float)(ii + 1) * l2g);
        f32x4 y[16];
#pragma unroll
        for (int et = 0; et < 16; ++et) {
            f32x4 a = {0.f, 0.f, 0.f, 0.f};
            const bf16_t* sp = SPTu + (16 * et + fr) * 128 + fq * 8;
#pragma unroll
            for (int kc = 0; kc < 4; ++kc) a = mfma16(*(const bf16x8*)(sp + kc * 32), Qf[kc], a);
            a = a * qw;
            const bf16_t* vp = VTu + (16 * et + fr) * 128 + 4 * fq;
#pragma unroll
            for (int cc = 0; cc < 4; ++cc) {
                if (2 * cc <= w) {
                    union { bf16x8 v; u32x2 hh[2]; } af;
                    af.hh[0] = *(const u32x2*)(vp + 32 * cc); af.hh[1] = *(const u32x2*)(vp + 32 * cc + 16);
                    a = mfma16(af.v, Pf[cc].v, a);
                }
            }
            y[et] = a;
        }
        float ss = 0.f;
#pragma unroll
        for (int et = 0; et < 16; ++et) ss += (y[et][0] * y[et][0] + y[et][1] * y[et][1]) + (y[et][2] * y[et][2] + y[et][3] * y[et][3]);
        ss += __shfl_xor(ss, 16); ss += __shfl_xor(ss, 32);
        const float rstd = rsqrtf(ss * (1.0f / 256.0f) + EPS);
        const bf16_t* gp = PROJ + (size_t)irow * DIN + C_GR + h * 256 + 4 * fq;
        bf16_t* op = ORb + (size_t)irow * D + h * 256 + 4 * fq;
#pragma unroll
        for (int et = 0; et < 16; ++et) {
            const u32x2 gv = *(const u32x2*)(gp + 16 * et);
            u32x2 wv; wv.x = cvt_pk_bf16(y[et][0] * rstd * bflo(gv.x), y[et][1] * rstd * bfhi(gv.x)); wv.y = cvt_pk_bf16(y[et][2] * rstd * bflo(gv.y), y[et][3] * rstd * bfhi(gv.y));
            *(u32x2*)(op + 16 * et) = wv;
        }
    }
}

#define XB_TMO      128
#define XB_XCNT(j)  (256  + 64 * (j))
#define XB_XSUB(j)  (1280 + 64 * (j))
#define XB_XGEN(j)  (2304 + 64 * (j))
#define XB_TOP      3328
#define XB_TOPGEN   3392
#define XCD_BAR_WORDS 3456
#define XB_SPIN_CAP (1u << 18)

__device__ __forceinline__ unsigned xb_ld(unsigned* p)              { return __hip_atomic_load(p, __ATOMIC_RELAXED, __HIP_MEMORY_SCOPE_AGENT); }
__device__ __forceinline__ unsigned xb_add(unsigned* p, unsigned v) { return __hip_atomic_fetch_add(p, v, __ATOMIC_RELAXED, __HIP_MEMORY_SCOPE_AGENT); }
__device__ __forceinline__ unsigned xb_xcc_id() { return (unsigned)__builtin_amdgcn_s_getreg((3 << 11) | 20) & 0xFu; }
#define XB_SPIN(cond, bar) do { unsigned _sp = 0; while (cond) { __builtin_amdgcn_s_sleep(1); \
    if ((++_sp & 255u) == 0u) { if (xb_ld(&(bar)[XB_TMO])) break; if (_sp > XB_SPIN_CAP) { atomicAdd(&(bar)[XB_TMO], 1u); break; } } } } while (0)

struct XcdBarrier {
    unsigned* bar; unsigned x;
    volatile LAS unsigned* st;
};

__device__ __forceinline__ XcdBarrier xcd_barrier_post(unsigned* bar, volatile LAS unsigned* st) {
    XcdBarrier b; b.bar = bar; b.x = xb_xcc_id(); b.st = st;
    if (threadIdx.x == 0) (void)xb_add(&bar[XB_XCNT(b.x)], 1u);
    return b;
}
__device__ __forceinline__ void xcd_barrier_complete(unsigned* bar, unsigned x, unsigned& nloc, unsigned& nx) {
    const unsigned G = gridDim.x * gridDim.y * gridDim.z;
    unsigned sum, cnt, mine, sp = 0u;
    for (;;) {
        sum = 0u; cnt = 0u; mine = 0u;
#pragma unroll
        for (unsigned j = 0; j < 16; ++j) { const unsigned c = xb_ld(&bar[XB_XCNT(j)]); sum += c; cnt += (c > 0u) ? 1u : 0u; mine = (j == x) ? c : mine; }
        if (sum == G) break;
        __builtin_amdgcn_s_sleep(1);
        if ((++sp & 255u) == 0u) { if (xb_ld(&bar[XB_TMO])) break; if (sp > XB_SPIN_CAP) { atomicAdd(&bar[XB_TMO], 1u); break; } }
    }
    nloc = mine > 0u ? mine : 1u; nx = cnt > 0u ? cnt : 1u;
}

__device__ __forceinline__ void xcd_barrier(const XcdBarrier& b) {
    asm volatile("s_waitcnt vmcnt(0)" ::: "memory");
    __syncthreads();
    if (threadIdx.x == 0) {
        unsigned* bar = b.bar;
        __builtin_amdgcn_s_waitcnt(0);
        unsigned nloc = b.st[0], nx = b.st[1];
        if (nloc == 0u) { xcd_barrier_complete(bar, b.x, nloc, nx); b.st[0] = nloc; b.st[1] = nx; }
        const unsigned old = xb_add(&bar[XB_XSUB(b.x)], 1u);
        const unsigned gen = old / nloc;
        if (old + 1u == (gen + 1u) * nloc) {
            __builtin_amdgcn_fence(__ATOMIC_RELEASE, "agent");
            asm volatile("s_waitcnt vmcnt(0)" ::: "memory");
            const unsigned og = xb_add(&bar[XB_TOP], 1u);
            const unsigned tg = og / nx;
            if (og + 1u == (tg + 1u) * nx) xb_add(&bar[XB_TOPGEN], 1u);
            else XB_SPIN(xb_ld(&bar[XB_TOPGEN]) == tg, bar);
            __builtin_amdgcn_fence(__ATOMIC_ACQUIRE, "agent");
            xb_add(&bar[XB_XGEN(b.x)], 1u);
            asm volatile("s_waitcnt vmcnt(0)" ::: "memory");
        } else {
            XB_SPIN(xb_ld(&bar[XB_XGEN(b.x)]) == gen, bar);
            __builtin_amdgcn_fence(__ATOMIC_ACQUIRE, "agent");
            asm volatile("s_waitcnt vmcnt(0)" ::: "memory");
        }
    }
    __syncthreads();
}


__device__ __forceinline__ void gemm_part(const Params& p, LAS unsigned char* lds, int which) {
    unsigned char* ws = p.ws;
    EpiPart E; E.P01 = (bf16_t*)(ws + WS_F); E.P23 = (bf16_t*)(ws + WS_PART23);
    const bf16_t* A; const bf16_t* Bt; int K;
    if (which == 1) { A = (const bf16_t*)(ws + WS_PROJ); Bt = (const bf16_t*)(ws + WS_WD1); K = DFF; }
    else if (which == 2) { A = (const bf16_t*)(ws + WS_HB); Bt = (const bf16_t*)(ws + WS_WO); K = D; }
    else { A = (const bf16_t*)(ws + WS_PROJ); Bt = (const bf16_t*)(ws + WS_WD2); K = DFF; }
    run_gemm(lds, A, Bt, MT, D, K, E, 4);
}
__device__ __forceinline__ void gemm_gu(const Params& p, LAS unsigned char* lds, int which) {
    unsigned char* ws = p.ws;
    EpiSwiGLU E; E.O = (bf16_t*)(ws + WS_PROJ);
    run_gemm(lds, (const bf16_t*)(ws + WS_HB), (const bf16_t*)(ws + (which == 0 ? WS_WGU1 : WS_WGU2)), MT, 2 * DFF, D, E);
}
__device__ __forceinline__ void gemm_win(const Params& p, LAS unsigned char* lds) {
    unsigned char* ws = p.ws;
    EpiWin E; E.O = (bf16_t*)(ws + WS_PROJ); E.rc = (const float*)(ws + WS_ROTC); E.rs = (const float*)(ws + WS_ROTS);
    run_gemm(lds, (const bf16_t*)(ws + WS_HB), (const bf16_t*)(ws + WS_WIN), MT, DIN, D, E);
}
__device__ __forceinline__ void gemm_papr(const Params& p, LAS unsigned char* lds) {
    unsigned char* ws = p.ws;
    EpiPa E1; E1.T = (float*)(ws + WS_F); E1.P = (const bf16_t*)(ws + WS_PROJ);
    run_gemm(lds, (const bf16_t*)(ws + WS_OA), (const bf16_t*)(ws + WS_WPA), MT, D, 1024, E1);
    EpiPr E2; E2.T = (const float*)(ws + WS_F); E2.P = (const bf16_t*)(ws + WS_PROJ); E2.O = (bf16_t*)(ws + WS_HB);
    run_gemm(lds, (const bf16_t*)(ws + WS_OR), (const bf16_t*)(ws + WS_WPR), MT, D, D, E2);
}

#ifndef XSYNC
#define XSYNC 0
#endif
#ifndef DUPMASK
#define DUPMASK 0
#endif
#ifndef PHMASK
#define PHMASK 0xFFFF
#endif
#define PHASE(k, body) if (((PHMASK >> (k)) & 1) && p.ph_lo <= (k) && (k) < p.ph_hi) { if ((k) > p.ph_lo) { xcd_barrier(xb); for (int _x = 0; _x < XSYNC; ++_x) xcd_barrier(xb); } body; if ((DUPMASK >> (k)) & 1) { xcd_barrier(xb); body; } }
__global__ __launch_bounds__(512, 2) void mega(Params p) {
    extern __shared__ __attribute__((aligned(16))) unsigned char shm[];
    LAS unsigned char* lds = (LAS unsigned char*)shm;
    cg::grid_group grid = cg::this_grid();
    if (p.ph_lo < 0) grid.sync();
    volatile LAS unsigned* xst = (volatile LAS unsigned*)(lds + LDS_BYTES - 16);
    if (threadIdx.x == 0) { xst[0] = 0u; xst[1] = 0u; }
    __syncthreads();
    const XcdBarrier xb = xcd_barrier_post((unsigned*)p.ws, xst);
    PHASE(PH_PREP, phase_prep(p, lds))
    PHASE(PH_ADA, phase_ada(p, lds))
    PHASE(PH_ROW0, phase_row<0>(p))
    PHASE(PH_GU1, (gemm_gu(p, lds, 0), tail_tjobs(p, lds, 36 * 44, 2, 3), tail_tjobs(p, lds, 36 * 44, 7, 8)))
    PHASE(PH_D1, (gemm_part(p, lds, 1), tail_tjobs(p, lds, 36 * 8 * 4, 4, 7), tail_tjobs(p, lds, 36 * 8 * 4, 3, 4, 8832)))
    PHASE(PH_ROW1, phase_row<1>(p))
    PHASE(PH_WIN, (gemm_win(p, lds), tail_tjobs(p, lds, 36 * 46, 8, 9)))
    PHASE(PH_MIX1, phase_mix1(p, lds))
    PHASE(PH_SCAN, phase_scan(p))
    PHASE(PH_RET3, phase_ret3(p))
    PHASE(PH_PAPR, (gemm_papr(p, lds), tail_tjobs(p, lds, 36 * 8, 9, 10)))
    PHASE(PH_WO, gemm_part(p, lds, 2))
    PHASE(PH_ROW2, phase_row<2>(p))
    PHASE(PH_GU2, gemm_gu(p, lds, 1))
    PHASE(PH_D2, gemm_part(p, lds, 3))
    PHASE(PH_ROW3, phase_row<3>(p))
}

extern "C" void kernel_launch(void* const* d_in, const int* in_sizes, int n_in, void* d_out, int out_size, void* d_ws, size_t ws_size, hipStream_t stream) {
    static int grid = 0;
    if (grid == 0) {
        if (n_in != 22 || ws_size < WS_END) { fprintf(stderr, "kernel_launch: need 22 inputs and %zu bytes of workspace (got %d, %zu)\n", (size_t)WS_END, n_in, ws_size); grid = -1; return; }
        int dev = 0, cus = 0, per_cu = 0;
        (void)hipGetDevice(&dev);
        (void)hipDeviceGetAttribute(&cus, hipDeviceAttributeMultiprocessorCount, dev);
        if (hipFuncSetAttribute((const void*)mega, hipFuncAttributeMaxDynamicSharedMemorySize, LDS_BYTES) != hipSuccess) { fprintf(stderr, "kernel_launch: hipFuncSetAttribute failed\n"); grid = -1; return; }
        if (hipOccupancyMaxActiveBlocksPerMultiprocessor(&per_cu, (const void*)mega, 512, LDS_BYTES) != hipSuccess || per_cu < 1) { fprintf(stderr, "kernel_launch: occupancy query says %d\n", per_cu); per_cu = 1; }
        (void)hipGetLastError();
        grid = cus;
        if (grid <= 0) grid = 256;
    }
    if (grid < 0) return;
    if (hipMemsetAsync(d_ws, 0, XCD_BAR_WORDS * sizeof(unsigned), stream) != hipSuccess) { fprintf(stderr, "kernel_launch: memset of the barrier words failed\n"); return; }
    Params p{};
    for (int i = 0; i < 22; ++i) p.in[i] = (const float*)d_in[i];
    p.out = (float*)d_out; p.ws = (unsigned char*)d_ws;
#if MK_SPLIT
    for (int ph = 0; ph < NPH; ++ph) {
        p.ph_lo = ph; p.ph_hi = ph + 1;
        void* args[] = {&p};
        hipError_t e = hipLaunchCooperativeKernel((const void*)mega, dim3(grid), dim3(512), args, LDS_BYTES, stream);
        if (e != hipSuccess) { fprintf(stderr, "cooperative launch failed: %s (grid %d)\n", hipGetErrorString(e), grid); break; }
    }
#else
    p.ph_lo = 0; p.ph_hi = NPH;
    void* args[] = {&p};
    hipError_t e = hipLaunchCooperativeKernel((const void*)mega, dim3(grid), dim3(512), args, LDS_BYTES, stream);
    if (e != hipSuccess) fprintf(stderr, "cooperative launch failed: %s (grid %d)\n", hipGetErrorString(e), grid);
#endif
}
```

```cpp
#include <hip/hip_runtime.h>
#include <hip/hip_cooperative_groups.h>
#include <cstdio>
#include <cstdint>
namespace cg = cooperative_groups;

#ifndef MK_SPLIT
#define MK_SPLIT 0
#endif

namespace pg8 {
#define PG8_LAS __attribute__((address_space(3)))
typedef unsigned short bf16_t;
typedef short bf16x8 __attribute__((ext_vector_type(8)));
typedef float f32x4 __attribute__((ext_vector_type(4)));
typedef unsigned u32x4 __attribute__((ext_vector_type(4)));
typedef unsigned u32x2 __attribute__((ext_vector_type(2)));
constexpr int BM = 256, BK = 64, HALF = 128, HTB = HALF * BK * 2  , STAGE_BYTES = 8 * HTB, NXCD = 8, WGM = 8;

__host__ __device__ __forceinline__ int lds_byte(int r, int c) { const int st = (r >> 4) * 2 + (c >> 5), rr = r & 15, cc = c & 31, ob = rr * 64 + cc * 2; return st * 1024 + (ob ^ (((ob >> 9) & 1) << 5)); }
__host__ __device__ __forceinline__ void stage_rc(int b, int& R, int& C) { const int st = b / 1024, sb = b % 1024, swz = sb ^ (((sb >> 9) & 1) << 5); R = (st >> 1) * 16 + swz / 64; C = (st & 1) * 32 + (swz % 64) / 2; }
__host__ __device__ __forceinline__ int perm32(int rho) { const int n = rho >> 4, i = rho & 15; return 8 * (i >> 2) + 4 * n + (i & 3); }

struct Unit { int pm, pn, ks; };
struct Gemm { const bf16_t* A; const bf16_t* Bt; int M, N, K, ld; };

struct StaticOrder {
    int nM, nN, nwg, G, c, ns;
    __host__ __device__ void init(int M, int N, int G_, int c_, int ns_ = 1) { nM = M / BM; nN = N / BM; nwg = nM * nN; G = G_; c = c_; ns = ns_; }
    __host__ __device__ bool next(int i, Unit& u) const {
        const long L = (long)i * G + c; if (L >= (long)nwg * ns) return false;
        u.ks = (int)(L / nwg);
        int wgid = (int)(L - (long)u.ks * nwg); { const int q = nwg / NXCD, r = nwg % NXCD, xcd = wgid % NXCD, off = wgid / NXCD; wgid = (xcd < r ? xcd * (q + 1) : r * (q + 1) + (xcd - r) * q) + off; }
        const int nig = WGM * nN, gid = wgid / nig, fm = gid * WGM, gsz = (nM - fm) < WGM ? (nM - fm) : WGM;
        u.pm = fm + ((wgid % nig) % gsz); u.pn = (wgid % nig) / gsz; return true;
    }
    __device__ __forceinline__ void a_ready(const Unit&) const {}
    __device__ __forceinline__ void done(const Unit&) const {}
};

typedef float f32x2_cv __attribute__((ext_vector_type(2)));
typedef __bf16 bf16x2_cv __attribute__((ext_vector_type(2)));
__device__ __forceinline__ unsigned cvt_pk_bf16(float lo, float hi) { const f32x2_cv v = {lo, hi}; const bf16x2_cv b = __builtin_convertvector(v, bf16x2_cv); return __builtin_bit_cast(unsigned, b); }

template <class Epi, class Sched>
__device__ __forceinline__ void gemm_phase(PG8_LAS unsigned char* lds, const Gemm g, const Sched& S, const Epi& E) {
    int tid_ = threadIdx.x; asm volatile("" : "+v"(tid_));
    const int tid = tid_, wid = __builtin_amdgcn_readfirstlane(tid >> 6), lane = tid & 63, wr = wid >> 2, wc = wid & 3, fr = lane & 15, fq = lane >> 4;
    const int K = g.ld, nt = g.K / BK;
    unsigned voffA[2], voffB[2];
#pragma unroll
    for (int i = 0; i < 2; ++i) { int R, C; stage_rc(tid * 16 + i * 8192, R, C); const int Rb = Epi::PERM ? ((R & ~31) + perm32(R & 31)) : R;
        voffA[i] = (unsigned)(R * K + C) * 2u; voffB[i] = (unsigned)(Rb * K + C) * 2u; }
    const size_t kstep = (size_t)(BK * 2);
    const size_t hstep = (size_t)HALF * K * 2;
    const size_t tstep = 2 * hstep;
    const unsigned ldsw = (unsigned)wid * 1024u;
    const int aoff = lds_byte(wr * 64 + fr, fq * 8), boff = lds_byte(wc * 32 + fr, fq * 8);
#define PG8_SA(b, h) (((b) * 2 + (h)) * HTB)
#define PG8_SB(b, h) ((4 + (b) * 2 + (h)) * HTB)
#define PG8_STAGE(bufoff, gbase, voff) do { _Pragma("unroll") for (int _i = 0; _i < 2; ++_i) \
        __builtin_amdgcn_global_load_lds((const unsigned*)((const char*)(gbase) + (voff)[_i]), (PG8_LAS unsigned*)(lds + (bufoff) + ldsw + _i * 8192), 16, 0, 0); } while (0)
#define PG8_LDA(dst, b, h) do { _Pragma("unroll") for (int m = 0; m < 4; ++m) _Pragma("unroll") for (int k = 0; k < 2; ++k) dst[m][k] = *(const PG8_LAS bf16x8*)(lds + PG8_SA(b, h) + aoff + m * 2048 + k * 1024); } while (0)
#define PG8_LDB(dst, b, h) do { _Pragma("unroll") for (int n = 0; n < 2; ++n) _Pragma("unroll") for (int k = 0; k < 2; ++k) dst[n][k] = *(const PG8_LAS bf16x8*)(lds + PG8_SB(b, h) + boff + n * 2048 + k * 1024); } while (0)
#define PG8_MMA(ai, bj, At, Bt) do { __builtin_amdgcn_s_setprio(1); _Pragma("unroll") for (int m = 0; m < 4; ++m) _Pragma("unroll") for (int n = 0; n < 2; ++n) _Pragma("unroll") for (int k = 0; k < 2; ++k) \
        acc[ai][bj][m][n] = __builtin_amdgcn_mfma_f32_16x16x32_bf16(Bt[n][k], At[m][k], acc[ai][bj][m][n], 0, 0, 0); __builtin_amdgcn_s_setprio(0); } while (0)
#define PG8_WAIT_V(n) asm volatile("s_waitcnt vmcnt(" #n ")" ::: "memory")
#define PG8_WAIT_L(n) asm volatile("s_waitcnt lgkmcnt(" #n ")" ::: "memory")
#define PG8_BAR __builtin_amdgcn_s_barrier()
#define PG8_SCHED __builtin_amdgcn_sched_barrier(0)
    Unit cur, nxt; int ui = 0;
    if (!S.next(0, cur)) return;
    f32x4 acc[2][2][4][2];
#pragma unroll
    for (int a = 0; a < 2; ++a)
#pragma unroll
        for (int b = 0; b < 2; ++b)
#pragma unroll
            for (int m = 0; m < 4; ++m)
#pragma unroll
                for (int n = 0; n < 2; ++n) acc[a][b][m][n] = (f32x4){0.f, 0.f, 0.f, 0.f};
    bf16x8 At[4][2], B0[2][2], B1[2][2];
    const size_t ksb = (size_t)g.K * 2;
    const char* cA = (const char*)g.A + (size_t)cur.pm * tstep + (size_t)cur.ks * ksb; const char* cB = (const char*)g.Bt + (size_t)cur.pn * tstep + (size_t)cur.ks * ksb;
    S.a_ready(cur);
    PG8_STAGE(PG8_SB(0, 0), cB, voffB); PG8_STAGE(PG8_SB(0, 1), cB + hstep, voffB); PG8_STAGE(PG8_SA(0, 0), cA, voffA); PG8_STAGE(PG8_SA(0, 1), cA + hstep, voffA);
    if (wr == 1) PG8_BAR;
    PG8_WAIT_V(2); PG8_BAR;
    PG8_STAGE(PG8_SB(1, 0), cB + kstep, voffB); PG8_STAGE(PG8_SA(1, 0), cA + kstep, voffA); PG8_STAGE(PG8_SB(1, 1), cB + hstep + kstep, voffB);
    PG8_WAIT_V(6); PG8_BAR;
    for (;;) {
        const bool has_next = S.next(ui + 1, nxt);
        const char* nA = has_next ? (const char*)g.A + (size_t)nxt.pm * tstep + (size_t)nxt.ks * ksb : cA; const char* nB = has_next ? (const char*)g.Bt + (size_t)nxt.pn * tstep + (size_t)nxt.ks * ksb : cB;
        for (int t = 0; t < nt; t += 2) {
            const bool last = (t == nt - 2);
            const char* a1 = cA + (size_t)(t + 1) * kstep;
            const char* a2 = last ? nA : cA + (size_t)(t + 2) * kstep; const char* b2 = last ? nB : cB + (size_t)(t + 2) * kstep;
            const char* a3 = a2 + kstep; const char* b3 = b2 + kstep;
            if (last && has_next) S.a_ready(nxt);
            PG8_LDB(B0, 0, 0); PG8_LDB(B1, 0, 1); PG8_SCHED; PG8_LDA(At, 0, 0); PG8_STAGE(PG8_SA(1, 1), a1 + hstep, voffA);
            PG8_WAIT_V(8); PG8_WAIT_L(0); PG8_BAR; PG8_MMA(0, 0, At, B0); PG8_MMA(0, 1, At, B1); PG8_BAR; PG8_SCHED;
            PG8_LDA(At, 0, 1); PG8_STAGE(PG8_SB(0, 0), b2, voffB); PG8_STAGE(PG8_SB(0, 1), b2 + hstep, voffB); PG8_STAGE(PG8_SA(0, 0), a2, voffA);
            PG8_WAIT_V(8); PG8_WAIT_L(0); PG8_BAR; PG8_MMA(1, 0, At, B0); PG8_MMA(1, 1, At, B1); PG8_BAR; PG8_SCHED;
            PG8_LDB(B0, 1, 0); PG8_LDB(B1, 1, 1); PG8_SCHED; PG8_LDA(At, 1, 0); PG8_STAGE(PG8_SA(0, 1), a2 + hstep, voffA);
            PG8_WAIT_V(8); PG8_WAIT_L(0); PG8_BAR; PG8_MMA(0, 0, At, B0); PG8_MMA(0, 1, At, B1); PG8_BAR; PG8_SCHED;
            PG8_LDA(At, 1, 1); PG8_STAGE(PG8_SB(1, 0), b3, voffB); PG8_STAGE(PG8_SB(1, 1), b3 + hstep, voffB); PG8_STAGE(PG8_SA(1, 0), a3, voffA);
            PG8_WAIT_V(8); PG8_WAIT_L(0); PG8_BAR; PG8_MMA(1, 0, At, B0); PG8_MMA(1, 1, At, B1); PG8_BAR; PG8_SCHED;
        }
        if (wr == 0) PG8_BAR;
        if constexpr (!Epi::AFTER_DRAIN) { E(acc, cur, wr, wc, fr, fq); S.done(cur); }
        if (!has_next) break;
#pragma unroll
        for (int a = 0; a < 2; ++a)
#pragma unroll
            for (int b = 0; b < 2; ++b)
#pragma unroll
                for (int m = 0; m < 4; ++m)
#pragma unroll
                    for (int n = 0; n < 2; ++n) acc[a][b][m][n] = (f32x4){0.f, 0.f, 0.f, 0.f};
        cur = nxt; cA = nA; cB = nB; ++ui;
        if (wr == 1) PG8_BAR;
    }
    PG8_WAIT_V(0);
    PG8_BAR;
    if constexpr (Epi::AFTER_DRAIN) { E.fused(acc, cur, wr, wc, fr, fq, lds, wid, lane); S.done(cur); }
#undef PG8_SA
#undef PG8_SB
#undef PG8_STAGE
#undef PG8_LDA
#undef PG8_LDB
#undef PG8_MMA
#undef PG8_WAIT_V
#undef PG8_WAIT_L
#undef PG8_BAR
#undef PG8_SCHED
}
}

using pg8::bf16_t; using pg8::bf16x8; using pg8::f32x4; using pg8::u32x4; using pg8::u32x2; using pg8::cvt_pk_bf16;
#define LAS __attribute__((address_space(3)))
#define LDS_WAIT() asm volatile("s_waitcnt lgkmcnt(0)" ::: "memory")

constexpr int D = 2048, NP = 8192, NS = 1024, MT = 9216, DFF = 5632, DIN = 11776, NADA = 18432;
constexpr int C_QA = 0, C_KA = 1024, C_VA = 1280, C_QR = 1536, C_KR = 2560, C_VR = 3584, C_GR = 5632, C_GA = 7680, C_GB = 9728;
constexpr float EPS = 1e-6f;
constexpr int LDS_BYTES = 147456;
constexpr int NPH = 16;
enum { PH_PREP = 0, PH_ADA, PH_ROW0, PH_GU1, PH_D1, PH_ROW1, PH_WIN, PH_MIX1, PH_SCAN, PH_RET3, PH_PAPR, PH_WO, PH_ROW2, PH_GU2, PH_D2, PH_ROW3 };

constexpr size_t al256(size_t x) { return (x + 255) & ~(size_t)255; }
constexpr size_t SZ_WGU = (size_t)2 * DFF * D * 2, SZ_WD = (size_t)D * DFF * 2, SZ_WIN = (size_t)DIN * D * 2, SZ_WPA = (size_t)D * 1024 * 2, SZ_WPR = (size_t)D * D * 2, SZ_WO = (size_t)D * D * 2;
constexpr size_t WS_WGU1 = 16384;
constexpr size_t WS_WD1 = WS_WGU1 + SZ_WGU;
constexpr size_t WS_WIN = WS_WD1 + SZ_WD;
constexpr size_t WS_WPA = WS_WIN + SZ_WIN;
constexpr size_t WS_WPR = WS_WPA + SZ_WPA;
constexpr size_t WS_WO = WS_WPR + SZ_WPR;
constexpr size_t WS_WGU2 = WS_WO + SZ_WO;
constexpr size_t WS_WD2 = WS_WGU2 + SZ_WGU;
constexpr size_t WS_MOD = WS_WD2 + SZ_WD;
constexpr size_t WS_CS = WS_MOD + (size_t)256 * NADA * 4;
constexpr size_t WS_ROTC = WS_CS + (size_t)256 * D * 2;
constexpr size_t WS_ROTS = WS_ROTC + al256((size_t)4104 * 64 * 4);
constexpr size_t WS_HB = WS_ROTS + al256((size_t)4104 * 64 * 4);
constexpr size_t WS_F = WS_HB + (size_t)MT * D * 2;
constexpr size_t WS_PROJ = WS_F + (size_t)MT * D * 4;
constexpr size_t WS_PART23 = WS_PROJ + (size_t)MT * DFF * 2;
constexpr size_t WS_OA = WS_PROJ + (size_t)MT * DIN * 2;
constexpr size_t WS_OR = WS_OA + (size_t)MT * 1024 * 2;
constexpr size_t WS_SPT = WS_OR + (size_t)MT * D * 2;
constexpr size_t WS_VT = WS_SPT + (size_t)512 * 32768 * 2;
constexpr size_t WS_END = WS_VT + (size_t)512 * 32768 * 2;

constexpr size_t O_Y = 0, O_KWP = (size_t)MT * D, O_VWP = O_KWP + 65536, O_SRP = O_VWP + 65536, O_KWS = O_SRP + 524288, O_VWS = O_KWS + 4194304, O_SRS = O_VWS + 4194304;

struct Params {
    const float* in[22];
    float* out;
    unsigned char* ws;
    int ph_lo, ph_hi;
};
enum { I_XP = 0, I_XS, I_CK, I_CV, I_ST, I_CP, I_CSM, I_WADA, I_BADA, I_NPRE, I_NPOST, I_WIN, I_SINK, I_WPA, I_WPR, I_WO, I_F1G, I_F1U, I_F1D, I_F2G, I_F2U, I_F2D };

__device__ __forceinline__ float bf2f(unsigned short b) { return __uint_as_float(((unsigned)b) << 16); }
__device__ __forceinline__ float bflo(unsigned w) { return __uint_as_float(w << 16); }
__device__ __forceinline__ float bfhi(unsigned w) { return __uint_as_float(w & 0xffff0000u); }
__device__ __forceinline__ float wave_sum(float v) {
#pragma unroll
    for (int o = 1; o < 64; o <<= 1) v += __shfl_xor(v, o);
    return v;
}
__device__ __forceinline__ float wave_max(float v) {
#pragma unroll
    for (int o = 1; o < 64; o <<= 1) v = fmaxf(v, __shfl_xor(v, o));
    return v;
}
__device__ __forceinline__ float silu_f(float x) { return x * __builtin_amdgcn_rcpf(1.0f + __expf(-x)); }
__device__ __forceinline__ float sigm_f(float x) { return __builtin_amdgcn_rcpf(1.0f + __expf(-x)); }
__device__ __forceinline__ float log2_gamma(int h) { return log2f(1.0f - exp2f(-5.0f - (float)h)); }
__device__ __forceinline__ f32x4 mfma16(bf16x8 a, bf16x8 b, f32x4 c) { return __builtin_amdgcn_mfma_f32_16x16x32_bf16(a, b, c, 0, 0, 0); }

struct EpiF32 {
    static constexpr bool PERM = false, AFTER_DRAIN = false;
    float* C; int ldc; const float* bias;
    __device__ __forceinline__ void operator()(const f32x4 (&acc)[2][2][4][2], const pg8::Unit& u, int wr, int wc, int fr, int fq) const {
        const int row0 = u.pm * 256 + wr * 64 + fr, col0 = u.pn * 256 + wc * 32 + 4 * fq;
        f32x4 bv[2][2];
#pragma unroll
        for (int bj = 0; bj < 2; ++bj)
#pragma unroll
            for (int n = 0; n < 2; ++n) bv[bj][n] = bias ? *(const f32x4*)(bias + col0 + bj * 128 + n * 16) : (f32x4){0.f, 0.f, 0.f, 0.f};
#pragma unroll
        for (int ai = 0; ai < 2; ++ai)
#pragma unroll
            for (int m = 0; m < 4; ++m) { float* rowp = C + (size_t)(row0 + ai * 128 + m * 16) * ldc + col0;
#pragma unroll
                for (int bj = 0; bj < 2; ++bj)
#pragma unroll
                    for (int n = 0; n < 2; ++n) *(f32x4*)(rowp + bj * 128 + n * 16) = acc[ai][bj][m][n] + bv[bj][n]; }
    }
};
struct EpiPart {
    static constexpr bool PERM = true, AFTER_DRAIN = false;
    bf16_t* P01; bf16_t* P23;
    __device__ __forceinline__ void operator()(const f32x4 (&acc)[2][2][4][2], const pg8::Unit& u, int wr, int wc, int fr, int fq) const {
        bf16_t* O = (u.ks < 2 ? P01 : P23) + (size_t)(u.ks & 1) * MT * D;
        const int row0 = u.pm * 256 + wr * 64 + fr, col0 = u.pn * 256 + wc * 32 + 8 * fq;
#pragma unroll
        for (int ai = 0; ai < 2; ++ai)
#pragma unroll
            for (int m = 0; m < 4; ++m) {
                bf16_t* rowp = O + (size_t)(row0 + ai * 128 + m * 16) * D + col0;
#pragma unroll
                for (int bj = 0; bj < 2; ++bj) {
                    const f32x4 v0 = acc[ai][bj][m][0], v1 = acc[ai][bj][m][1];
                    u32x4 w; w.x = cvt_pk_bf16(v0[0], v0[1]); w.y = cvt_pk_bf16(v0[2], v0[3]); w.z = cvt_pk_bf16(v1[0], v1[1]); w.w = cvt_pk_bf16(v1[2], v1[3]);
                    *(u32x4*)(rowp + bj * 128) = w;
                }
            }
    }
};
struct EpiSwiGLU {
    static constexpr bool PERM = true, AFTER_DRAIN = false;
    bf16_t* O;
    __device__ __forceinline__ void operator()(const f32x4 (&acc)[2][2][4][2], const pg8::Unit& u, int wr, int wc, int fr, int fq) const {
        const int row0 = u.pm * 256 + wr * 64 + fr, col0 = u.pn * 128 + wc * 32 + 8 * fq;
#pragma unroll
        for (int ai = 0; ai < 2; ++ai)
#pragma unroll
            for (int m = 0; m < 4; ++m) {
                bf16_t* rowp = O + (size_t)(row0 + ai * 128 + m * 16) * DFF + col0;
                const f32x4 g0 = acc[ai][0][m][0], g1 = acc[ai][0][m][1], u0 = acc[ai][1][m][0], u1 = acc[ai][1][m][1];
                u32x4 w;
                w.x = cvt_pk_bf16(silu_f(g0[0]) * u0[0], silu_f(g0[1]) * u0[1]); w.y = cvt_pk_bf16(silu_f(g0[2]) * u0[2], silu_f(g0[3]) * u0[3]);
                w.z = cvt_pk_bf16(silu_f(g1[0]) * u1[0], silu_f(g1[1]) * u1[1]); w.w = cvt_pk_bf16(silu_f(g1[2]) * u1[2], silu_f(g1[3]) * u1[3]);
                *(u32x4*)rowp = w;
            }
    }
};
struct EpiWin {
    static constexpr bool PERM = true, AFTER_DRAIN = false;
    bf16_t* O; const float* rc; const float* rs;
    __device__ __forceinline__ void operator()(const f32x4 (&acc)[2][2][4][2], const pg8::Unit& u, int wr, int wc, int fr, int fq) const {
        const int pn = u.pn, row0 = u.pm * 256 + wr * 64 + fr;
        if (pn >= 6 && pn < 14) {
            const int slice = (pn - 6) >> 2, tt = (pn - 6) & 3, head = 2 * tt + (wc >> 1), d0 = 32 * (wc & 1) + 8 * fq;
            const int colbase = C_QR + slice * 1024 + head * 128 + d0;
            const float sc = slice ? 0.08838834764831845f : 1.0f;
#pragma unroll
            for (int ai = 0; ai < 2; ++ai)
#pragma unroll
                for (int m = 0; m < 4; ++m) {
                    const int row = row0 + ai * 128 + m * 16;
                    const int pidx = row < NP ? (row & 4095) : 4096 + ((row - NP) & 7);
                    const f32x4 c0 = *(const f32x4*)(rc + pidx * 64 + d0), c1 = *(const f32x4*)(rc + pidx * 64 + d0 + 4);
                    const f32x4 s0 = *(const f32x4*)(rs + pidx * 64 + d0), s1 = *(const f32x4*)(rs + pidx * 64 + d0 + 4);
                    const f32x4 a0 = acc[ai][0][m][0] * sc, a1 = acc[ai][0][m][1] * sc, b0 = acc[ai][1][m][0] * sc, b1 = acc[ai][1][m][1] * sc;
                    const f32x4 p0 = a0 * c0 - b0 * s0, p1 = a1 * c1 - b1 * s1, q0 = a0 * s0 + b0 * c0, q1 = a1 * s1 + b1 * c1;
                    u32x4 w1, w2;
                    w1.x = cvt_pk_bf16(p0[0], p0[1]); w1.y = cvt_pk_bf16(p0[2], p0[3]); w1.z = cvt_pk_bf16(p1[0], p1[1]); w1.w = cvt_pk_bf16(p1[2], p1[3]);
                    w2.x = cvt_pk_bf16(q0[0], q0[1]); w2.y = cvt_pk_bf16(q0[2], q0[3]); w2.z = cvt_pk_bf16(q1[0], q1[1]); w2.w = cvt_pk_bf16(q1[2], q1[3]);
                    bf16_t* rowp = O + (size_t)row * DIN + colbase;
                    *(u32x4*)rowp = w1; *(u32x4*)(rowp + 64) = w2;
                }
        } else {
            const int mode = pn < 22 ? 0 : (pn < 30 ? 1 : 2);
            const int col0 = pn * 256 + wc * 32 + 8 * fq;
#pragma unroll
            for (int ai = 0; ai < 2; ++ai)
#pragma unroll
                for (int m = 0; m < 4; ++m) {
                    bf16_t* rowp = O + (size_t)(row0 + ai * 128 + m * 16) * DIN + col0;
#pragma unroll
                    for (int bj = 0; bj < 2; ++bj) {
                        f32x4 v0 = acc[ai][bj][m][0], v1 = acc[ai][bj][m][1];
                        if (mode == 1) {
#pragma unroll
                            for (int j = 0; j < 4; ++j) { v0[j] = silu_f(v0[j]); v1[j] = silu_f(v1[j]); }
                        } else if (mode == 2) {
#pragma unroll
                            for (int j = 0; j < 4; ++j) { v0[j] = sigm_f(v0[j]); v1[j] = sigm_f(v1[j]); }
                        }
                        u32x4 w; w.x = cvt_pk_bf16(v0[0], v0[1]); w.y = cvt_pk_bf16(v0[2], v0[3]); w.z = cvt_pk_bf16(v1[0], v1[1]); w.w = cvt_pk_bf16(v1[2], v1[3]);
                        *(u32x4*)(rowp + bj * 128) = w;
                    }
                }
        }
    }
};
struct EpiPa {
    static constexpr bool PERM = true, AFTER_DRAIN = false;
    float* T; const bf16_t* P;
    __device__ __forceinline__ void operator()(const f32x4 (&acc)[2][2][4][2], const pg8::Unit& u, int wr, int wc, int fr, int fq) const {
        const int row0 = u.pm * 256 + wr * 64 + fr, col0 = u.pn * 256 + wc * 32 + 8 * fq;
#pragma unroll
        for (int ai = 0; ai < 2; ++ai) {
            u32x4 gq[4][2];
#pragma unroll
            for (int m = 0; m < 4; ++m)
#pragma unroll
                for (int bj = 0; bj < 2; ++bj) gq[m][bj] = *(const u32x4*)(P + (size_t)(row0 + ai * 128 + m * 16) * DIN + C_GA + col0 + bj * 128);
#pragma unroll
            for (int m = 0; m < 4; ++m) {
                const int row = row0 + ai * 128 + m * 16;
#pragma unroll
                for (int bj = 0; bj < 2; ++bj) {
                    const u32x4 g = gq[m][bj];
                    f32x4 v0 = acc[ai][bj][m][0], v1 = acc[ai][bj][m][1];
                    v0[0] *= bflo(g.x); v0[1] *= bfhi(g.x); v0[2] *= bflo(g.y); v0[3] *= bfhi(g.y);
                    v1[0] *= bflo(g.z); v1[1] *= bfhi(g.z); v1[2] *= bflo(g.w); v1[3] *= bfhi(g.w);
                    float* tp = T + (size_t)row * D + col0 + bj * 128;
                    *(f32x4*)tp = v0; *(f32x4*)(tp + 4) = v1;
                }
            }
        }
    }
};
struct EpiPr {
    static constexpr bool PERM = true, AFTER_DRAIN = false;
    const float* T; const bf16_t* P; bf16_t* O;
    __device__ __forceinline__ void operator()(const f32x4 (&acc)[2][2][4][2], const pg8::Unit& u, int wr, int wc, int fr, int fq) const {
        const int row0 = u.pm * 256 + wr * 64 + fr, col0 = u.pn * 256 + wc * 32 + 8 * fq;
#pragma unroll
        for (int ai = 0; ai < 2; ++ai)
#pragma unroll
            for (int mp = 0; mp < 2; ++mp) {
                u32x4 gq[2][2]; f32x4 t0[2][2], t1[2][2];
#pragma unroll
                for (int mi = 0; mi < 2; ++mi)
#pragma unroll
                    for (int bj = 0; bj < 2; ++bj) {
                        const int row = row0 + ai * 128 + (2 * mp + mi) * 16;
                        gq[mi][bj] = *(const u32x4*)(P + (size_t)row * DIN + C_GB + col0 + bj * 128);
                        const float* tp = T + (size_t)row * D + col0 + bj * 128;
                        t0[mi][bj] = *(const f32x4*)tp; t1[mi][bj] = *(const f32x4*)(tp + 4);
                    }
#pragma unroll
                for (int mi = 0; mi < 2; ++mi)
#pragma unroll
                    for (int bj = 0; bj < 2; ++bj) {
                        const int m = 2 * mp + mi, row = row0 + ai * 128 + m * 16;
                        const u32x4 g = gq[mi][bj]; const f32x4 a0 = t0[mi][bj], a1 = t1[mi][bj];
                        f32x4 v0 = acc[ai][bj][m][0], v1 = acc[ai][bj][m][1];
                        v0[0] = a0[0] + v0[0] * bflo(g.x); v0[1] = a0[1] + v0[1] * bfhi(g.x); v0[2] = a0[2] + v0[2] * bflo(g.y); v0[3] = a0[3] + v0[3] * bfhi(g.y);
                        v1[0] = a1[0] + v1[0] * bflo(g.z); v1[1] = a1[1] + v1[1] * bfhi(g.z); v1[2] = a1[2] + v1[2] * bflo(g.w); v1[3] = a1[3] + v1[3] * bfhi(g.w);
                        u32x4 w; w.x = cvt_pk_bf16(v0[0], v0[1]); w.y = cvt_pk_bf16(v0[2], v0[3]); w.z = cvt_pk_bf16(v1[0], v1[1]); w.w = cvt_pk_bf16(v1[2], v1[3]);
                        *(u32x4*)(O + (size_t)row * D + col0 + bj * 128) = w;
                    }
            }
    }
};

template <class Epi>
__device__ __forceinline__ void run_gemm(LAS unsigned char* lds, const bf16_t* A, const bf16_t* Bt, int M, int N, int K, const Epi& E, int ns = 1) {
    pg8::Gemm g; g.A = A; g.Bt = Bt; g.M = M; g.N = N; g.K = K / ns; g.ld = K;
    pg8::StaticOrder S; S.init(M, N, (int)gridDim.x, (int)blockIdx.x, ns);
    pg8::gemm_phase<Epi, pg8::StaticOrder>(lds, g, S, E);
}

__device__ __forceinline__ void transpose_item(const float* __restrict__ W, int K, int N, bf16_t* WT, int k0, int n0, int drow, LAS float* scr, int lane) {
#pragma unroll 8
    for (int i = 0; i < 32; ++i) { const int kk = 2 * i + (lane >> 5); scr[kk * 33 + (lane & 31)] = W[(size_t)(k0 + kk) * N + n0 + (lane & 31)]; }
    LDS_WAIT();
    const int c = lane & 7;
#pragma unroll
    for (int j = 0; j < 4; ++j) { const int n = (lane >> 3) + 8 * j; const LAS float* s = scr + (8 * c) * 33 + n;
        u32x4 o; o.x = cvt_pk_bf16(s[0 * 33], s[1 * 33]); o.y = cvt_pk_bf16(s[2 * 33], s[3 * 33]); o.z = cvt_pk_bf16(s[4 * 33], s[5 * 33]); o.w = cvt_pk_bf16(s[6 * 33], s[7 * 33]);
        *(u32x4*)(WT + (size_t)(drow + n) * K + k0 + 8 * c) = o; }
    LDS_WAIT();
}
__device__ __forceinline__ int map_gu(int n0, int up) { return 256 * (n0 >> 7) + (n0 & 127) + (up ? 128 : 0); }
__device__ __forceinline__ int map_win(int n0) {
    if (n0 < C_QR || n0 >= C_VR) return n0;
    const int s = n0 - C_QR, slice = s >> 10, within = s & 1023, h = within >> 7, half = (within >> 6) & 1, d0 = within & 63;
    return C_QR + slice * 1024 + (h >> 1) * 256 + half * 128 + (h & 1) * 64 + d0;
}
__device__ __forceinline__ int tjob_items(int j) {
    return (j == 0 || j == 1 || j == 7 || j == 8) ? (D / 64) * (DFF / 32) : (j == 2 || j == 9) ? (DFF / 64) * (D / 32) : j == 3 ? (D / 64) * (DIN / 32) : j == 4 ? (1024 / 64) * (D / 32) : (D / 64) * (D / 32);
}
__device__ __forceinline__ void run_tjobs(const Params& p, LAS unsigned char* lds, int jlo, int jhi, int widx, int nw, int skip = 0, int limit = 0x7fffffff) {
    const int lane = threadIdx.x & 63, wave = threadIdx.x >> 6;
    LAS float* scr = (LAS float*)(lds + wave * 8704);
    unsigned char* ws = p.ws;
    int total = 0;
    for (int j = jlo; j < jhi; ++j) total += tjob_items(j);
    if (total > skip + limit) total = skip + limit;
    for (int it = skip + widx; it < total; it += nw) {
        int r = it, j = jlo;
        while (r >= tjob_items(j)) { r -= tjob_items(j); ++j; }
        const float* W; int K, N; bf16_t* WT; int kind;
        switch (j) {
        case 0: W = p.in[I_F1G]; K = D; N = DFF; WT = (bf16_t*)(ws + WS_WGU1); kind = 1; break;
        case 1: W = p.in[I_F1U]; K = D; N = DFF; WT = (bf16_t*)(ws + WS_WGU1); kind = 2; break;
        case 2: W = p.in[I_F1D]; K = DFF; N = D; WT = (bf16_t*)(ws + WS_WD1); kind = 0; break;
        case 3: W = p.in[I_WIN]; K = D; N = DIN; WT = (bf16_t*)(ws + WS_WIN); kind = 3; break;
        case 4: W = p.in[I_WPA]; K = 1024; N = D; WT = (bf16_t*)(ws + WS_WPA); kind = 0; break;
        case 5: W = p.in[I_WPR]; K = D; N = D; WT = (bf16_t*)(ws + WS_WPR); kind = 0; break;
        case 6: W = p.in[I_WO]; K = D; N = D; WT = (bf16_t*)(ws + WS_WO); kind = 0; break;
        case 7: W = p.in[I_F2G]; K = D; N = DFF; WT = (bf16_t*)(ws + WS_WGU2); kind = 1; break;
        case 8: W = p.in[I_F2U]; K = D; N = DFF; WT = (bf16_t*)(ws + WS_WGU2); kind = 2; break;
        default: W = p.in[I_F2D]; K = DFF; N = D; WT = (bf16_t*)(ws + WS_WD2); kind = 0; break;
        }
        const int nblk = N / 32, kb = r / nblk, nb = r - kb * nblk, k0 = 64 * kb, n0 = 32 * nb;
        const int drow = kind == 0 ? n0 : (kind == 3 ? map_win(n0) : map_gu(n0, kind == 2));
        transpose_item(W, K, N, WT, k0, n0, drow, scr, lane);
    }
}
__device__ __forceinline__ void tail_tjobs(const Params& p, LAS unsigned char* lds, int nunits, int jlo, int jhi, int skip = 0, int limit = 0x7fffffff) {
    const int G = gridDim.x, rem = nunits % G, c = blockIdx.x;
    if (rem == 0) { run_tjobs(p, lds, jlo, jhi, c * 8 + (threadIdx.x >> 6), G * 8, skip, limit); return; }
    if (c >= rem) run_tjobs(p, lds, jlo, jhi, (c - rem) * 8 + (threadIdx.x >> 6), (G - rem) * 8, skip, limit);
}
__device__ __forceinline__ void phase_prep(const Params& p, LAS unsigned char* lds) {
    const int tid = threadIdx.x, wave = tid >> 6;
    unsigned char* ws = p.ws;
    const int gt = blockIdx.x * 512 + tid, NGT = gridDim.x * 512;
    bf16_t* CS = (bf16_t*)(ws + WS_CS);
    for (int i = gt; i < 256 * D / 4; i += NGT) {
        const int r = i >> 9, k = (i & 511) * 4;
        u32x2 w = {0u, 0u};
        if (r < 130) {
            const float* c = r < 2 ? p.in[I_CP] + (size_t)r * D : p.in[I_CSM] + (size_t)(r - 2) * D;
            const f32x4 v = *(const f32x4*)(c + k);
            w.x = cvt_pk_bf16(silu_f(v[0]), silu_f(v[1])); w.y = cvt_pk_bf16(silu_f(v[2]), silu_f(v[3]));
        }
        *(u32x2*)(CS + (size_t)r * D + k) = w;
    }
    float* rc = (float*)(ws + WS_ROTC); float* rs = (float*)(ws + WS_ROTS);
    for (int i = gt; i < 4104 * 64; i += NGT) {
        const int pi = i >> 6, d = i & 63;
        const float pos = pi < 4096 ? (float)pi : (float)(16384 + (pi - 4096));
        const float inv = (float)exp(-((double)d / 63.0) * 9.210340371976184);
        const float ang = pos * inv;
        double rev = (double)ang * 0.15915494309189535; rev -= rint(rev);
        const float rf = (float)rev;
        rc[i] = __builtin_amdgcn_cosf(rf); rs[i] = __builtin_amdgcn_sinf(rf);
    }
    run_tjobs(p, lds, 0, 2, blockIdx.x * 8 + wave, gridDim.x * 8);
}
__device__ __forceinline__ void phase_ada(const Params& p, LAS unsigned char* lds) {
    const int tid = threadIdx.x, lane = tid & 63, wave = tid >> 6, fr = lane & 15, fq = lane >> 4;
    const int gw = blockIdx.x * 8 + wave, NGW = gridDim.x * 8;
    constexpr int NT = NADA / 16;
    const int nblk_ada = (NT + 7) / 8;
    if ((int)blockIdx.x >= nblk_ada) { run_tjobs(p, lds, 3, 4, (blockIdx.x - nblk_ada) * 8 + wave, ((int)gridDim.x - nblk_ada) * 8, 0, 8832); return; }
    const bf16_t* CS = (const bf16_t*)(p.ws + WS_CS);
    float* MOD = (float*)(p.ws + WS_MOD);
    const float* W = p.in[I_WADA];
    LAS bf16_t* As0 = (LAS bf16_t*)lds;
    LAS bf16_t* As1 = As0 + 144 * 136;
    {
        const int t = gw;
        const int n = 16 * (t < NT ? t : NT - 1) + fr;
        f32x4 acc[9];
#pragma unroll
        for (int mt = 0; mt < 9; ++mt) acc[mt] = (f32x4){0.f, 0.f, 0.f, 0.f};
#define ADA_ALOAD(g_) do { _Pragma("unroll") for (int tt = 0; tt < 5; ++tt) { const int pc = tid + 512 * tt; if (pc < 2304) av[tt] = *(const u32x4*)(CS + (size_t)(pc >> 4) * D + 128 * (g_) + (pc & 15) * 8); } } while (0)
#define ADA_ASTORE(buf) do { _Pragma("unroll") for (int tt = 0; tt < 5; ++tt) { const int pc = tid + 512 * tt; if (pc < 2304) *(LAS u32x4*)((buf) + (pc >> 4) * 136 + (pc & 15) * 8) = av[tt]; } } while (0)
#define ADA_WLOAD(wv, g_) do { const float* wp_ = W + (size_t)(128 * (g_) + 8 * fq) * NADA + n; \
        _Pragma("unroll") for (int c = 0; c < 4; ++c) _Pragma("unroll") for (int i = 0; i < 8; ++i) wv[c][i] = wp_[(size_t)(32 * c + i) * NADA]; } while (0)
#define ADA_COMPUTE(wv, buf) do { _Pragma("unroll") for (int c = 0; c < 4; ++c) { \
            union { bf16x8 v; u32x4 q; } bf; \
            bf.q.x = cvt_pk_bf16(wv[c][0], wv[c][1]); bf.q.y = cvt_pk_bf16(wv[c][2], wv[c][3]); bf.q.z = cvt_pk_bf16(wv[c][4], wv[c][5]); bf.q.w = cvt_pk_bf16(wv[c][6], wv[c][7]); \
            const LAS bf16_t* ap = (buf) + fr * 136 + 32 * c + 8 * fq; \
            _Pragma("unroll") for (int mt = 0; mt < 9; ++mt) acc[mt] = mfma16(*(const LAS bf16x8*)(ap + (16 * mt) * 136), bf.v, acc[mt]); } } while (0)
        float wa[4][8], wb[4][8]; u32x4 av[5];
        ADA_ALOAD(0); ADA_WLOAD(wa, 0);
        ADA_ASTORE(As0);
        ADA_ALOAD(1); ADA_WLOAD(wb, 1);
        __syncthreads();
#pragma unroll 1
        for (int g = 0; g < 16; g += 2) {
            ADA_COMPUTE(wa, As0);
            ADA_ASTORE(As1);
            if (g + 2 < 16) { ADA_ALOAD(g + 2); ADA_WLOAD(wa, g + 2); }
            __syncthreads();
            ADA_COMPUTE(wb, As1);
            if (g + 2 < 16) ADA_ASTORE(As0);
            if (g + 3 < 16) { ADA_ALOAD(g + 3); ADA_WLOAD(wb, g + 3); }
            __syncthreads();
        }
#undef ADA_ALOAD
#undef ADA_ASTORE
#undef ADA_WLOAD
#undef ADA_COMPUTE
        const int sec = n >> 11, i3 = sec / 3, j3 = sec - 3 * i3, cc = n & 2047;
        const float bias = p.in[I_BADA][n];
        float mul = 1.0f, add = bias;
        if (j3 == 1) { mul = p.in[I_NPRE][i3 * D + cc]; add = bias + 1.0f; }
        else if (j3 == 2) mul = p.in[I_NPOST][i3 * D + cc] * (i3 == 1 ? 1.0f : 0.5f);
#pragma unroll
        for (int mt = 0; mt < 9; ++mt)
#pragma unroll
            for (int jj = 0; jj < 4; ++jj) { const int m = 16 * mt + 4 * fq + jj; if (m < 130 && t < NT) MOD[(size_t)m * NADA + n] = (acc[mt][jj] + add) * mul; }
    }
}

template <int KIND>
__device__ __forceinline__ void phase_row(const Params& p) {
    const int tid = threadIdx.x, lane = tid & 63, wave = tid >> 6;
    const int gw = blockIdx.x * 8 + wave, NGW = gridDim.x * 8;
    const float* MOD = (const float*)(p.ws + WS_MOD);
    const bf16_t* P01 = (const bf16_t*)(p.ws + WS_F);
    const bf16_t* P23 = (const bf16_t*)(p.ws + WS_PART23);
    bf16_t* HB = (bf16_t*)(p.ws + WS_HB);
    float* X = p.out;
#pragma unroll 1
    for (int row = gw; row < MT; row += NGW) {
        const int mrow = row < NP ? (row >> 12) : 2 + ((row - NP) >> 3);
        const float* mod = MOD + (size_t)mrow * NADA;
        const float* xin = row < NP ? p.in[I_XP] + (size_t)row * D : p.in[I_XS] + (size_t)(row - NP) * D;
        const float* xs = (KIND <= 1) ? xin : X + (size_t)row * D;
        f32x4 v[8], b1[8], b2[8];
#pragma unroll
        for (int j = 0; j < 8; ++j) v[j] = *(const f32x4*)(xs + 4 * (lane + 64 * j));
        __builtin_amdgcn_sched_barrier(0);
        if (KIND == 0) {
#pragma unroll
            for (int j = 0; j < 8; ++j) { b1[j] = *(const f32x4*)(mod + (KIND * 3 + 1) * D + 4 * (lane + 64 * j)); b2[j] = *(const f32x4*)(mod + (KIND * 3) * D + 4 * (lane + 64 * j)); }
        }
        if (KIND > 0) {
            u32x2 pr[4][8]; f32x4 a1[8];
#pragma unroll
            for (int j = 0; j < 8; ++j) {
                const size_t o = (size_t)row * D + 4 * (lane + 64 * j);
                pr[0][j] = *(const u32x2*)(P01 + o); pr[1][j] = *(const u32x2*)(P01 + (size_t)MT * D + o);
                pr[2][j] = *(const u32x2*)(P23 + o); pr[3][j] = *(const u32x2*)(P23 + (size_t)MT * D + o);
                a1[j] = *(const f32x4*)(mod + ((KIND - 1) * 3 + 2) * D + 4 * (lane + 64 * j));
            }
            __builtin_amdgcn_sched_barrier(0);
            f32x4 f[8]; float ss = 0.f;
#pragma unroll
            for (int j = 0; j < 8; ++j) {
                f[j][0] = (bflo(pr[0][j].x) + bflo(pr[1][j].x)) + (bflo(pr[2][j].x) + bflo(pr[3][j].x));
                f[j][1] = (bfhi(pr[0][j].x) + bfhi(pr[1][j].x)) + (bfhi(pr[2][j].x) + bfhi(pr[3][j].x));
                f[j][2] = (bflo(pr[0][j].y) + bflo(pr[1][j].y)) + (bflo(pr[2][j].y) + bflo(pr[3][j].y));
                f[j][3] = (bfhi(pr[0][j].y) + bfhi(pr[1][j].y)) + (bfhi(pr[2][j].y) + bfhi(pr[3][j].y));
                ss += (f[j][0] * f[j][0] + f[j][1] * f[j][1]) + (f[j][2] * f[j][2] + f[j][3] * f[j][3]);
            }
            __builtin_amdgcn_sched_barrier(0);
            if (KIND < 3) {
#pragma unroll
                for (int j = 0; j < 8; ++j) { b1[j] = *(const f32x4*)(mod + (KIND * 3 + 1) * D + 4 * (lane + 64 * j)); b2[j] = *(const f32x4*)(mod + (KIND * 3) * D + 4 * (lane + 64 * j)); }
            }
            __builtin_amdgcn_sched_barrier(0);
            const float rstd = rsqrtf(wave_sum(ss) * (1.0f / D) + EPS);
#pragma unroll
            for (int j = 0; j < 8; ++j) {
                v[j] = v[j] + (f[j] * rstd) * a1[j];
                *(f32x4*)(X + (size_t)row * D + 4 * (lane + 64 * j)) = v[j];
            }
        }
        __builtin_amdgcn_sched_barrier(0);
        if (KIND < 3) {
            float ss = 0.f;
#pragma unroll
            for (int j = 0; j < 8; ++j) ss += (v[j][0] * v[j][0] + v[j][1] * v[j][1]) + (v[j][2] * v[j][2] + v[j][3] * v[j][3]);
            const float rstd = rsqrtf(wave_sum(ss) * (1.0f / D) + EPS);
#pragma unroll
            for (int j = 0; j < 8; ++j) {
                const f32x4 h = (v[j] * rstd) * b1[j] + b2[j];
                u32x2 w; w.x = cvt_pk_bf16(h[0], h[1]); w.y = cvt_pk_bf16(h[2], h[3]);
                *(u32x2*)(HB + (size_t)row * D + 4 * (lane + 64 * j)) = w;
            }
        }
    }
}

__device__ __forceinline__ void kv_unit(const Params& p, LAS unsigned char* lds, int u) {
    const int tid = threadIdx.x, lane = tid & 63, w = tid >> 6, fr = lane & 15, fq = lane >> 4;
    const int c = u & 31, bh = u >> 5, h = bh & 7, b = bh >> 3;
    const int row0 = b * 4096 + c * 128;
    const bf16_t* PROJ = (const bf16_t*)(p.ws + WS_PROJ);
    const bf16_t* Kg = PROJ + (size_t)row0 * DIN + C_KR + h * 128;
    const bf16_t* Vg = PROJ + (size_t)row0 * DIN + C_VR + h * 256;
    LAS bf16_t* Kt = (LAS bf16_t*)lds;
    LAS bf16_t* Vt = (LAS bf16_t*)(lds + 34816);
    const float l2g = log2_gamma(h);
    {
        const int j = tid & 127, cgp = tid >> 7;
        const float kw = exp2f((float)(127 - j) * l2g);
#pragma unroll
        for (int it = 0; it < 4; ++it) {
            const int ch = cgp + 4 * it;
            const u32x4 v = *(const u32x4*)(Kg + (size_t)j * DIN + ch * 8);
            const unsigned a0 = cvt_pk_bf16(bflo(v.x) * kw, bfhi(v.x) * kw), a1 = cvt_pk_bf16(bflo(v.y) * kw, bfhi(v.y) * kw), a2 = cvt_pk_bf16(bflo(v.z) * kw, bfhi(v.z) * kw), a3 = cvt_pk_bf16(bflo(v.w) * kw, bfhi(v.w) * kw);
            LAS bf16_t* dst = Kt + (ch * 8) * 136 + j;
            dst[0 * 136] = (bf16_t)a0; dst[1 * 136] = (bf16_t)(a0 >> 16); dst[2 * 136] = (bf16_t)a1; dst[3 * 136] = (bf16_t)(a1 >> 16);
            dst[4 * 136] = (bf16_t)a2; dst[5 * 136] = (bf16_t)(a2 >> 16); dst[6 * 136] = (bf16_t)a3; dst[7 * 136] = (bf16_t)(a3 >> 16);
        }
#pragma unroll
        for (int it = 0; it < 8; ++it) {
            const int ch = cgp + 4 * it;
            const u32x4 v = *(const u32x4*)(Vg + (size_t)j * DIN + ch * 8);
            LAS bf16_t* dst = Vt + (ch * 8) * 136 + j;
            dst[0 * 136] = (bf16_t)v.x; dst[1 * 136] = (bf16_t)(v.x >> 16); dst[2 * 136] = (bf16_t)v.y; dst[3 * 136] = (bf16_t)(v.y >> 16);
            dst[4 * 136] = (bf16_t)v.z; dst[5 * 136] = (bf16_t)(v.z >> 16); dst[6 * 136] = (bf16_t)v.w; dst[7 * 136] = (bf16_t)(v.w >> 16);
        }
    }
    __syncthreads();
    {
        bf16_t* VTg = (bf16_t*)(p.ws + WS_VT) + (size_t)u * 32768;
#pragma unroll
        for (int it = 0; it < 8; ++it) { const int piece = tid + 512 * it, e = piece >> 4, jc = piece & 15;
            *(u32x4*)(VTg + e * 128 + jc * 8) = *(const LAS u32x4*)(Vt + e * 136 + jc * 8); }
    }
    f32x4 acc[8][2];
#pragma unroll
    for (int mt = 0; mt < 8; ++mt) { acc[mt][0] = (f32x4){0.f, 0.f, 0.f, 0.f}; acc[mt][1] = (f32x4){0.f, 0.f, 0.f, 0.f}; }
#pragma unroll
    for (int kc = 0; kc < 4; ++kc) {
        const bf16x8 b0 = *(const LAS bf16x8*)(Vt + (32 * w + fr) * 136 + kc * 32 + fq * 8);
        const bf16x8 b1 = *(const LAS bf16x8*)(Vt + (32 * w + 16 + fr) * 136 + kc * 32 + fq * 8);
#pragma unroll
        for (int mt = 0; mt < 8; ++mt) {
            const bf16x8 a = *(const LAS bf16x8*)(Kt + (16 * mt + fr) * 136 + kc * 32 + fq * 8);
            acc[mt][0] = mfma16(a, b0, acc[mt][0]); acc[mt][1] = mfma16(a, b1, acc[mt][1]);
        }
    }
    float* KVT = (float*)(p.ws + WS_F) + (size_t)u * 32768;
#pragma unroll
    for (int nt = 0; nt < 2; ++nt)
#pragma unroll
        for (int mt = 0; mt < 8; ++mt) *(f32x4*)(KVT + (32 * w + 16 * nt + fr) * 128 + 16 * mt + 4 * fq) = acc[mt][nt];
    __syncthreads();
}

__device__ __forceinline__ void attn_unit(const Params& p, LAS unsigned char* lds, int u) {
    const int tid = threadIdx.x, lane = tid & 63, w = tid >> 6, fr = lane & 15, fq = lane >> 4;
    const int kvh = u & 3, qb = (u >> 2) & 31, b = u >> 7;
    const int rowq0 = b * 4096 + qb * 128, rowk0 = rowq0 - 128;
    const bf16_t* PROJ = (const bf16_t*)(p.ws + WS_PROJ);
    bf16_t* OA = (bf16_t*)(p.ws + WS_OA);
    LAS bf16_t* Vt = (LAS bf16_t*)lds;
    {
        const int s = tid & 255, hf = tid >> 8;
        const bool ok = (qb > 0) || (s >= 128);
#pragma unroll
        for (int it = 0; it < 4; ++it) {
            const int ch = hf * 4 + it;
            u32x4 v = {0u, 0u, 0u, 0u};
            if (ok) v = *(const u32x4*)(PROJ + (size_t)(rowk0 + s) * DIN + C_VA + kvh * 64 + ch * 8);
            LAS bf16_t* dst = Vt + (ch * 8) * 296 + s;
            dst[0 * 296] = (bf16_t)v.x; dst[1 * 296] = (bf16_t)(v.x >> 16); dst[2 * 296] = (bf16_t)v.y; dst[3 * 296] = (bf16_t)(v.y >> 16);
            dst[4 * 296] = (bf16_t)v.z; dst[5 * 296] = (bf16_t)(v.z >> 16); dst[6 * 296] = (bf16_t)v.w; dst[7 * 296] = (bf16_t)(v.w >> 16);
        }
        const int d = tid >> 3, k4 = (tid & 7) * 4;
        *(LAS u32x2*)(Vt + d * 296 + 256 + k4) = (u32x2){0u, 0u};
    }
    __syncthreads();
    const int g = w >> 1, hh = kvh * 4 + g;
    const float slope = exp2f(-0.5f * (float)(hh + 1));
    const float sink = p.in[I_SINK][hh];
#pragma unroll 1
    for (int qt = 0; qt < 4; ++qt) {
        const int a0 = (w & 1) * 64 + 16 * qt, a = a0 + fr, kt0 = a0 >> 4;
        const bf16_t* qp = PROJ + (size_t)(rowq0 + a) * DIN + C_QA + hh * 64 + fq * 8;
        const bf16x8 q0 = *(const bf16x8*)qp, q1 = *(const bf16x8*)(qp + 32);
        f32x4 s[10];
#pragma unroll
        for (int kt = 0; kt < 10; ++kt) {
            const int sidx = 16 * (kt0 + kt) + fr;
            int krow = rowk0 + sidx;
            if (sidx > 255) krow = rowq0;
            if (krow < 0) krow = 0;
            const bf16_t* kp = PROJ + (size_t)krow * DIN + C_KA + kvh * 64 + fq * 8;
            const bf16x8 k0 = *(const bf16x8*)kp, k1 = *(const bf16x8*)(kp + 32);
            f32x4 z = {0.f, 0.f, 0.f, 0.f};
            z = mfma16(k0, q0, z); s[kt] = mfma16(k1, q1, z);
        }
        float m = sink;
#pragma unroll
        for (int kt = 0; kt < 10; ++kt)
#pragma unroll
            for (int jj = 0; jj < 4; ++jj) {
                const int sidx = 16 * (kt0 + kt) + 4 * fq + jj, dist = 128 + a - sidx;
                const bool valid = dist >= 0 && dist <= 128 && (qb > 0 || sidx >= 128);
                const float sc = valid ? s[kt][jj] * 0.125f - slope * (float)dist : -INFINITY;
                s[kt][jj] = sc; m = fmaxf(m, sc);
            }
        m = fmaxf(m, __shfl_xor(m, 16)); m = fmaxf(m, __shfl_xor(m, 32));
        float l = 0.f;
#pragma unroll
        for (int kt = 0; kt < 10; ++kt)
#pragma unroll
            for (int jj = 0; jj < 4; ++jj) { const float e = __expf(s[kt][jj] - m); s[kt][jj] = e; l += e; }
        l += __shfl_xor(l, 16); l += __shfl_xor(l, 32);
        l += __expf(sink - m);
        f32x4 o[4];
#pragma unroll
        for (int dt = 0; dt < 4; ++dt) o[dt] = (f32x4){0.f, 0.f, 0.f, 0.f};
#pragma unroll
        for (int cc = 0; cc < 5; ++cc) {
            union { bf16x8 v; u32x4 w; } pf;
            pf.w.x = cvt_pk_bf16(s[2 * cc][0], s[2 * cc][1]); pf.w.y = cvt_pk_bf16(s[2 * cc][2], s[2 * cc][3]);
            pf.w.z = cvt_pk_bf16(s[2 * cc + 1][0], s[2 * cc + 1][1]); pf.w.w = cvt_pk_bf16(s[2 * cc + 1][2], s[2 * cc + 1][3]);
#pragma unroll
            for (int dt = 0; dt < 4; ++dt) {
                const LAS bf16_t* vp = Vt + (16 * dt + fr) * 296 + 16 * (kt0 + 2 * cc) + 4 * fq;
                union { bf16x8 v; u32x2 h[2]; } af;
                af.h[0] = *(const LAS u32x2*)vp; af.h[1] = *(const LAS u32x2*)(vp + 16);
                o[dt] = mfma16(af.v, pf.v, o[dt]);
            }
        }
        const float inv = 1.0f / l;
        bf16_t* op = OA + (size_t)(rowq0 + a) * 1024 + hh * 64 + 4 * fq;
#pragma unroll
        for (int dt = 0; dt < 4; ++dt) { u32x2 wv; wv.x = cvt_pk_bf16(o[dt][0] * inv, o[dt][1] * inv); wv.y = cvt_pk_bf16(o[dt][2] * inv, o[dt][3] * inv); *(u32x2*)(op + 16 * dt) = wv; }
    }
    __syncthreads();
}

__device__ __forceinline__ void sattn_unit(const Params& p, LAS unsigned char* lds, int u) {
    const int tid = threadIdx.x, lane = tid & 63, w = tid >> 6;
    const int kvh = u & 3, n = u >> 2;
    const bf16_t* PROJ = (const bf16_t*)(p.ws + WS_PROJ);
    bf16_t* OA = (bf16_t*)(p.ws + WS_OA);
    LAS float* Ks = (LAS float*)lds;
    LAS float* Vs = Ks + 136 * 65;
    LAS float* Qs = Vs + 136 * 64;
    LAS float* Ps = Qs + 2048;
    const float* ck = p.in[I_CK]; const float* cv = p.in[I_CV];
    {
        f32x4 kq[4], vq[4];
#pragma unroll
        for (int t = 0; t < 4; ++t) { const int pc = tid + 512 * t, sr = pc >> 4, d4 = (pc & 15) * 4; const size_t o = ((size_t)(n * 128 + sr)) * 256 + kvh * 64 + d4;
            kq[t] = *(const f32x4*)(ck + o); vq[t] = *(const f32x4*)(cv + o); }
        const bf16_t* rn = PROJ + (size_t)(NP + n * 8 + (tid >> 6)) * DIN + kvh * 64 + (tid & 63);
        const bf16_t kn = rn[C_KA], vn = rn[C_VA];
        const int qr_ = tid >> 4, qd4 = (tid & 15) * 4, qg = qr_ >> 3, qa = qr_ & 7;
        const u32x2 qv = *(const u32x2*)(PROJ + (size_t)(NP + n * 8 + qa) * DIN + C_QA + (kvh * 4 + qg) * 64 + qd4);
#pragma unroll
        for (int t = 0; t < 4; ++t) { const int pc = tid + 512 * t, sr = pc >> 4, d4 = (pc & 15) * 4;
            Ks[sr * 65 + d4] = kq[t][0]; Ks[sr * 65 + d4 + 1] = kq[t][1]; Ks[sr * 65 + d4 + 2] = kq[t][2]; Ks[sr * 65 + d4 + 3] = kq[t][3];
            *(LAS f32x4*)(Vs + sr * 64 + d4) = vq[t]; }
        Ks[(128 + (tid >> 6)) * 65 + (tid & 63)] = bf2f(kn); Vs[(128 + (tid >> 6)) * 64 + (tid & 63)] = bf2f(vn);
        *(LAS f32x4*)(Qs + qr_ * 64 + qd4) = (f32x4){bflo(qv.x), bfhi(qv.x), bflo(qv.y), bfhi(qv.y)};
    }
    __syncthreads();
    float linv[4];
#pragma unroll
    for (int rr = 0; rr < 4; ++rr) {
        const int r = 4 * w + rr, g = r >> 3, a = r & 7, hh = kvh * 4 + g;
        const float slope = exp2f(-0.5f * (float)(hh + 1)), sink = p.in[I_SINK][hh];
        float sc[3]; float m = sink;
#pragma unroll
        for (int t = 0; t < 3; ++t) {
            const int s = lane + 64 * t; sc[t] = -INFINITY;
            if (s < 136) {
                float dot = 0.f;
                for (int d = 0; d < 64; ++d) dot += Qs[r * 64 + d] * Ks[s * 65 + d];
                const int dist = 128 + a - s;
                if (dist >= 0 && dist <= 128) sc[t] = dot * 0.125f - slope * (float)dist;
            }
            m = fmaxf(m, sc[t]);
        }
        m = wave_max(m);
        float l = 0.f;
#pragma unroll
        for (int t = 0; t < 3; ++t) { const int s = lane + 64 * t; const float e = __expf(sc[t] - m); if (s < 136) { Ps[r * 136 + s] = e; l += e; } }
        l = wave_sum(l) + __expf(sink - m);
        linv[rr] = 1.0f / l;
    }
    __syncthreads();
#pragma unroll
    for (int rr = 0; rr < 4; ++rr) {
        const int r = 4 * w + rr, g = r >> 3, a = r & 7, hh = kvh * 4 + g;
        float o = 0.f;
        for (int s = 0; s < 136; ++s) o += Ps[r * 136 + s] * Vs[s * 64 + lane];
        OA[(size_t)(NP + n * 8 + a) * 1024 + hh * 64 + lane] = (bf16_t)(cvt_pk_bf16(o * linv[rr], 0.f) & 0xffffu);
    }
    __syncthreads();
}

__device__ __forceinline__ void sret_unit(const Params& p, LAS unsigned char* lds, int u) {
    const int tid = threadIdx.x, lane = tid & 63, w = tid >> 6;
    const int h = u & 7, n = u >> 3;
    const bf16_t* PROJ = (const bf16_t*)(p.ws + WS_PROJ);
    bf16_t* ORb = (bf16_t*)(p.ws + WS_OR);
    LAS float* qT = (LAS float*)lds;
    LAS float* kT = qT + 1024;
    LAS float* vS = kT + 1024;
    LAS float* SCP = vS + 2048;
    LAS float* PART = SCP + 512;
    const float l2g = log2_gamma(h);
    const float g8 = exp2f(8.0f * l2g), gm8 = exp2f(-8.0f * l2g);
    const size_t rbase = (size_t)(NP + n * 8);
    const int e4 = lane * 4;
    const float* S0 = p.in[I_ST] + ((size_t)(n * 8 + h) * 128) * 256 + e4;
    float* S1 = p.out + O_SRS + ((size_t)(n * 8 + h) * 128) * 256 + e4;
    f32x4 S[16];
#pragma unroll
    for (int it = 0; it < 16; ++it) S[it] = *(const f32x4*)(S0 + (size_t)(w + 8 * it) * 256);
    {
        bf16_t qv[2], kv[2];
#pragma unroll
        for (int t = 0; t < 2; ++t) { const int idx = tid + 512 * t, i = idx >> 7, d = idx & 127; const bf16_t* r = PROJ + (rbase + i) * DIN + h * 128 + d; qv[t] = r[C_QR]; kv[t] = r[C_KR]; }
        const u32x2 v2 = *(const u32x2*)(PROJ + (rbase + w) * DIN + C_VR + h * 256 + e4);
#pragma unroll
        for (int t = 0; t < 2; ++t) { const int idx = tid + 512 * t, i = idx >> 7, d = idx & 127;
            qT[d * 8 + i] = bf2f(qv[t]) * exp2f((float)(i + 1) * l2g); kT[d * 8 + i] = bf2f(kv[t]) * exp2f((float)(7 - i) * l2g); }
        *(LAS f32x4*)(vS + w * 256 + e4) = (f32x4){bflo(v2.x), bfhi(v2.x), bflo(v2.y), bfhi(v2.y)};
    }
    __syncthreads();
    {
        const int i = lane >> 3, j = lane & 7; float sc = 0.f;
#pragma unroll
        for (int dd = 0; dd < 16; ++dd) { const int d = 16 * w + dd; sc += qT[d * 8 + i] * kT[d * 8 + j]; }
        SCP[w * 64 + lane] = sc;
    }
    f32x4 vv[8], ya[8];
#pragma unroll
    for (int j = 0; j < 8; ++j) { vv[j] = *(const LAS f32x4*)(vS + j * 256 + e4); ya[j] = (f32x4){0.f, 0.f, 0.f, 0.f}; }
#pragma unroll
    for (int it = 0; it < 16; ++it) {
        const int d = w + 8 * it;
        const f32x4 qa = *(const LAS f32x4*)(qT + d * 8), qb = *(const LAS f32x4*)(qT + d * 8 + 4);
        const f32x4 ka = *(const LAS f32x4*)(kT + d * 8), kb = *(const LAS f32x4*)(kT + d * 8 + 4);
        f32x4 sn = S[it] * g8;
        sn += vv[0] * ka[0]; sn += vv[1] * ka[1]; sn += vv[2] * ka[2]; sn += vv[3] * ka[3];
        sn += vv[4] * kb[0]; sn += vv[5] * kb[1]; sn += vv[6] * kb[2]; sn += vv[7] * kb[3];
        *(f32x4*)(S1 + (size_t)d * 256) = sn;
        ya[0] += S[it] * qa[0]; ya[1] += S[it] * qa[1]; ya[2] += S[it] * qa[2]; ya[3] += S[it] * qa[3];
        ya[4] += S[it] * qb[0]; ya[5] += S[it] * qb[1]; ya[6] += S[it] * qb[2]; ya[7] += S[it] * qb[3];
    }
#pragma unroll
    for (int i = 0; i < 8; ++i) *(LAS f32x4*)(PART + (w * 8 + i) * 256 + e4) = ya[i];
    __syncthreads();
    {
        const int i = w;
        f32x4 y = {0.f, 0.f, 0.f, 0.f};
#pragma unroll
        for (int ww = 0; ww < 8; ++ww) y += *(const LAS f32x4*)(PART + (ww * 8 + i) * 256 + e4);
#pragma unroll
        for (int j = 0; j < 8; ++j) {
            float sc = 0.f;
#pragma unroll
            for (int ww = 0; ww < 8; ++ww) sc += SCP[ww * 64 + i * 8 + j];
            if (j <= i) y += vv[j] * (sc * gm8);
        }
        const float ss = wave_sum((y[0] * y[0] + y[1] * y[1]) + (y[2] * y[2] + y[3] * y[3]));
        const float rstd = rsqrtf(ss * (1.0f / 256.0f) + EPS);
        const u32x2 gv = *(const u32x2*)(PROJ + (rbase + i) * DIN + C_GR + h * 256 + e4);
        u32x2 wv; wv.x = cvt_pk_bf16(y[0] * rstd * bflo(gv.x), y[1] * rstd * bfhi(gv.x)); wv.y = cvt_pk_bf16(y[2] * rstd * bflo(gv.y), y[3] * rstd * bfhi(gv.y));
        *(u32x2*)(ORb + (rbase + i) * D + h * 256 + e4) = wv;
    }
    __syncthreads();
}

__device__ __forceinline__ void phase_mix1(const Params& p, LAS unsigned char* lds) {
    const int G = gridDim.x;
    for (int u = blockIdx.x; u < 512; u += G) kv_unit(p, lds, u);
    for (int u = blockIdx.x; u < 256; u += G) attn_unit(p, lds, u);
    for (int u = blockIdx.x; u < 512; u += G) sattn_unit(p, lds, u);
    for (int u = blockIdx.x; u < 1024; u += G) sret_unit(p, lds, u);
    const bf16_t* PROJ = (const bf16_t*)(p.ws + WS_PROJ);
    const int gt = blockIdx.x * 512 + threadIdx.x, NGT = G * 512;
    for (int i = gt; i < 2 * 65536 / 4; i += NGT) {
        const int which = i >> 14, r = i & 16383, bw = r >> 6, c4 = (r & 63) * 4, b = bw >> 7, wdx = bw & 127;
        const u32x2 v = *(const u32x2*)(PROJ + (size_t)(b * 4096 + 3968 + wdx) * DIN + (which ? C_VA : C_KA) + c4);
        *(f32x4*)(p.out + (which ? O_VWP : O_KWP) + (size_t)bw * 256 + c4) = (f32x4){bflo(v.x), bfhi(v.x), bflo(v.y), bfhi(v.y)};
    }
    for (int i0 = gt; i0 < 2 * 4194304 / 4; i0 += 4 * NGT) {
        f32x4 o[4];
#pragma unroll
        for (int t = 0; t < 4; ++t) {
            const int i = i0 + t * NGT;
            if (i < 2 * 4194304 / 4) {
                const int which = i >> 20, r = i & 1048575, nw = r >> 6, c4 = (r & 63) * 4, n = nw >> 7, wdx = nw & 127;
                if (wdx < 120) o[t] = *(const f32x4*)((which ? p.in[I_CV] : p.in[I_CK]) + ((size_t)(n * 128 + wdx + 8)) * 256 + c4);
                else { const u32x2 v = *(const u32x2*)(PROJ + (size_t)(NP + n * 8 + (wdx - 120)) * DIN + (which ? C_VA : C_KA) + c4); o[t] = (f32x4){bflo(v.x), bfhi(v.x), bflo(v.y), bfhi(v.y)}; }
            }
        }
#pragma unroll
        for (int t = 0; t < 4; ++t) {
            const int i = i0 + t * NGT;
            if (i < 2 * 4194304 / 4) { const int which = i >> 20, r = i & 1048575, nw = r >> 6, c4 = (r & 63) * 4; *(f32x4*)(p.out + (which ? O_VWS : O_KWS) + (size_t)nw * 256 + c4) = o[t]; }
        }
    }
}

__device__ __forceinline__ void phase_scan(const Params& p) {
    const float* KVT = (const float*)(p.ws + WS_F);
    bf16_t* SPT = (bf16_t*)(p.ws + WS_SPT);
    const int gt = blockIdx.x * 512 + threadIdx.x, NGT = gridDim.x * 512;
    for (int it = gt; it < 16 * 8192; it += NGT) {
        const int bh = it >> 13, rem = it & 8191, e = rem >> 5, d4 = (rem & 31) * 4, h = bh & 7;
        const float g128 = exp2f(128.0f * log2_gamma(h));
        f32x4 S = {0.f, 0.f, 0.f, 0.f};
        const size_t off = (size_t)e * 128 + d4;
        f32x4 kvr[32];
#pragma unroll
        for (int c = 0; c < 32; ++c) kvr[c] = *(const f32x4*)(KVT + (size_t)(bh * 32 + c) * 32768 + off);
#pragma unroll
        for (int c = 0; c < 32; ++c) {
            const size_t uo = (size_t)(bh * 32 + c) * 32768 + off;
            u32x2 wv; wv.x = cvt_pk_bf16(S[0], S[1]); wv.y = cvt_pk_bf16(S[2], S[3]);
            *(u32x2*)(SPT + uo) = wv;
            S = S * g128 + kvr[c];
        }
        float* so = p.out + O_SRP + (size_t)bh * 32768 + e;
        so[(size_t)(d4 + 0) * 256] = S[0]; so[(size_t)(d4 + 1) * 256] = S[1]; so[(size_t)(d4 + 2) * 256] = S[2]; so[(size_t)(d4 + 3) * 256] = S[3];
    }
}

__device__ __forceinline__ void phase_ret3(const Params& p) {
    const int tid = threadIdx.x, lane = tid & 63, w = tid >> 6, fr = lane & 15, fq = lane >> 4;
    const bf16_t* PROJ = (const bf16_t*)(p.ws + WS_PROJ);
    bf16_t* ORb = (bf16_t*)(p.ws + WS_OR);
    for (int u = blockIdx.x; u < 512; u += gridDim.x) {
        const int c = u & 31, bh = u >> 5, h = bh & 7, b = bh >> 3;
        const int row0 = b * 4096 + c * 128, i0 = 16 * w, irow = row0 + i0 + fr;
        const float l2g = log2_gamma(h);
        const bf16_t* SPTu = (const bf16_t*)(p.ws + WS_SPT) + (size_t)u * 32768;
        const bf16_t* VTu = (const bf16_t*)(p.ws + WS_VT) + (size_t)u * 32768;
        bf16x8 Qf[4];
        { const bf16_t* qp = PROJ + (size_t)irow * DIN + C_QR + h * 128 + fq * 8;
#pragma unroll
          for (int kc = 0; kc < 4; ++kc) Qf[kc] = *(const bf16x8*)(qp + kc * 32); }
        f32x4 sa[8];
#pragma unroll
        for (int jt = 0; jt < 8; ++jt) {
            sa[jt] = (f32x4){0.f, 0.f, 0.f, 0.f};
            if (jt <= w) {
                const bf16_t* kp = PROJ + (size_t)(row0 + 16 * jt + fr) * DIN + C_KR + h * 128 + fq * 8;
#pragma unroll
                for (int kc = 0; kc < 4; ++kc) sa[jt] = mfma16(*(const bf16x8*)(kp + kc * 32), Qf[kc], sa[jt]);
            }
        }
        const int ii = i0 + fr;
#pragma unroll
        for (int jt = 0; jt < 8; ++jt)
#pragma unroll
            for (int jj = 0; jj < 4; ++jj) { const int dj = ii - (16 * jt + 4 * fq + jj); sa[jt][jj] = dj >= 0 ? sa[jt][jj] * exp2f((float)dj * l2g) : 0.f; }
        union { bf16x8 v; u32x4 q; } Pf[4];
#pragma unroll
        for (int cc = 0; cc < 4; ++cc) {
            Pf[cc].q.x = cvt_pk_bf16(sa[2 * cc][0], sa[2 * cc][1]); Pf[cc].q.y = cvt_pk_bf16(sa[2 * cc][2], sa[2 * cc][3]);
            Pf[cc].q.z = cvt_pk_bf16(sa[2 * cc + 1][0], sa[2 * cc + 1][1]); Pf[cc].q.w = cvt_pk_bf16(sa[2 * cc + 1][2], sa[2 * cc + 1][3]);
        }
        const float qw = exp2f((float)(ii + 1) * l2g);
        f32x4 y[16];
#pragma unroll
        for (int et = 0; et < 16; ++et) {
            f32x4 a = {0.f, 0.f, 0.f, 0.f};
            const bf16_t* sp = SPTu + (16 * et + fr) * 128 + fq * 8;
#pragma unroll
            for (int kc = 0; kc < 4; ++kc) a = mfma16(*(const bf16x8*)(sp + kc * 32), Qf[kc], a);
            a = a * qw;
            const bf16_t* vp = VTu + (16 * et + fr) * 128 + 4 * fq;
#pragma unroll
            for (int cc = 0; cc < 4; ++cc) {
                if (2 * cc <= w) {
                    union { bf16x8 v; u32x2 hh[2]; } af;
                    af.hh[0] = *(const u32x2*)(vp + 32 * cc); af.hh[1] = *(const u32x2*)(vp + 32 * cc + 16);
                    a = mfma16(af.v, Pf[cc].v, a);
                }
            }
            y[et] = a;
        }
        float ss = 0.f;
#pragma unroll
        for (int et = 0; et < 16; ++et) ss += (y[et][0] * y[et][0] + y[et][1] * y[et][1]) + (y[et][2] * y[et][2] + y[et][3] * y[et][3]);
        ss += __shfl_xor(ss, 16); ss += __shfl_xor(ss, 32);
        const float rstd = rsqrtf(ss * (1.0f / 256.0f) + EPS);
        const bf16_t* gp = PROJ + (size_t)irow * DIN + C_GR + h * 256 + 4 * fq;
        bf16_t* op = ORb + (size_t)irow * D + h * 256 + 4 * fq;
#pragma unroll
        for (int et = 0; et < 16; ++et) {
            const u32x2 gv = *(const u32x2*)(gp + 16 * et);
            u32x2 wv; wv.x = cvt_pk_bf16(y[et][0] * rstd * bflo(gv.x), y[et][1] * rstd * bfhi(gv.x)); wv.y = cvt_pk_bf16(y[et][2] * rstd * bflo(gv.y), y[et][3] * rstd * bfhi(gv.y));
            *(u32x2*)(op + 16 * et) = wv;
        }
    }
}

#define XB_TMO      128
#define XB_XCNT(j)  (256  + 64 * (j))
#define XB_XSUB(j)  (1280 + 64 * (j))
#define XB_XGEN(j)  (2304 + 64 * (j))
#define XB_TOP      3328
#define XB_TOPGEN   3392
#define XCD_BAR_WORDS 3456
#define XB_SPIN_CAP (1u << 18)

__device__ __forceinline__ unsigned xb_ld(unsigned* p)              { return __hip_atomic_load(p, __ATOMIC_RELAXED, __HIP_MEMORY_SCOPE_AGENT); }
__device__ __forceinline__ unsigned xb_add(unsigned* p, unsigned v) { return __hip_atomic_fetch_add(p, v, __ATOMIC_RELAXED, __HIP_MEMORY_SCOPE_AGENT); }
__device__ __forceinline__ unsigned xb_xcc_id() { return (unsigned)__builtin_amdgcn_s_getreg((3 << 11) | 20) & 0xFu; }
#define XB_SPIN(cond, bar) do { unsigned _sp = 0; while (cond) { __builtin_amdgcn_s_sleep(1); \
    if ((++_sp & 255u) == 0u) { if (xb_ld(&(bar)[XB_TMO])) break; if (_sp > XB_SPIN_CAP) { atomicAdd(&(bar)[XB_TMO], 1u); break; } } } } while (0)

struct XcdBarrier {
    unsigned* bar; unsigned x;
    volatile LAS unsigned* st;
};

__device__ __forceinline__ XcdBarrier xcd_barrier_post(unsigned* bar, volatile LAS unsigned* st) {
    XcdBarrier b; b.bar = bar; b.x = xb_xcc_id(); b.st = st;
    if (threadIdx.x == 0) (void)xb_add(&bar[XB_XCNT(b.x)], 1u);
    return b;
}
__device__ __forceinline__ void xcd_barrier_complete(unsigned* bar, unsigned x, unsigned& nloc, unsigned& nx) {
    const unsigned G = gridDim.x * gridDim.y * gridDim.z;
    unsigned sum, cnt, mine, sp = 0u;
    for (;;) {
        sum = 0u; cnt = 0u; mine = 0u;
#pragma unroll
        for (unsigned j = 0; j < 16; ++j) { const unsigned c = xb_ld(&bar[XB_XCNT(j)]); sum += c; cnt += (c > 0u) ? 1u : 0u; mine = (j == x) ? c : mine; }
        if (sum == G) break;
        __builtin_amdgcn_s_sleep(1);
        if ((++sp & 255u) == 0u) { if (xb_ld(&bar[XB_TMO])) break; if (sp > XB_SPIN_CAP) { atomicAdd(&bar[XB_TMO], 1u); break; } }
    }
    nloc = mine > 0u ? mine : 1u; nx = cnt > 0u ? cnt : 1u;
}

__device__ __forceinline__ void xcd_barrier(const XcdBarrier& b) {
    asm volatile("s_waitcnt vmcnt(0)" ::: "memory");
    __syncthreads();
    if (threadIdx.x == 0) {
        unsigned* bar = b.bar;
        __builtin_amdgcn_s_waitcnt(0);
        unsigned nloc = b.st[0], nx = b.st[1];
        if (nloc == 0u) { xcd_barrier_complete(bar, b.x, nloc, nx); b.st[0] = nloc; b.st[1] = nx; }
        const unsigned old = xb_add(&bar[XB_XSUB(b.x)], 1u);
        const unsigned gen = old / nloc;
        if (old + 1u == (gen + 1u) * nloc) {
            __builtin_amdgcn_fence(__ATOMIC_RELEASE, "agent");
            asm volatile("s_waitcnt vmcnt(0)" ::: "memory");
            const unsigned og = xb_add(&bar[XB_TOP], 1u);
            const unsigned tg = og / nx;
            if (og + 1u == (tg + 1u) * nx) xb_add(&bar[XB_TOPGEN], 1u);
            else XB_SPIN(xb_ld(&bar[XB_TOPGEN]) == tg, bar);
            __builtin_amdgcn_fence(__ATOMIC_ACQUIRE, "agent");
            xb_add(&bar[XB_XGEN(b.x)], 1u);
            asm volatile("s_waitcnt vmcnt(0)" ::: "memory");
        } else {
            XB_SPIN(xb_ld(&bar[XB_XGEN(b.x)]) == gen, bar);
            __builtin_amdgcn_fence(__ATOMIC_ACQUIRE, "agent");
            asm volatile("s_waitcnt vmcnt(0)" ::: "memory");
        }
    }
    __syncthreads();
}


__device__ __forceinline__ void gemm_part(const Params& p, LAS unsigned char* lds, int which) {
    unsigned char* ws = p.ws;
    EpiPart E; E.P01 = (bf16_t*)(ws + WS_F); E.P23 = (bf16_t*)(ws + WS_PART23);
    const bf16_t* A; const bf16_t* Bt; int K;
    if (which == 1) { A = (const bf16_t*)(ws + WS_PROJ); Bt = (const bf16_t*)(ws + WS_WD1); K = DFF; }
    else if (which == 2) { A = (const bf16_t*)(ws + WS_HB); Bt = (const bf16_t*)(ws + WS_WO); K = D; }
    else { A = (const bf16_t*)(ws + WS_PROJ); Bt = (const bf16_t*)(ws + WS_WD2); K = DFF; }
    run_gemm(lds, A, Bt, MT, D, K, E, 4);
}
__device__ __forceinline__ void gemm_gu(const Params& p, LAS unsigned char* lds, int which) {
    unsigned char* ws = p.ws;
    EpiSwiGLU E; E.O = (bf16_t*)(ws + WS_PROJ);
    run_gemm(lds, (const bf16_t*)(ws + WS_HB), (const bf16_t*)(ws + (which == 0 ? WS_WGU1 : WS_WGU2)), MT, 2 * DFF, D, E);
}
__device__ __forceinline__ void gemm_win(const Params& p, LAS unsigned char* lds) {
    unsigned char* ws = p.ws;
    EpiWin E; E.O = (bf16_t*)(ws + WS_PROJ); E.rc = (const float*)(ws + WS_ROTC); E.rs = (const float*)(ws + WS_ROTS);
    run_gemm(lds, (const bf16_t*)(ws + WS_HB), (const bf16_t*)(ws + WS_WIN), MT, DIN, D, E);
}
__device__ __forceinline__ void gemm_papr(const Params& p, LAS unsigned char* lds) {
    unsigned char* ws = p.ws;
    EpiPa E1; E1.T = (float*)(ws + WS_F); E1.P = (const bf16_t*)(ws + WS_PROJ);
    run_gemm(lds, (const bf16_t*)(ws + WS_OA), (const bf16_t*)(ws + WS_WPA), MT, D, 1024, E1);
    EpiPr E2; E2.T = (const float*)(ws + WS_F); E2.P = (const bf16_t*)(ws + WS_PROJ); E2.O = (bf16_t*)(ws + WS_HB);
    run_gemm(lds, (const bf16_t*)(ws + WS_OR), (const bf16_t*)(ws + WS_WPR), MT, D, D, E2);
}

#ifndef XSYNC
#define XSYNC 0
#endif
#ifndef DUPMASK
#define DUPMASK 0
#endif
#ifndef PHMASK
#define PHMASK 0xFFFF
#endif
#define PHASE(k, body) if (((PHMASK >> (k)) & 1) && p.ph_lo <= (k) && (k) < p.ph_hi) { if ((k) > p.ph_lo) { xcd_barrier(xb); for (int _x = 0; _x < XSYNC; ++_x) xcd_barrier(xb); } body; if ((DUPMASK >> (k)) & 1) { xcd_barrier(xb); body; } }
__global__ __launch_bounds__(512, 2) void mega(Params p) {
    extern __shared__ __attribute__((aligned(16))) unsigned char shm[];
    LAS unsigned char* lds = (LAS unsigned char*)shm;
    cg::grid_group grid = cg::this_grid();
    if (p.ph_lo < 0) grid.sync();
    volatile LAS unsigned* xst = (volatile LAS unsigned*)(lds + LDS_BYTES - 16);
    if (threadIdx.x == 0) { xst[0] = 0u; xst[1] = 0u; }
    __syncthreads();
    const XcdBarrier xb = xcd_barrier_post((unsigned*)p.ws, xst);
    PHASE(PH_PREP, phase_prep(p, lds))
    PHASE(PH_ADA, phase_ada(p, lds))
    PHASE(PH_ROW0, phase_row<0>(p))
    PHASE(PH_GU1, (gemm_gu(p, lds, 0), tail_tjobs(p, lds, 36 * 44, 2, 3), tail_tjobs(p, lds, 36 * 44, 7, 8)))
    PHASE(PH_D1, (gemm_part(p, lds, 1), tail_tjobs(p, lds, 36 * 8 * 4, 4, 7), tail_tjobs(p, lds, 36 * 8 * 4, 3, 4, 8832)))
    PHASE(PH_ROW1, phase_row<1>(p))
    PHASE(PH_WIN, (gemm_win(p, lds), tail_tjobs(p, lds, 36 * 46, 8, 9)))
    PHASE(PH_MIX1, phase_mix1(p, lds))
    PHASE(PH_SCAN, phase_scan(p))
    PHASE(PH_RET3, phase_ret3(p))
    PHASE(PH_PAPR, (gemm_papr(p, lds), tail_tjobs(p, lds, 36 * 8, 9, 10)))
    PHASE(PH_WO, gemm_part(p, lds, 2))
    PHASE(PH_ROW2, phase_row<2>(p))
    PHASE(PH_GU2, gemm_gu(p, lds, 1))
    PHASE(PH_D2, gemm_part(p, lds, 3))
    PHASE(PH_ROW3, phase_row<3>(p))
}

extern "C" void kernel_launch(void* const* d_in, const int* in_sizes, int n_in, void* d_out, int out_size, void* d_ws, size_t ws_size, hipStream_t stream) {
    static int grid = 0;
    if (grid == 0) {
        if (n_in != 22 || ws_size < WS_END) { fprintf(stderr, "kernel_launch: need 22 inputs and %zu bytes of workspace (got %d, %zu)\n", (size_t)WS_END, n_in, ws_size); grid = -1; return; }
        int dev = 0, cus = 0, per_cu = 0;
        (void)hipGetDevice(&dev);
        (void)hipDeviceGetAttribute(&cus, hipDeviceAttributeMultiprocessorCount, dev);
        if (hipFuncSetAttribute((const void*)mega, hipFuncAttributeMaxDynamicSharedMemorySize, LDS_BYTES) != hipSuccess) { fprintf(stderr, "kernel_launch: hipFuncSetAttribute failed\n"); grid = -1; return; }
        if (hipOccupancyMaxActiveBlocksPerMultiprocessor(&per_cu, (const void*)mega, 512, LDS_BYTES) != hipSuccess || per_cu < 1) { fprintf(stderr, "kernel_launch: occupancy query says %d\n", per_cu); per_cu = 1; }
        (void)hipGetLastError();
        grid = cus;
        if (grid <= 0) grid = 256;
    }
    if (grid < 0) return;
    if (hipMemsetAsync(d_ws, 0, XCD_BAR_WORDS * sizeof(unsigned), stream) != hipSuccess) { fprintf(stderr, "kernel_launch: memset of the barrier words failed\n"); return; }
    Params p{};
    for (int i = 0; i < 22; ++i) p.in[i] = (const float*)d_in[i];
    p.out = (float*)d_out; p.ws = (unsigned char*)d_ws;
#if MK_SPLIT
    for (int ph = 0; ph < NPH; ++ph) {
        p.ph_lo = ph; p.ph_hi = ph + 1;
        void* args[] = {&p};
        hipError_t e = hipLaunchCooperativeKernel((const void*)mega, dim3(grid), dim3(512), args, LDS_BYTES, stream);
        if (e != hipSuccess) { fprintf(stderr, "cooperative launch failed: %s (grid %d)\n", hipGetErrorString(e), grid); break; }
    }
#else
    p.ph_lo = 0; p.ph_hi = NPH;
    void* args[] = {&p};
    hipError_t e = hipLaunchCooperativeKernel((const void*)mega, dim3(grid), dim3(512), args, LDS_BYTES, stream);
    if (e != hipSuccess) fprintf(stderr, "cooperative launch failed: %s (grid %d)\n", hipGetErrorString(e), grid);
#endif
}
```

```cpp
#include <hip/hip_runtime.h>
#include <hip/hip_cooperative_groups.h>
#include <cstdio>
#include <cstdint>
namespace cg = cooperative_groups;

#ifndef MK_SPLIT
#define MK_SPLIT 0
#endif

namespace pg8 {
#define PG8_LAS __attribute__((address_space(3)))
typedef unsigned short bf16_t;
typedef short bf16x8 __attribute__((ext_vector_type(8)));
typedef float f32x4 __attribute__((ext_vector_type(4)));
typedef unsigned u32x4 __attribute__((ext_vector_type(4)));
typedef unsigned u32x2 __attribute__((ext_vector_type(2)));
constexpr int BM = 256, BK = 64, HALF = 128, HTB = HALF * BK * 2  , STAGE_BYTES = 8 * HTB, NXCD = 8, WGM = 8;

__host__ __device__ __forceinline__ int lds_byte(int r, int c) { const int st = (r >> 4) * 2 + (c >> 5), rr = r & 15, cc = c & 31, ob = rr * 64 + cc * 2; return st * 1024 + (ob ^ (((ob >> 9) & 1) << 5)); }
__host__ __device__ __forceinline__ void stage_rc(int b, int& R, int& C) { const int st = b / 1024, sb = b % 1024, swz = sb ^ (((sb >> 9) & 1) << 5); R = (st >> 1) * 16 + swz / 64; C = (st & 1) * 32 + (swz % 64) / 2; }
__host__ __device__ __forceinline__ int perm32(int rho) { const int n = rho >> 4, i = rho & 15; return 8 * (i >> 2) + 4 * n + (i & 3); }

struct Unit { int pm, pn, ks; };
struct Gemm { const bf16_t* A; const bf16_t* Bt; int M, N, K, ld; };

struct StaticOrder {
    int nM, nN, nwg, G, c, ns;
    __host__ __device__ void init(int M, int N, int G_, int c_, int ns_ = 1) { nM = M / BM; nN = N / BM; nwg = nM * nN; G = G_; c = c_; ns = ns_; }
    __host__ __device__ bool next(int i, Unit& u) const {
        const long L = (long)i * G + c; if (L >= (long)nwg * ns) return false;
        u.ks = (int)(L / nwg);
        int wgid = (int)(L - (long)u.ks * nwg); { const int q = nwg / NXCD, r = nwg % NXCD, xcd = wgid % NXCD, off = wgid / NXCD; wgid = (xcd < r ? xcd * (q + 1) : r * (q + 1) + (xcd - r) * q) + off; }
        const int nig = WGM * nN, gid = wgid / nig, fm = gid * WGM, gsz = (nM - fm) < WGM ? (nM - fm) : WGM;
        u.pm = fm + ((wgid % nig) % gsz); u.pn = (wgid % nig) / gsz; return true;
    }
    __device__ __forceinline__ void a_ready(const Unit&) const {}
    __device__ __forceinline__ void done(const Unit&) const {}
};

typedef float f32x2_cv __attribute__((ext_vector_type(2)));
typedef __bf16 bf16x2_cv __attribute__((ext_vector_type(2)));
__device__ __forceinline__ unsigned cvt_pk_bf16(float lo, float hi) { const f32x2_cv v = {lo, hi}; const bf16x2_cv b = __builtin_convertvector(v, bf16x2_cv); return __builtin_bit_cast(unsigned, b); }

template <class Epi, class Sched>
__device__ __forceinline__ void gemm_phase(PG8_LAS unsigned char* lds, const Gemm g, const Sched& S, const Epi& E) {
    int tid_ = threadIdx.x; asm volatile("" : "+v"(tid_));
    const int tid = tid_, wid = __builtin_amdgcn_readfirstlane(tid >> 6), lane = tid & 63, wr = wid >> 2, wc = wid & 3, fr = lane & 15, fq = lane >> 4;
    const int K = g.ld, nt = g.K / BK;
    unsigned voffA[2], voffB[2];
#pragma unroll
    for (int i = 0; i < 2; ++i) { int R, C; stage_rc(tid * 16 + i * 8192, R, C); const int Rb = Epi::PERM ? ((R & ~31) + perm32(R & 31)) : R;
        voffA[i] = (unsigned)(R * K + C) * 2u; voffB[i] = (unsigned)(Rb * K + C) * 2u; }
    const size_t kstep = (size_t)(BK * 2);
    const size_t hstep = (size_t)HALF * K * 2;
    const size_t tstep = 2 * hstep;
    const unsigned ldsw = (unsigned)wid * 1024u;
    const int aoff = lds_byte(wr * 64 + fr, fq * 8), boff = lds_byte(wc * 32 + fr, fq * 8);
#define PG8_SA(b, h) (((b) * 2 + (h)) * HTB)
#define PG8_SB(b, h) ((4 + (b) * 2 + (h)) * HTB)
#define PG8_STAGE(bufoff, gbase, voff) do { _Pragma("unroll") for (int _i = 0; _i < 2; ++_i) \
        __builtin_amdgcn_global_load_lds((const unsigned*)((const char*)(gbase) + (voff)[_i]), (PG8_LAS unsigned*)(lds + (bufoff) + ldsw + _i * 8192), 16, 0, 0); } while (0)
#define PG8_LDA(dst, b, h) do { _Pragma("unroll") for (int m = 0; m < 4; ++m) _Pragma("unroll") for (int k = 0; k < 2; ++k) dst[m][k] = *(const PG8_LAS bf16x8*)(lds + PG8_SA(b, h) + aoff + m * 2048 + k * 1024); } while (0)
#define PG8_LDB(dst, b, h) do { _Pragma("unroll") for (int n = 0; n < 2; ++n) _Pragma("unroll") for (int k = 0; k < 2; ++k) dst[n][k] = *(const PG8_LAS bf16x8*)(lds + PG8_SB(b, h) + boff + n * 2048 + k * 1024); } while (0)
#define PG8_MMA(ai, bj, At, Bt) do { __builtin_amdgcn_s_setprio(1); _Pragma("unroll") for (int m = 0; m < 4; ++m) _Pragma("unroll") for (int n = 0; n < 2; ++n) _Pragma("unroll") for (int k = 0; k < 2; ++k) \
        acc[ai][bj][m][n] = __builtin_amdgcn_mfma_f32_16x16x32_bf16(Bt[n][k], At[m][k], acc[ai][bj][m][n], 0, 0, 0); __builtin_amdgcn_s_setprio(0); } while (0)
#define PG8_WAIT_V(n) asm volatile("s_waitcnt vmcnt(" #n ")" ::: "memory")
#define PG8_WAIT_L(n) asm volatile("s_waitcnt lgkmcnt(" #n ")" ::: "memory")
#define PG8_BAR __builtin_amdgcn_s_barrier()
#define PG8_SCHED __builtin_amdgcn_sched_barrier(0)
    Unit cur, nxt; int ui = 0;
    if (!S.next(0, cur)) return;
    f32x4 acc[2][2][4][2];
#pragma unroll
    for (int a = 0; a < 2; ++a)
#pragma unroll
        for (int b = 0; b < 2; ++b)
#pragma unroll
            for (int m = 0; m < 4; ++m)
#pragma unroll
                for (int n = 0; n < 2; ++n) acc[a][b][m][n] = (f32x4){0.f, 0.f, 0.f, 0.f};
    bf16x8 At[4][2], B0[2][2], B1[2][2];
    const size_t ksb = (size_t)g.K * 2;
    const char* cA = (const char*)g.A + (size_t)cur.pm * tstep + (size_t)cur.ks * ksb; const char* cB = (const char*)g.Bt + (size_t)cur.pn * tstep + (size_t)cur.ks * ksb;
    S.a_ready(cur);
    PG8_STAGE(PG8_SB(0, 0), cB, voffB); PG8_STAGE(PG8_SB(0, 1), cB + hstep, voffB); PG8_STAGE(PG8_SA(0, 0), cA, voffA); PG8_STAGE(PG8_SA(0, 1), cA + hstep, voffA);
    if (wr == 1) PG8_BAR;
    PG8_WAIT_V(2); PG8_BAR;
    PG8_STAGE(PG8_SB(1, 0), cB + kstep, voffB); PG8_STAGE(PG8_SA(1, 0), cA + kstep, voffA); PG8_STAGE(PG8_SB(1, 1), cB + hstep + kstep, voffB);
    PG8_WAIT_V(6); PG8_BAR;
    for (;;) {
        const bool has_next = S.next(ui + 1, nxt);
        const char* nA = has_next ? (const char*)g.A + (size_t)nxt.pm * tstep + (size_t)nxt.ks * ksb : cA; const char* nB = has_next ? (const char*)g.Bt + (size_t)nxt.pn * tstep + (size_t)nxt.ks * ksb : cB;
        for (int t = 0; t < nt; t += 2) {
            const bool last = (t == nt - 2);
            const char* a1 = cA + (size_t)(t + 1) * kstep;
            const char* a2 = last ? nA : cA + (size_t)(t + 2) * kstep; const char* b2 = last ? nB : cB + (size_t)(t + 2) * kstep;
            const char* a3 = a2 + kstep; const char* b3 = b2 + kstep;
            if (last && has_next) S.a_ready(nxt);
            PG8_LDB(B0, 0, 0); PG8_LDB(B1, 0, 1); PG8_SCHED; PG8_LDA(At, 0, 0); PG8_STAGE(PG8_SA(1, 1), a1 + hstep, voffA);
            PG8_WAIT_V(8); PG8_WAIT_L(0); PG8_BAR; PG8_MMA(0, 0, At, B0); PG8_MMA(0, 1, At, B1); PG8_BAR; PG8_SCHED;
            PG8_LDA(At, 0, 1); PG8_STAGE(PG8_SB(0, 0), b2, voffB); PG8_STAGE(PG8_SB(0, 1), b2 + hstep, voffB); PG8_STAGE(PG8_SA(0, 0), a2, voffA);
            PG8_WAIT_V(8); PG8_WAIT_L(0); PG8_BAR; PG8_MMA(1, 0, At, B0); PG8_MMA(1, 1, At, B1); PG8_BAR; PG8_SCHED;
            PG8_LDB(B0, 1, 0); PG8_LDB(B1, 1, 1); PG8_SCHED; PG8_LDA(At, 1, 0); PG8_STAGE(PG8_SA(0, 1), a2 + hstep, voffA);
            PG8_WAIT_V(8); PG8_WAIT_L(0); PG8_BAR; PG8_MMA(0, 0, At, B0); PG8_MMA(0, 1, At, B1); PG8_BAR; PG8_SCHED;
            PG8_LDA(At, 1, 1); PG8_STAGE(PG8_SB(1, 0), b3, voffB); PG8_STAGE(PG8_SB(1, 1), b3 + hstep, voffB); PG8_STAGE(PG8_SA(1, 0), a3, voffA);
            PG8_WAIT_V(8); PG8_WAIT_L(0); PG8_BAR; PG8_MMA(1, 0, At, B0); PG8_MMA(1, 1, At, B1); PG8_BAR; PG8_SCHED;
        }
        if (wr == 0) PG8_BAR;
        if constexpr (!Epi::AFTER_DRAIN) { E(acc, cur, wr, wc, fr, fq); S.done(cur); }
        if (!has_next) break;
#pragma unroll
        for (int a = 0; a < 2; ++a)
#pragma unroll
            for (int b = 0; b < 2; ++b)
#pragma unroll
                for (int m = 0; m < 4; ++m)
#pragma unroll
                    for (int n = 0; n < 2; ++n) acc[a][b][m][n] = (f32x4){0.f, 0.f, 0.f, 0.f};
        cur = nxt; cA = nA; cB = nB; ++ui;
        if (wr == 1) PG8_BAR;
    }
    PG8_WAIT_V(0);
    PG8_BAR;
    if constexpr (Epi::AFTER_DRAIN) { E.fused(acc, cur, wr, wc, fr, fq, lds, wid, lane); S.done(cur); }
#undef PG8_SA
#undef PG8_SB
#undef PG8_STAGE
#undef PG8_LDA
#undef PG8_LDB
#undef PG8_MMA
#undef PG8_WAIT_V
#undef PG8_WAIT_L
#undef PG8_BAR
#undef PG8_SCHED
}
}

using pg8::bf16_t; using pg8::bf16x8; using pg8::f32x4; using pg8::u32x4; using pg8::u32x2; using pg8::cvt_pk_bf16;
#define LAS __attribute__((address_space(3)))
#define LDS_WAIT() asm volatile("s_waitcnt lgkmcnt(0)" ::: "memory")

constexpr int D = 2048, NP = 8192, NS = 1024, MT = 9216, DFF = 5632, DIN = 11776, NADA = 18432;
constexpr int C_QA = 0, C_KA = 1024, C_VA = 1280, C_QR = 1536, C_KR = 2560, C_VR = 3584, C_GR = 5632, C_GA = 7680, C_GB = 9728;
constexpr float EPS = 1e-6f;
constexpr int LDS_BYTES = 147456;
constexpr int NPH = 16;
enum { PH_PREP = 0, PH_ADA, PH_ROW0, PH_GU1, PH_D1, PH_ROW1, PH_WIN, PH_MIX1, PH_SCAN, PH_RET3, PH_PAPR, PH_WO, PH_ROW2, PH_GU2, PH_D2, PH_ROW3 };

constexpr size_t al256(size_t x) { return (x + 255) & ~(size_t)255; }
constexpr size_t SZ_WGU = (size_t)2 * DFF * D * 2, SZ_WD = (size_t)D * DFF * 2, SZ_WIN = (size_t)DIN * D * 2, SZ_WPA = (size_t)D * 1024 * 2, SZ_WPR = (size_t)D * D * 2, SZ_WO = (size_t)D * D * 2;
constexpr size_t WS_WGU1 = 16384;
constexpr size_t WS_WD1 = WS_WGU1 + SZ_WGU;
constexpr size_t WS_WIN = WS_WD1 + SZ_WD;
constexpr size_t WS_WPA = WS_WIN + SZ_WIN;
constexpr size_t WS_WPR = WS_WPA + SZ_WPA;
constexpr size_t WS_WO = WS_WPR + SZ_WPR;
constexpr size_t WS_WGU2 = WS_WO + SZ_WO;
constexpr size_t WS_WD2 = WS_WGU2 + SZ_WGU;
constexpr size_t WS_MOD = WS_WD2 + SZ_WD;
constexpr size_t WS_CS = WS_MOD + (size_t)256 * NADA * 4;
constexpr size_t WS_ROTC = WS_CS + (size_t)256 * D * 2;
constexpr size_t WS_ROTS = WS_ROTC + al256((size_t)4104 * 64 * 4);
constexpr size_t WS_HB = WS_ROTS + al256((size_t)4104 * 64 * 4);
constexpr size_t WS_F = WS_HB + (size_t)MT * D * 2;
constexpr size_t WS_PROJ = WS_F + (size_t)MT * D * 4;
constexpr size_t WS_PART23 = WS_PROJ + (size_t)MT * DFF * 2;
constexpr size_t WS_OA = WS_PROJ + (size_t)MT * DIN * 2;
constexpr size_t WS_OR = WS_OA + (size_t)MT * 1024 * 2;
constexpr size_t WS_SPT = WS_OR + (size_t)MT * D * 2;
constexpr size_t WS_VT = WS_SPT + (size_t)512 * 32768 * 2;
constexpr size_t WS_END = WS_VT + (size_t)512 * 32768 * 2;

constexpr size_t O_Y = 0, O_KWP = (size_t)MT * D, O_VWP = O_KWP + 65536, O_SRP = O_VWP + 65536, O_KWS = O_SRP + 524288, O_VWS = O_KWS + 4194304, O_SRS = O_VWS + 4194304;

struct Params {
    const float* in[22];
    float* out;
    unsigned char* ws;
    int ph_lo, ph_hi;
};
enum { I_XP = 0, I_XS, I_CK, I_CV, I_ST, I_CP, I_CSM, I_WADA, I_BADA, I_NPRE, I_NPOST, I_WIN, I_SINK, I_WPA, I_WPR, I_WO, I_F1G, I_F1U, I_F1D, I_F2G, I_F2U, I_F2D };

__device__ __forceinline__ float bf2f(unsigned short b) { return __uint_as_float(((unsigned)b) << 16); }
__device__ __forceinline__ float bflo(unsigned w) { return __uint_as_float(w << 16); }
__device__ __forceinline__ float bfhi(unsigned w) { return __uint_as_float(w & 0xffff0000u); }
__device__ __forceinline__ float wave_sum(float v) {
#pragma unroll
    for (int o = 1; o < 64; o <<= 1) v += __shfl_xor(v, o);
    return v;
}
__device__ __forceinline__ float wave_max(float v) {
#pragma unroll
    for (int o = 1; o < 64; o <<= 1) v = fmaxf(v, __shfl_xor(v, o));
    return v;
}
__device__ __forceinline__ float silu_f(float x) { return x * __builtin_amdgcn_rcpf(1.0f + __expf(-x)); }
__device__ __forceinline__ float sigm_f(float x) { return __builtin_amdgcn_rcpf(1.0f + __expf(-x)); }
__device__ __forceinline__ float log2_gamma(int h) { return log2f(1.0f - exp2f(-5.0f - (float)h)); }
__device__ __forceinline__ f32x4 mfma16(bf16x8 a, bf16x8 b, f32x4 c) { return __builtin_amdgcn_mfma_f32_16x16x32_bf16(a, b, c, 0, 0, 0); }

struct EpiF32 {
    static constexpr bool PERM = false, AFTER_DRAIN = false;
    float* C; int ldc; const float* bias;
    __device__ __forceinline__ void operator()(const f32x4 (&acc)[2][2][4][2], const pg8::Unit& u, int wr, int wc, int fr, int fq) const {
        const int row0 = u.pm * 256 + wr * 64 + fr, col0 = u.pn * 256 + wc * 32 + 4 * fq;
        f32x4 bv[2][2];
#pragma unroll
        for (int bj = 0; bj < 2; ++bj)
#pragma unroll
            for (int n = 0; n < 2; ++n) bv[bj][n] = bias ? *(const f32x4*)(bias + col0 + bj * 128 + n * 16) : (f32x4){0.f, 0.f, 0.f, 0.f};
#pragma unroll
        for (int ai = 0; ai < 2; ++ai)
#pragma unroll
            for (int m = 0; m < 4; ++m) { float* rowp = C + (size_t)(row0 + ai * 128 + m * 16) * ldc + col0;
#pragma unroll
                for (int bj = 0; bj < 2; ++bj)
#pragma unroll
                    for (int n = 0; n < 2; ++n) *(f32x4*)(rowp + bj * 128 + n * 16) = acc[ai][bj][m][n] + bv[bj][n]; }
    }
};
struct EpiPart {
    static constexpr bool PERM = true, AFTER_DRAIN = false;
    bf16_t* P01; bf16_t* P23;
    __device__ __forceinline__ void operator()(const f32x4 (&acc)[2][2][4][2], const pg8::Unit& u, int wr, int wc, int fr, int fq) const {
        bf16_t* O = (u.ks < 2 ? P01 : P23) + (size_t)(u.ks & 1) * MT * D;
        const int row0 = u.pm * 256 + wr * 64 + fr, col0 = u.pn * 256 + wc * 32 + 8 * fq;
#pragma unroll
        for (int ai = 0; ai < 2; ++ai)
#pragma unroll
            for (int m = 0; m < 4; ++m) {
                bf16_t* rowp = O + (size_t)(row0 + ai * 128 + m * 16) * D + col0;
#pragma unroll
                for (int bj = 0; bj < 2; ++bj) {
                    const f32x4 v0 = acc[ai][bj][m][0], v1 = acc[ai][bj][m][1];
                    u32x4 w; w.x = cvt_pk_bf16(v0[0], v0[1]); w.y = cvt_pk_bf16(v0[2], v0[3]); w.z = cvt_pk_bf16(v1[0], v1[1]); w.w = cvt_pk_bf16(v1[2], v1[3]);
                    *(u32x4*)(rowp + bj * 128) = w;
                }
            }
    }
};
struct EpiSwiGLU {
    static constexpr bool PERM = true, AFTER_DRAIN = false;
    bf16_t* O;
    __device__ __forceinline__ void operator()(const f32x4 (&acc)[2][2][4][2], const pg8::Unit& u, int wr, int wc, int fr, int fq) const {
        const int row0 = u.pm * 256 + wr * 64 + fr, col0 = u.pn * 128 + wc * 32 + 8 * fq;
#pragma unroll
        for (int ai = 0; ai < 2; ++ai)
#pragma unroll
            for (int m = 0; m < 4; ++m) {
                bf16_t* rowp = O + (size_t)(row0 + ai * 128 + m * 16) * DFF + col0;
                const f32x4 g0 = acc[ai][0][m][0], g1 = acc[ai][0][m][1], u0 = acc[ai][1][m][0], u1 = acc[ai][1][m][1];
                u32x4 w;
                w.x = cvt_pk_bf16(silu_f(g0[0]) * u0[0], silu_f(g0[1]) * u0[1]); w.y = cvt_pk_bf16(silu_f(g0[2]) * u0[2], silu_f(g0[3]) * u0[3]);
                w.z = cvt_pk_bf16(silu_f(g1[0]) * u1[0], silu_f(g1[1]) * u1[1]); w.w = cvt_pk_bf16(silu_f(g1[2]) * u1[2], silu_f(g1[3]) * u1[3]);
                *(u32x4*)rowp = w;
            }
    }
};
struct EpiWin {
    static constexpr bool PERM = true, AFTER_DRAIN = false;
    bf16_t* O; const float* rc; const float* rs;
    __device__ __forceinline__ void operator()(const f32x4 (&acc)[2][2][4][2], const pg8::Unit& u, int wr, int wc, int fr, int fq) const {
        const int pn = u.pn, row0 = u.pm * 256 + wr * 64 + fr;
        if (pn >= 6 && pn < 14) {
            const int slice = (pn - 6) >> 2, tt = (pn - 6) & 3, head = 2 * tt + (wc >> 1), d0 = 32 * (wc & 1) + 8 * fq;
            const int colbase = C_QR + slice * 1024 + head * 128 + d0;
            const float sc = slice ? 0.08838834764831845f : 1.0f;
#pragma unroll
            for (int ai = 0; ai < 2; ++ai)
#pragma unroll
                for (int m = 0; m < 4; ++m) {
                    const int row = row0 + ai * 128 + m * 16;
                    const int pidx = row < NP ? (row & 4095) : 4096 + ((row - NP) & 7);
                    const f32x4 c0 = *(const f32x4*)(rc + pidx * 64 + d0), c1 = *(const f32x4*)(rc + pidx * 64 + d0 + 4);
                    const f32x4 s0 = *(const f32x4*)(rs + pidx * 64 + d0), s1 = *(const f32x4*)(rs + pidx * 64 + d0 + 4);
                    const f32x4 a0 = acc[ai][0][m][0] * sc, a1 = acc[ai][0][m][1] * sc, b0 = acc[ai][1][m][0] * sc, b1 = acc[ai][1][m][1] * sc;
                    const f32x4 p0 = a0 * c0 - b0 * s0, p1 = a1 * c1 - b1 * s1, q0 = a0 * s0 + b0 * c0, q1 = a1 * s1 + b1 * c1;
                    u32x4 w1, w2;
                    w1.x = cvt_pk_bf16(p0[0], p0[1]); w1.y = cvt_pk_bf16(p0[2], p0[3]); w1.z = cvt_pk_bf16(p1[0], p1[1]); w1.w = cvt_pk_bf16(p1[2], p1[3]);
                    w2.x = cvt_pk_bf16(q0[0], q0[1]); w2.y = cvt_pk_bf16(q0[2], q0[3]); w2.z = cvt_pk_bf16(q1[0], q1[1]); w2.w = cvt_pk_bf16(q1[2], q1[3]);
                    bf16_t* rowp = O + (size_t)row * DIN + colbase;
                    *(u32x4*)rowp = w1; *(u32x4*)(rowp + 64) = w2;
                }
        } else {
            const int mode = pn < 22 ? 0 : (pn < 30 ? 1 : 2);
            const int col0 = pn * 256 + wc * 32 + 8 * fq;
#pragma unroll
            for (int ai = 0; ai < 2; ++ai)
#pragma unroll
                for (int m = 0; m < 4; ++m) {
                    bf16_t* rowp = O + (size_t)(row0 + ai * 128 + m * 16) * DIN + col0;
#pragma unroll
                    for (int bj = 0; bj < 2; ++bj) {
                        f32x4 v0 = acc[ai][bj][m][0], v1 = acc[ai][bj][m][1];
                        if (mode == 1) {
#pragma unroll
                            for (int j = 0; j < 4; ++j) { v0[j] = silu_f(v0[j]); v1[j] = silu_f(v1[j]); }
                        } else if (mode == 2) {
#pragma unroll
                            for (int j = 0; j < 4; ++j) { v0[j] = sigm_f(v0[j]); v1[j] = sigm_f(v1[j]); }
                        }
                        u32x4 w; w.x = cvt_pk_bf16(v0[0], v0[1]); w.y = cvt_pk_bf16(v0[2], v0[3]); w.z = cvt_pk_bf16(v1[0], v1[1]); w.w = cvt_pk_bf16(v1[2], v1[3]);
                        *(u32x4*)(rowp + bj * 128) = w;
                    }
                }
        }
    }
};
struct EpiPa {
    static constexpr bool PERM = true, AFTER_DRAIN = false;
    float* T; const bf16_t* P;
    __device__ __forceinline__ void operator()(const f32x4 (&acc)[2][2][4][2], const pg8::Unit& u, int wr, int wc, int fr, int fq) const {
        const int row0 = u.pm * 256 + wr * 64 + fr, col0 = u.pn * 256 + wc * 32 + 8 * fq;
#pragma unroll
        for (int ai = 0; ai < 2; ++ai) {
            u32x4 gq[4][2];
#pragma unroll
            for (int m = 0; m < 4; ++m)
#pragma unroll
                for (int bj = 0; bj < 2; ++bj) gq[m][bj] = *(const u32x4*)(P + (size_t)(row0 + ai * 128 + m * 16) * DIN + C_GA + col0 + bj * 128);
#pragma unroll
            for (int m = 0; m < 4; ++m) {
                const int row = row0 + ai * 128 + m * 16;
#pragma unroll
                for (int bj = 0; bj < 2; ++bj) {
                    const u32x4 g = gq[m][bj];
                    f32x4 v0 = acc[ai][bj][m][0], v1 = acc[ai][bj][m][1];
                    v0[0] *= bflo(g.x); v0[1] *= bfhi(g.x); v0[2] *= bflo(g.y); v0[3] *= bfhi(g.y);
                    v1[0] *= bflo(g.z); v1[1] *= bfhi(g.z); v1[2] *= bflo(g.w); v1[3] *= bfhi(g.w);
                    float* tp = T + (size_t)row * D + col0 + bj * 128;
                    *(f32x4*)tp = v0; *(f32x4*)(tp + 4) = v1;
                }
            }
        }
    }
};
struct EpiPr {
    static constexpr bool PERM = true, AFTER_DRAIN = false;
    const float* T; const bf16_t* P; bf16_t* O;
    __device__ __forceinline__ void operator()(const f32x4 (&acc)[2][2][4][2], const pg8::Unit& u, int wr, int wc, int fr, int fq) const {
        const int row0 = u.pm * 256 + wr * 64 + fr, col0 = u.pn * 256 + wc * 32 + 8 * fq;
#pragma unroll
        for (int ai = 0; ai < 2; ++ai)
#pragma unroll
            for (int mp = 0; mp < 2; ++mp) {
                u32x4 gq[2][2]; f32x4 t0[2][2], t1[2][2];
#pragma unroll
                for (int mi = 0; mi < 2; ++mi)
#pragma unroll
                    for (int bj = 0; bj < 2; ++bj) {
                        const int row = row0 + ai * 128 + (2 * mp + mi) * 16;
                        gq[mi][bj] = *(const u32x4*)(P + (size_t)row * DIN + C_GB + col0 + bj * 128);
                        const float* tp = T + (size_t)row * D + col0 + bj * 128;
                        t0[mi][bj] = *(const f32x4*)tp; t1[mi][bj] = *(const f32x4*)(tp + 4);
                    }
#pragma unroll
                for (int mi = 0; mi < 2; ++mi)
#pragma unroll
                    for (int bj = 0; bj < 2; ++bj) {
                        const int m = 2 * mp + mi, row = row0 + ai * 128 + m * 16;
                        const u32x4 g = gq[mi][bj]; const f32x4 a0 = t0[mi][bj], a1 = t1[mi][bj];
                        f32x4 v0 = acc[ai][bj][m][0], v1 = acc[ai][bj][m][1];
                        v0[0] = a0[0] + v0[0] * bflo(g.x); v0[1] = a0[1] + v0[1] * bfhi(g.x); v0[2] = a0[2] + v0[2] * bflo(g.y); v0[3] = a0[3] + v0[3] * bfhi(g.y);
                        v1[0] = a1[0] + v1[0] * bflo(g.z); v1[1] = a1[1] + v1[1] * bfhi(g.z); v1[2] = a1[2] + v1[2] * bflo(g.w); v1[3] = a1[3] + v1[3] * bfhi(g.w);
                        u32x4 w; w.x = cvt_pk_bf16(v0[0], v0[1]); w.y = cvt_pk_bf16(v0[2], v0[3]); w.z = cvt_pk_bf16(v1[0], v1[1]); w.w = cvt_pk_bf16(v1[2], v1[3]);
                        *(u32x4*)(O + (size_t)row * D + col0 + bj * 128) = w;
                    }
            }
    }
};

template <class Epi>
__device__ __forceinline__ void run_gemm(LAS unsigned char* lds, const bf16_t* A, const bf16_t* Bt, int M, int N, int K, const Epi& E, int ns = 1) {
    pg8::Gemm g; g.A = A; g.Bt = Bt; g.M = M; g.N = N; g.K = K / ns; g.ld = K;
    pg8::StaticOrder S; S.init(M, N, (int)gridDim.x, (int)blockIdx.x, ns);
    pg8::gemm_phase<Epi, pg8::StaticOrder>(lds, g, S, E);
}

__device__ __forceinline__ void transpose_item(const float* __restrict__ W, int K, int N, bf16_t* WT, int k0, int n0, int drow, LAS float* scr, int lane) {
#pragma unroll 8
    for (int i = 0; i < 32; ++i) { const int kk = 2 * i + (lane >> 5); scr[kk * 33 + (lane & 31)] = W[(size_t)(k0 + kk) * N + n0 + (lane & 31)]; }
    LDS_WAIT();
    const int c = lane & 7;
#pragma unroll
    for (int j = 0; j < 4; ++j) { const int n = (lane >> 3) + 8 * j; const LAS float* s = scr + (8 * c) * 33 + n;
        u32x4 o; o.x = cvt_pk_bf16(s[0 * 33], s[1 * 33]); o.y = cvt_pk_bf16(s[2 * 33], s[3 * 33]); o.z = cvt_pk_bf16(s[4 * 33], s[5 * 33]); o.w = cvt_pk_bf16(s[6 * 33], s[7 * 33]);
        *(u32x4*)(WT + (size_t)(drow + n) * K + k0 + 8 * c) = o; }
    LDS_WAIT();
}
__device__ __forceinline__ int map_gu(int n0, int up) { return 256 * (n0 >> 7) + (n0 & 127) + (up ? 128 : 0); }
__device__ __forceinline__ int map_win(int n0) {
    if (n0 < C_QR || n0 >= C_VR) return n0;
    const int s = n0 - C_QR, slice = s >> 10, within = s & 1023, h = within >> 7, half = (within >> 6) & 1, d0 = within & 63;
    return C_QR + slice * 1024 + (h >> 1) * 256 + half * 128 + (h & 1) * 64 + d0;
}
__device__ __forceinline__ int tjob_items(int j) {
    return (j == 0 || j == 1 || j == 7 || j == 8) ? (D / 64) * (DFF / 32) : (j == 2 || j == 9) ? (DFF / 64) * (D / 32) : j == 3 ? (D / 64) * (DIN / 32) : j == 4 ? (1024 / 64) * (D / 32) : (D / 64) * (D / 32);
}
__device__ __forceinline__ void run_tjobs(const Params& p, LAS unsigned char* lds, int jlo, int jhi, int widx, int nw, int skip = 0, int limit = 0x7fffffff) {
    const int lane = threadIdx.x & 63, wave = threadIdx.x >> 6;
    LAS float* scr = (LAS float*)(lds + wave * 8704);
    unsigned char* ws = p.ws;
    int total = 0;
    for (int j = jlo; j < jhi; ++j) total += tjob_items(j);
    if (total > skip + limit) total = skip + limit;
    for (int it = skip + widx; it < total; it += nw) {
        int r = it, j = jlo;
        while (r >= tjob_items(j)) { r -= tjob_items(j); ++j; }
        const float* W; int K, N; bf16_t* WT; int kind;
        switch (j) {
        case 0: W = p.in[I_F1G]; K = D; N = DFF; WT = (bf16_t*)(ws + WS_WGU1); kind = 1; break;
        case 1: W = p.in[I_F1U]; K = D; N = DFF; WT = (bf16_t*)(ws + WS_WGU1); kind = 2; break;
        case 2: W = p.in[I_F1D]; K = DFF; N = D; WT = (bf16_t*)(ws + WS_WD1); kind = 0; break;
        case 3: W = p.in[I_WIN]; K = D; N = DIN; WT = (bf16_t*)(ws + WS_WIN); kind = 3; break;
        case 4: W = p.in[I_WPA]; K = 1024; N = D; WT = (bf16_t*)(ws + WS_WPA); kind = 0; break;
        case 5: W = p.in[I_WPR]; K = D; N = D; WT = (bf16_t*)(ws + WS_WPR); kind = 0; break;
        case 6: W = p.in[I_WO]; K = D; N = D; WT = (bf16_t*)(ws + WS_WO); kind = 0; break;
        case 7: W = p.in[I_F2G]; K = D; N = DFF; WT = (bf16_t*)(ws + WS_WGU2); kind = 1; break;
        case 8: W = p.in[I_F2U]; K = D; N = DFF; WT = (bf16_t*)(ws + WS_WGU2); kind = 2; break;
        default: W = p.in[I_F2D]; K = DFF; N = D; WT = (bf16_t*)(ws + WS_WD2); kind = 0; break;
        }
        const int nblk = N / 32, kb = r / nblk, nb = r - kb * nblk, k0 = 64 * kb, n0 = 32 * nb;
        const int drow = kind == 0 ? n0 : (kind == 3 ? map_win(n0) : map_gu(n0, kind == 2));
        transpose_item(W, K, N, WT, k0, n0, drow, scr, lane);
    }
}
__device__ __forceinline__ void tail_tjobs(const Params& p, LAS unsigned char* lds, int nunits, int jlo, int jhi, int skip = 0, int limit = 0x7fffffff) {
    const int G = gridDim.x, rem = nunits % G, c = blockIdx.x;
    if (rem == 0) { run_tjobs(p, lds, jlo, jhi, c * 8 + (threadIdx.x >> 6), G * 8, skip, limit); return; }
    if (c >= rem) run_tjobs(p, lds, jlo, jhi, (c - rem) * 8 + (threadIdx.x >> 6), (G - rem) * 8, skip, limit);
}
__device__ __forceinline__ void phase_prep(const Params& p, LAS unsigned char* lds) {
    const int tid = threadIdx.x, wave = tid >> 6;
    unsigned char* ws = p.ws;
    const int gt = blockIdx.x * 512 + tid, NGT = gridDim.x * 512;
    bf16_t* CS = (bf16_t*)(ws + WS_CS);
    for (int i = gt; i < 256 * D / 4; i += NGT) {
        const int r = i >> 9, k = (i & 511) * 4;
        u32x2 w = {0u, 0u};
        if (r < 130) {
            const float* c = r < 2 ? p.in[I_CP] + (size_t)r * D : p.in[I_CSM] + (size_t)(r - 2) * D;
            const f32x4 v = *(const f32x4*)(c + k);
            w.x = cvt_pk_bf16(silu_f(v[0]), silu_f(v[1])); w.y = cvt_pk_bf16(silu_f(v[2]), silu_f(v[3]));
        }
        *(u32x2*)(CS + (size_t)r * D + k) = w;
    }
    float* rc = (float*)(ws + WS_ROTC); float* rs = (float*)(ws + WS_ROTS);
    for (int i = gt; i < 4104 * 64; i += NGT) {
        const int pi = i >> 6, d = i & 63;
        const float pos = pi < 4096 ? (float)pi : (float)(16384 + (pi - 4096));
        const float inv = (float)exp(-((double)d / 63.0) * 9.210340371976184);
        const float ang = pos * inv;
        double rev = (double)ang * 0.15915494309189535; rev -= rint(rev);
        const float rf = (float)rev;
        rc[i] = __builtin_amdgcn_cosf(rf); rs[i] = __builtin_amdgcn_sinf(rf);
    }
    run_tjobs(p, lds, 0, 2, blockIdx.x * 8 + wave, gridDim.x * 8);
}
__device__ __forceinline__ void phase_ada(const Params& p, LAS unsigned char* lds) {
    const int tid = threadIdx.x, lane = tid & 63, wave = tid >> 6, fr = lane & 15, fq = lane >> 4;
    const int gw = blockIdx.x * 8 + wave, NGW = gridDim.x * 8;
    constexpr int NT = NADA / 16;
    const int nblk_ada = (NT + 7) / 8;
    if ((int)blockIdx.x >= nblk_ada) { run_tjobs(p, lds, 3, 4, (blockIdx.x - nblk_ada) * 8 + wave, ((int)gridDim.x - nblk_ada) * 8, 0, 8832); return; }
    const bf16_t* CS = (const bf16_t*)(p.ws + WS_CS);
    float* MOD = (float*)(p.ws + WS_MOD);
    const float* W = p.in[I_WADA];
    LAS bf16_t* As0 = (LAS bf16_t*)lds;
    LAS bf16_t* As1 = As0 + 144 * 136;
    {
        const int t = gw;
        const int n = 16 * (t < NT ? t : NT - 1) + fr;
        f32x4 acc[9];
#pragma unroll
        for (int mt = 0; mt < 9; ++mt) acc[mt] = (f32x4){0.f, 0.f, 0.f, 0.f};
#define ADA_ALOAD(g_) do { _Pragma("unroll") for (int tt = 0; tt < 5; ++tt) { const int pc = tid + 512 * tt; if (pc < 2304) av[tt] = *(const u32x4*)(CS + (size_t)(pc >> 4) * D + 128 * (g_) + (pc & 15) * 8); } } while (0)
#define ADA_ASTORE(buf) do { _Pragma("unroll") for (int tt = 0; tt < 5; ++tt) { const int pc = tid + 512 * tt; if (pc < 2304) *(LAS u32x4*)((buf) + (pc >> 4) * 136 + (pc & 15) * 8) = av[tt]; } } while (0)
#define ADA_WLOAD(wv, g_) do { const float* wp_ = W + (size_t)(128 * (g_) + 8 * fq) * NADA + n; \
        _Pragma("unroll") for (int c = 0; c < 4; ++c) _Pragma("unroll") for (int i = 0; i < 8; ++i) wv[c][i] = wp_[(size_t)(32 * c + i) * NADA]; } while (0)
#define ADA_COMPUTE(wv, buf) do { _Pragma("unroll") for (int c = 0; c < 4; ++c) { \
            union { bf16x8 v; u32x4 q; } bf; \
            bf.q.x = cvt_pk_bf16(wv[c][0], wv[c][1]); bf.q.y = cvt_pk_bf16(wv[c][2], wv[c][3]); bf.q.z = cvt_pk_bf16(wv[c][4], wv[c][5]); bf.q.w = cvt_pk_bf16(wv[c][6], wv[c][7]); \
            const LAS bf16_t* ap = (buf) + fr * 136 + 32 * c + 8 * fq; \
            _Pragma("unroll") for (int mt = 0; mt < 9; ++mt) acc[mt] = mfma16(*(const LAS bf16x8*)(ap + (16 * mt) * 136), bf.v, acc[mt]); } } while (0)
        float wa[4][8], wb[4][8]; u32x4 av[5];
        ADA_ALOAD(0); ADA_WLOAD(wa, 0);
        ADA_ASTORE(As0);
        ADA_ALOAD(1); ADA_WLOAD(wb, 1);
        __syncthreads();
#pragma unroll 1
        for (int g = 0; g < 16; g += 2) {
            ADA_COMPUTE(wa, As0);
            ADA_ASTORE(As1);
            if (g + 2 < 16) { ADA_ALOAD(g + 2); ADA_WLOAD(wa, g + 2); }
            __syncthreads();
            ADA_COMPUTE(wb, As1);
            if (g + 2 < 16) ADA_ASTORE(As0);
            if (g + 3 < 16) { ADA_ALOAD(g + 3); ADA_WLOAD(wb, g + 3); }
            __syncthreads();
        }
#undef ADA_ALOAD
#undef ADA_ASTORE
#undef ADA_WLOAD
#undef ADA_COMPUTE
        const int sec = n >> 11, i3 = sec / 3, j3 = sec - 3 * i3, cc = n & 2047;
        const float bias = p.in[I_BADA][n];
        float mul = 1.0f, add = bias;
        if (j3 == 1) { mul = p.in[I_NPRE][i3 * D + cc]; add = bias + 1.0f; }
        else if (j3 == 2) mul = p.in[I_NPOST][i3 * D + cc] * (i3 == 1 ? 1.0f : 0.5f);
#pragma unroll
        for (int mt = 0; mt < 9; ++mt)
#pragma unroll
            for (int jj = 0; jj < 4; ++jj) { const int m = 16 * mt + 4 * fq + jj; if (m < 130 && t < NT) MOD[(size_t)m * NADA + n] = (acc[mt][jj] + add) * mul; }
    }
}

template <int KIND>
__device__ __forceinline__ void phase_row(const Params& p) {
    const int tid = threadIdx.x, lane = tid & 63, wave = tid >> 6;
    const int gw = blockIdx.x * 8 + wave, NGW = gridDim.x * 8;
    const float* MOD = (const float*)(p.ws + WS_MOD);
    const bf16_t* P01 = (const bf16_t*)(p.ws + WS_F);
    const bf16_t* P23 = (const bf16_t*)(p.ws + WS_PART23);
    bf16_t* HB = (bf16_t*)(p.ws + WS_HB);
    float* X = p.out;
#pragma unroll 1
    for (int row = gw; row < MT; row += NGW) {
        const int mrow = row < NP ? (row >> 12) : 2 + ((row - NP) >> 3);
        const float* mod = MOD + (size_t)mrow * NADA;
        const float* xin = row < NP ? p.in[I_XP] + (size_t)row * D : p.in[I_XS] + (size_t)(row - NP) * D;
        const float* xs = (KIND <= 1) ? xin : X + (size_t)row * D;
        f32x4 v[8], b1[8], b2[8];
#pragma unroll
        for (int j = 0; j < 8; ++j) v[j] = *(const f32x4*)(xs + 4 * (lane + 64 * j));
        __builtin_amdgcn_sched_barrier(0);
        if (KIND == 0) {
#pragma unroll
            for (int j = 0; j < 8; ++j) { b1[j] = *(const f32x4*)(mod + (KIND * 3 + 1) * D + 4 * (lane + 64 * j)); b2[j] = *(const f32x4*)(mod + (KIND * 3) * D + 4 * (lane + 64 * j)); }
        }
        if (KIND > 0) {
            u32x2 pr[4][8]; f32x4 a1[8];
#pragma unroll
            for (int j = 0; j < 8; ++j) {
                const size_t o = (size_t)row * D + 4 * (lane + 64 * j);
                pr[0][j] = *(const u32x2*)(P01 + o); pr[1][j] = *(const u32x2*)(P01 + (size_t)MT * D + o);
                pr[2][j] = *(const u32x2*)(P23 + o); pr[3][j] = *(const u32x2*)(P23 + (size_t)MT * D + o);
                a1[j] = *(const f32x4*)(mod + ((KIND - 1) * 3 + 2) * D + 4 * (lane + 64 * j));
            }
            __builtin_amdgcn_sched_barrier(0);
            f32x4 f[8]; float ss = 0.f;
#pragma unroll
            for (int j = 0; j < 8; ++j) {
                f[j][0] = (bflo(pr[0][j].x) + bflo(pr[1][j].x)) + (bflo(pr[2][j].x) + bflo(pr[3][j].x));
                f[j][1] = (bfhi(pr[0][j].x) + bfhi(pr[1][j].x)) + (bfhi(pr[2][j].x) + bfhi(pr[3][j].x));
                f[j][2] = (bflo(pr[0][j].y) + bflo(pr[1][j].y)) + (bflo(pr[2][j].y) + bflo(pr[3][j].y));
                f[j][3] = (bfhi(pr[0][j].y) + bfhi(pr[1][j].y)) + (bfhi(pr[2][j].y) + bfhi(pr[3][j].y));
                ss += (f[j][0] * f[j][0] + f[j][1] * f[j][1]) + (f[j][2] * f[j][2] + f[j][3] * f[j][3]);
            }
            __builtin_amdgcn_sched_barrier(0);
            if (KIND < 3) {
#pragma unroll
                for (int j = 0; j < 8; ++j) { b1[j] = *(const f32x4*)(mod + (KIND * 3 + 1) * D + 4 * (lane + 64 * j)); b2[j] = *(const f32x4*)(mod + (KIND * 3) * D + 4 * (lane + 64 * j)); }
            }
            __builtin_amdgcn_sched_barrier(0);
            const float rstd = rsqrtf(wave_sum(ss) * (1.0f / D) + EPS);
#pragma unroll
            for (int j = 0; j < 8; ++j) {
                v[j] = v[j] + (f[j] * rstd) * a1[j];
                *(f32x4*)(X + (size_t)row * D + 4 * (lane + 64 * j)) = v[j];
            }
        }
        __builtin_amdgcn_sched_barrier(0);
        if (KIND < 3) {
            float ss = 0.f;
#pragma unroll
            for (int j = 0; j < 8; ++j) ss += (v[j][0] * v[j][0] + v[j][1] * v[j][1]) + (v[j][2] * v[j][2] + v[j][3] * v[j][3]);
            const float rstd = rsqrtf(wave_sum(ss) * (1.0f / D) + EPS);
#pragma unroll
            for (int j = 0; j < 8; ++j) {
                const f32x4 h = (v[j] * rstd) * b1[j] + b2[j];
                u32x2 w; w.x = cvt_pk_bf16(h[0], h[1]); w.y = cvt_pk_bf16(h[2], h[3]);
                *(u32x2*)(HB + (size_t)row * D + 4 * (lane + 64 * j)) = w;
            }
        }
    }
}

__device__ __forceinline__ void kv_unit(const Params& p, LAS unsigned char* lds, int u) {
    const int tid = threadIdx.x, lane = tid & 63, w = tid >> 6, fr = lane & 15, fq = lane >> 4;
    const int c = u & 31, bh = u >> 5, h = bh & 7, b = bh >> 3;
    const int row0 = b * 4096 + c * 128;
    const bf16_t* PROJ = (const bf16_t*)(p.ws + WS_PROJ);
    const bf16_t* Kg = PROJ + (size_t)row0 * DIN + C_KR + h * 128;
    const bf16_t* Vg = PROJ + (size_t)row0 * DIN + C_VR + h * 256;
    LAS bf16_t* Kt = (LAS bf16_t*)lds;
    LAS bf16_t* Vt = (LAS bf16_t*)(lds + 34816);
    const float l2g = log2_gamma(h);
    {
        const int j = tid & 127, cgp = tid >> 7;
        const float kw = exp2f((float)(127 - j) * l2g);
#pragma unroll
        for (int it = 0; it < 4; ++it) {
            const int ch = cgp + 4 * it;
            const u32x4 v = *(const u32x4*)(Kg + (size_t)j * DIN + ch * 8);
            const unsigned a0 = cvt_pk_bf16(bflo(v.x) * kw, bfhi(v.x) * kw), a1 = cvt_pk_bf16(bflo(v.y) * kw, bfhi(v.y) * kw), a2 = cvt_pk_bf16(bflo(v.z) * kw, bfhi(v.z) * kw), a3 = cvt_pk_bf16(bflo(v.w) * kw, bfhi(v.w) * kw);
            LAS bf16_t* dst = Kt + (ch * 8) * 136 + j;
            dst[0 * 136] = (bf16_t)a0; dst[1 * 136] = (bf16_t)(a0 >> 16); dst[2 * 136] = (bf16_t)a1; dst[3 * 136] = (bf16_t)(a1 >> 16);
            dst[4 * 136] = (bf16_t)a2; dst[5 * 136] = (bf16_t)(a2 >> 16); dst[6 * 136] = (bf16_t)a3; dst[7 * 136] = (bf16_t)(a3 >> 16);
        }
#pragma unroll
        for (int it = 0; it < 8; ++it) {
            const int ch = cgp + 4 * it;
            const u32x4 v = *(const u32x4*)(Vg + (size_t)j * DIN + ch * 8);
            LAS bf16_t* dst = Vt + (ch * 8) * 136 + j;
            dst[0 * 136] = (bf16_t)v.x; dst[1 * 136] = (bf16_t)(v.x >> 16); dst[2 * 136] = (bf16_t)v.y; dst[3 * 136] = (bf16_t)(v.y >> 16);
            dst[4 * 136] = (bf16_t)v.z; dst[5 * 136] = (bf16_t)(v.z >> 16); dst[6 * 136] = (bf16_t)v.w; dst[7 * 136] = (bf16_t)(v.w >> 16);
        }
    }
    __syncthreads();
    {
        bf16_t* VTg = (bf16_t*)(p.ws + WS_VT) + (size_t)u * 32768;
#pragma unroll
        for (int it = 0; it < 8; ++it) { const int piece = tid + 512 * it, e = piece >> 4, jc = piece & 15;
            *(u32x4*)(VTg + e * 128 + jc * 8) = *(const LAS u32x4*)(Vt + e * 136 + jc * 8); }
    }
    f32x4 acc[8][2];
#pragma unroll
    for (int mt = 0; mt < 8; ++mt) { acc[mt][0] = (f32x4){0.f, 0.f, 0.f, 0.f}; acc[mt][1] = (f32x4){0.f, 0.f, 0.f, 0.f}; }
#pragma unroll
    for (int kc = 0; kc < 4; ++kc) {
        const bf16x8 b0 = *(const LAS bf16x8*)(Vt + (32 * w + fr) * 136 + kc * 32 + fq * 8);
        const bf16x8 b1 = *(const LAS bf16x8*)(Vt + (32 * w + 16 + fr) * 136 + kc * 32 + fq * 8);
#pragma unroll
        for (int mt = 0; mt < 8; ++mt) {
            const bf16x8 a = *(const LAS bf16x8*)(Kt + (16 * mt + fr) * 136 + kc * 32 + fq * 8);
            acc[mt][0] = mfma16(a, b0, acc[mt][0]); acc[mt][1] = mfma16(a, b1, acc[mt][1]);
        }
    }
    float* KVT = (float*)(p.ws + WS_F) + (size_t)u * 32768;
#pragma unroll
    for (int nt = 0; nt < 2; ++nt)
#pragma unroll
        for (int mt = 0; mt < 8; ++mt) *(f32x4*)(KVT + (32 * w + 16 * nt + fr) * 128 + 16 * mt + 4 * fq) = acc[mt][nt];
    __syncthreads();
}

__device__ __forceinline__ void attn_unit(const Params& p, LAS unsigned char* lds, int u) {
    const int tid = threadIdx.x, lane = tid & 63, w = tid >> 6, fr = lane & 15, fq = lane >> 4;
    const int kvh = u & 3, qb = (u >> 2) & 31, b = u >> 7;
    const int rowq0 = b * 4096 + qb * 128, rowk0 = rowq0 - 128;
    const bf16_t* PROJ = (const bf16_t*)(p.ws + WS_PROJ);
    bf16_t* OA = (bf16_t*)(p.ws + WS_OA);
    LAS bf16_t* Vt = (LAS bf16_t*)lds;
    {
        const int s = tid & 255, hf = tid >> 8;
        const bool ok = (qb > 0) || (s >= 128);
#pragma unroll
        for (int it = 0; it < 4; ++it) {
            const int ch = hf * 4 + it;
            u32x4 v = {0u, 0u, 0u, 0u};
            if (ok) v = *(const u32x4*)(PROJ + (size_t)(rowk0 + s) * DIN + C_VA + kvh * 64 + ch * 8);
            LAS bf16_t* dst = Vt + (ch * 8) * 296 + s;
            dst[0 * 296] = (bf16_t)v.x; dst[1 * 296] = (bf16_t)(v.x >> 16); dst[2 * 296] = (bf16_t)v.y; dst[3 * 296] = (bf16_t)(v.y >> 16);
            dst[4 * 296] = (bf16_t)v.z; dst[5 * 296] = (bf16_t)(v.z >> 16); dst[6 * 296] = (bf16_t)v.w; dst[7 * 296] = (bf16_t)(v.w >> 16);
        }
        const int d = tid >> 3, k4 = (tid & 7) * 4;
        *(LAS u32x2*)(Vt + d * 296 + 256 + k4) = (u32x2){0u, 0u};
    }
    __syncthreads();
    const int g = w >> 1, hh = kvh * 4 + g;
    const float slope = exp2f(-0.5f * (float)(hh + 1));
    const float sink = p.in[I_SINK][hh];
#pragma unroll 1
    for (int qt = 0; qt < 4; ++qt) {
        const int a0 = (w & 1) * 64 + 16 * qt, a = a0 + fr, kt0 = a0 >> 4;
        const bf16_t* qp = PROJ + (size_t)(rowq0 + a) * DIN + C_QA + hh * 64 + fq * 8;
        const bf16x8 q0 = *(const bf16x8*)qp, q1 = *(const bf16x8*)(qp + 32);
        f32x4 s[10];
#pragma unroll
        for (int kt = 0; kt < 10; ++kt) {
            const int sidx = 16 * (kt0 + kt) + fr;
            int krow = rowk0 + sidx;
            if (sidx > 255) krow = rowq0;
            if (krow < 0) krow = 0;
            const bf16_t* kp = PROJ + (size_t)krow * DIN + C_KA + kvh * 64 + fq * 8;
            const bf16x8 k0 = *(const bf16x8*)kp, k1 = *(const bf16x8*)(kp + 32);
            f32x4 z = {0.f, 0.f, 0.f, 0.f};
            z = mfma16(k0, q0, z); s[kt] = mfma16(k1, q1, z);
        }
        float m = sink;
#pragma unroll
        for (int kt = 0; kt < 10; ++kt)
#pragma unroll
            for (int jj = 0; jj < 4; ++jj) {
                const int sidx = 16 * (kt0 + kt) + 4 * fq + jj, dist = 128 + a - sidx;
                const bool valid = dist >= 0 && dist <= 128 && (qb > 0 || sidx >= 128);
                const float sc = valid ? s[kt][jj] * 0.125f - slope * (float)dist : -INFINITY;
                s[kt][jj] = sc; m = fmaxf(m, sc);
            }
        m = fmaxf(m, __shfl_xor(m, 16)); m = fmaxf(m, __shfl_xor(m, 32));
        float l = 0.f;
#pragma unroll
        for (int kt = 0; kt < 10; ++kt)
#pragma unroll
            for (int jj = 0; jj < 4; ++jj) { const float e = __expf(s[kt][jj] - m); s[kt][jj] = e; l += e; }
        l += __shfl_xor(l, 16); l += __shfl_xor(l, 32);
        l += __expf(sink - m);
        f32x4 o[4];
#pragma unroll
        for (int dt = 0; dt < 4; ++dt) o[dt] = (f32x4){0.f, 0.f, 0.f, 0.f};
#pragma unroll
        for (int cc = 0; cc < 5; ++cc) {
            union { bf16x8 v; u32x4 w; } pf;
            pf.w.x = cvt_pk_bf16(s[2 * cc][0], s[2 * cc][1]); pf.w.y = cvt_pk_bf16(s[2 * cc][2], s[2 * cc][3]);
            pf.w.z = cvt_pk_bf16(s[2 * cc + 1][0], s[2 * cc + 1][1]); pf.w.w = cvt_pk_bf16(s[2 * cc + 1][2], s[2 * cc + 1][3]);
#pragma unroll
            for (int dt = 0; dt < 4; ++dt) {
                const LAS bf16_t* vp = Vt + (16 * dt + fr) * 296 + 16 * (kt0 + 2 * cc) + 4 * fq;
                union { bf16x8 v; u32x2 h[2]; } af;
                af.h[0] = *(const LAS u32x2*)vp; af.h[1] = *(const LAS u32x2*)(vp + 16);
                o[dt] = mfma16(af.v, pf.v, o[dt]);
            }
        }
        const float inv = 1.0f / l;
        bf16_t* op = OA + (size_t)(rowq0 + a) * 1024 + hh * 64 + 4 * fq;
#pragma unroll
        for (int dt = 0; dt < 4; ++dt) { u32x2 wv; wv.x = cvt_pk_bf16(o[dt][0] * inv, o[dt][1] * inv); wv.y = cvt_pk_bf16(o[dt][2] * inv, o[dt][3] * inv); *(u32x2*)(op + 16 * dt) = wv; }
    }
    __syncthreads();
}

__device__ __forceinline__ void sattn_unit(const Params& p, LAS unsigned char* lds, int u) {
    const int tid = threadIdx.x, lane = tid & 63, w = tid >> 6;
    const int kvh = u & 3, n = u >> 2;
    const bf16_t* PROJ = (const bf16_t*)(p.ws + WS_PROJ);
    bf16_t* OA = (bf16_t*)(p.ws + WS_OA);
    LAS float* Ks = (LAS float*)lds;
    LAS float* Vs = Ks + 136 * 65;
    LAS float* Qs = Vs + 136 * 64;
    LAS float* Ps = Qs + 2048;
    const float* ck = p.in[I_CK]; const float* cv = p.in[I_CV];
    {
        f32x4 kq[4], vq[4];
#pragma unroll
        for (int t = 0; t < 4; ++t) { const int pc = tid + 512 * t, sr = pc >> 4, d4 = (pc & 15) * 4; const size_t o = ((size_t)(n * 128 + sr)) * 256 + kvh * 64 + d4;
            kq[t] = *(const f32x4*)(ck + o); vq[t] = *(const f32x4*)(cv + o); }
        const bf16_t* rn = PROJ + (size_t)(NP + n * 8 + (tid >> 6)) * DIN + kvh * 64 + (tid & 63);
        const bf16_t kn = rn[C_KA], vn = rn[C_VA];
        const int qr_ = tid >> 4, qd4 = (tid & 15) * 4, qg = qr_ >> 3, qa = qr_ & 7;
        const u32x2 qv = *(const u32x2*)(PROJ + (size_t)(NP + n * 8 + qa) * DIN + C_QA + (kvh * 4 + qg) * 64 + qd4);
#pragma unroll
        for (int t = 0; t < 4; ++t) { const int pc = tid + 512 * t, sr = pc >> 4, d4 = (pc & 15) * 4;
            Ks[sr * 65 + d4] = kq[t][0]; Ks[sr * 65 + d4 + 1] = kq[t][1]; Ks[sr * 65 + d4 + 2] = kq[t][2]; Ks[sr * 65 + d4 + 3] = kq[t][3];
            *(LAS f32x4*)(Vs + sr * 64 + d4) = vq[t]; }
        Ks[(128 + (tid >> 6)) * 65 + (tid & 63)] = bf2f(kn); Vs[(128 + (tid >> 6)) * 64 + (tid & 63)] = bf2f(vn);
        *(LAS f32x4*)(Qs + qr_ * 64 + qd4) = (f32x4){bflo(qv.x), bfhi(qv.x), bflo(qv.y), bfhi(qv.y)};
    }
    __syncthreads();
    float linv[4];
#pragma unroll
    for (int rr = 0; rr < 4; ++rr) {
        const int r = 4 * w + rr, g = r >> 3, a = r & 7, hh = kvh * 4 + g;
        const float slope = exp2f(-0.5f * (float)(hh + 1)), sink = p.in[I_SINK][hh];
        float sc[3]; float m = sink;
#pragma unroll
        for (int t = 0; t < 3; ++t) {
            const int s = lane + 64 * t; sc[t] = -INFINITY;
            if (s < 136) {
                float dot = 0.f;
                for (int d = 0; d < 64; ++d) dot += Qs[r * 64 + d] * Ks[s * 65 + d];
                const int dist = 128 + a - s;
                if (dist >= 0 && dist <= 128) sc[t] = dot * 0.125f - slope * (float)dist;
            }
            m = fmaxf(m, sc[t]);
        }
        m = wave_max(m);
        float l = 0.f;
#pragma unroll
        for (int t = 0; t < 3; ++t) { const int s = lane + 64 * t; const float e = __expf(sc[t] - m); if (s < 136) { Ps[r * 136 + s] = e; l += e; } }
        l = wave_sum(l) + __expf(sink - m);
        linv[rr] = 1.0f / l;
    }
    __syncthreads();
#pragma unroll
    for (int rr = 0; rr < 4; ++rr) {
        const int r = 4 * w + rr, g = r >> 3, a = r & 7, hh = kvh * 4 + g;
        float o = 0.f;
        for (int s = 0; s < 136; ++s) o += Ps[r * 136 + s] * Vs[s * 64 + lane];
        OA[(size_t)(NP + n * 8 + a) * 1024 + hh * 64 + lane] = (bf16_t)(cvt_pk_bf16(o * linv[rr], 0.f) & 0xffffu);
    }
    __syncthreads();
}

__device__ __forceinline__ void sret_unit(const Params& p, LAS unsigned char* lds, int u) {
    const int tid = threadIdx.x, lane = tid & 63, w = tid >> 6;
    const int h = u & 7, n = u >> 3;
    const bf16_t* PROJ = (const bf16_t*)(p.ws + WS_PROJ);
    bf16_t* ORb = (bf16_t*)(p.ws + WS_OR);
    LAS float* qT = (LAS float*)lds;
    LAS float* kT = qT + 1024;
    LAS float* vS = kT + 1024;
    LAS float* SCP = vS + 2048;
    LAS float* PART = SCP + 512;
    const float l2g = log2_gamma(h);
    const float g8 = exp2f(8.0f * l2g), gm8 = exp2f(-8.0f * l2g);
    const size_t rbase = (size_t)(NP + n * 8);
    const int e4 = lane * 4;
    const float* S0 = p.in[I_ST] + ((size_t)(n * 8 + h) * 128) * 256 + e4;
    float* S1 = p.out + O_SRS + ((size_t)(n * 8 + h) * 128) * 256 + e4;
    f32x4 S[16];
    {
        bf16_t qv[2], kv[2];
#pragma unroll
        for (int t = 0; t < 2; ++t) { const int idx = tid + 512 * t, i = idx >> 7, d = idx & 127; const bf16_t* r = PROJ + (rbase + i) * DIN + h * 128 + d; qv[t] = r[C_QR]; kv[t] = r[C_KR]; }
        const u32x2 v2 = *(const u32x2*)(PROJ + (rbase + w) * DIN + C_VR + h * 256 + e4);
#pragma unroll
        for (int it = 0; it < 16; ++it) S[it] = *(const f32x4*)(S0 + (size_t)(w + 8 * it) * 256);
#pragma unroll
        for (int t = 0; t < 2; ++t) { const int idx = tid + 512 * t, i = idx >> 7, d = idx & 127;
            qT[d * 8 + i] = bf2f(qv[t]) * exp2f((float)(i + 1) * l2g); kT[d * 8 + i] = bf2f(kv[t]) * exp2f((float)(7 - i) * l2g); }
        *(LAS f32x4*)(vS + w * 256 + e4) = (f32x4){bflo(v2.x), bfhi(v2.x), bflo(v2.y), bfhi(v2.y)};
    }
    __syncthreads();
    {
        const int i = lane >> 3, j = lane & 7; float sc = 0.f;
#pragma unroll
        for (int dd = 0; dd < 16; ++dd) { const int d = 16 * w + dd; sc += qT[d * 8 + i] * kT[d * 8 + j]; }
        SCP[w * 64 + lane] = sc;
    }
    f32x4 vv[8], ya[8];
#pragma unroll
    for (int j = 0; j < 8; ++j) { vv[j] = *(const LAS f32x4*)(vS + j * 256 + e4); ya[j] = (f32x4){0.f, 0.f, 0.f, 0.f}; }
#pragma unroll
    for (int it = 0; it < 16; ++it) {
        const int d = w + 8 * it;
        const f32x4 qa = *(const LAS f32x4*)(qT + d * 8), qb = *(const LAS f32x4*)(qT + d * 8 + 4);
        const f32x4 ka = *(const LAS f32x4*)(kT + d * 8), kb = *(const LAS f32x4*)(kT + d * 8 + 4);
        f32x4 sn = S[it] * g8;
        sn += vv[0] * ka[0]; sn += vv[1] * ka[1]; sn += vv[2] * ka[2]; sn += vv[3] * ka[3];
        sn += vv[4] * kb[0]; sn += vv[5] * kb[1]; sn += vv[6] * kb[2]; sn += vv[7] * kb[3];
        *(f32x4*)(S1 + (size_t)d * 256) = sn;
        ya[0] += S[it] * qa[0]; ya[1] += S[it] * qa[1]; ya[2] += S[it] * qa[2]; ya[3] += S[it] * qa[3];
        ya[4] += S[it] * qb[0]; ya[5] += S[it] * qb[1]; ya[6] += S[it] * qb[2]; ya[7] += S[it] * qb[3];
    }
#pragma unroll
    for (int i = 0; i < 8; ++i) *(LAS f32x4*)(PART + (w * 8 + i) * 256 + e4) = ya[i];
    __syncthreads();
    {
        const int i = w;
        f32x4 y = {0.f, 0.f, 0.f, 0.f};
#pragma unroll
        for (int ww = 0; ww < 8; ++ww) y += *(const LAS f32x4*)(PART + (ww * 8 + i) * 256 + e4);
#pragma unroll
        for (int j = 0; j < 8; ++j) {
            float sc = 0.f;
#pragma unroll
            for (int ww = 0; ww < 8; ++ww) sc += SCP[ww * 64 + i * 8 + j];
            if (j <= i) y += vv[j] * (sc * gm8);
        }
        const float ss = wave_sum((y[0] * y[0] + y[1] * y[1]) + (y[2] * y[2] + y[3] * y[3]));
        const float rstd = rsqrtf(ss * (1.0f / 256.0f) + EPS);
        const u32x2 gv = *(const u32x2*)(PROJ + (rbase + i) * DIN + C_GR + h * 256 + e4);
        u32x2 wv; wv.x = cvt_pk_bf16(y[0] * rstd * bflo(gv.x), y[1] * rstd * bfhi(gv.x)); wv.y = cvt_pk_bf16(y[2] * rstd * bflo(gv.y), y[3] * rstd * bfhi(gv.y));
        *(u32x2*)(ORb + (rbase + i) * D + h * 256 + e4) = wv;
    }
    __syncthreads();
}

__device__ __forceinline__ void phase_mix1(const Params& p, LAS unsigned char* lds) {
    const int G = gridDim.x;
    for (int u = blockIdx.x; u < 512; u += G) kv_unit(p, lds, u);
    for (int u = blockIdx.x; u < 256; u += G) attn_unit(p, lds, u);
    for (int u = blockIdx.x; u < 512; u += G) sattn_unit(p, lds, u);
    for (int u = blockIdx.x; u < 1024; u += G) sret_unit(p, lds, u);
    const bf16_t* PROJ = (const bf16_t*)(p.ws + WS_PROJ);
    const int gt = blockIdx.x * 512 + threadIdx.x, NGT = G * 512;
    for (int i = gt; i < 2 * 65536 / 4; i += NGT) {
        const int which = i >> 14, r = i & 16383, bw = r >> 6, c4 = (r & 63) * 4, b = bw >> 7, wdx = bw & 127;
        const u32x2 v = *(const u32x2*)(PROJ + (size_t)(b * 4096 + 3968 + wdx) * DIN + (which ? C_VA : C_KA) + c4);
        *(f32x4*)(p.out + (which ? O_VWP : O_KWP) + (size_t)bw * 256 + c4) = (f32x4){bflo(v.x), bfhi(v.x), bflo(v.y), bfhi(v.y)};
    }
    for (int i0 = gt; i0 < 2 * 4194304 / 4; i0 += 8 * NGT) {
        f32x4 o[8];
#pragma unroll
        for (int t = 0; t < 8; ++t) {
            const int i = i0 + t * NGT;
            if (i < 2 * 4194304 / 4) {
                const int which = i >> 20, r = i & 1048575, nw = r >> 6, c4 = (r & 63) * 4, n = nw >> 7, wdx = nw & 127;
                if (wdx < 120) o[t] = *(const f32x4*)((which ? p.in[I_CV] : p.in[I_CK]) + ((size_t)(n * 128 + wdx + 8)) * 256 + c4);
                else { const u32x2 v = *(const u32x2*)(PROJ + (size_t)(NP + n * 8 + (wdx - 120)) * DIN + (which ? C_VA : C_KA) + c4); o[t] = (f32x4){bflo(v.x), bfhi(v.x), bflo(v.y), bfhi(v.y)}; }
            }
        }
#pragma unroll
        for (int t = 0; t < 8; ++t) {
            const int i = i0 + t * NGT;
            if (i < 2 * 4194304 / 4) { const int which = i >> 20, r = i & 1048575, nw = r >> 6, c4 = (r & 63) * 4; *(f32x4*)(p.out + (which ? O_VWS : O_KWS) + (size_t)nw * 256 + c4) = o[t]; }
        }
    }
}

__device__ __forceinline__ void phase_scan(const Params& p) {
    const float* KVT = (const float*)(p.ws + WS_F);
    bf16_t* SPT = (bf16_t*)(p.ws + WS_SPT);
    const int gt = blockIdx.x * 512 + threadIdx.x, NGT = gridDim.x * 512;
    for (int it = gt; it < 16 * 8192; it += NGT) {
        const int bh = it >> 13, rem = it & 8191, e = rem >> 5, d4 = (rem & 31) * 4, h = bh & 7;
        const float g128 = exp2f(128.0f * log2_gamma(h));
        f32x4 S = {0.f, 0.f, 0.f, 0.f};
        const size_t off = (size_t)e * 128 + d4;
        f32x4 kvr[32];
#pragma unroll
        for (int c = 0; c < 32; ++c) kvr[c] = *(const f32x4*)(KVT + (size_t)(bh * 32 + c) * 32768 + off);
#pragma unroll
        for (int c = 0; c < 32; ++c) {
            const size_t uo = (size_t)(bh * 32 + c) * 32768 + off;
            u32x2 wv; wv.x = cvt_pk_bf16(S[0], S[1]); wv.y = cvt_pk_bf16(S[2], S[3]);
            *(u32x2*)(SPT + uo) = wv;
            S = S * g128 + kvr[c];
        }
        float* so = p.out + O_SRP + (size_t)bh * 32768 + e;
        so[(size_t)(d4 + 0) * 256] = S[0]; so[(size_t)(d4 + 1) * 256] = S[1]; so[(size_t)(d4 + 2) * 256] = S[2]; so[(size_t)(d4 + 3) * 256] = S[3];
    }
}

__device__ __forceinline__ void phase_ret3(const Params& p) {
    const int tid = threadIdx.x, lane = tid & 63, w = tid >> 6, fr = lane & 15, fq = lane >> 4;
    const bf16_t* PROJ = (const bf16_t*)(p.ws + WS_PROJ);
    bf16_t* ORb = (bf16_t*)(p.ws + WS_OR);
    for (int u = blockIdx.x; u < 512; u += gridDim.x) {
        const int c = u & 31, bh = u >> 5, h = bh & 7, b = bh >> 3;
        const int row0 = b * 4096 + c * 128, i0 = 16 * w, irow = row0 + i0 + fr;
        const float l2g = log2_gamma(h);
        const bf16_t* SPTu = (const bf16_t*)(p.ws + WS_SPT) + (size_t)u * 32768;
        const bf16_t* VTu = (const bf16_t*)(p.ws + WS_VT) + (size_t)u * 32768;
        bf16x8 Qf[4];
        { const bf16_t* qp = PROJ + (size_t)irow * DIN + C_QR + h * 128 + fq * 8;
#pragma unroll
          for (int kc = 0; kc < 4; ++kc) Qf[kc] = *(const bf16x8*)(qp + kc * 32); }
        f32x4 sa[8];
#pragma unroll
        for (int jt = 0; jt < 8; ++jt) {
            sa[jt] = (f32x4){0.f, 0.f, 0.f, 0.f};
            if (jt <= w) {
                const bf16_t* kp = PROJ + (size_t)(row0 + 16 * jt + fr) * DIN + C_KR + h * 128 + fq * 8;
#pragma unroll
                for (int kc = 0; kc < 4; ++kc) sa[jt] = mfma16(*(const bf16x8*)(kp + kc * 32), Qf[kc], sa[jt]);
            }
        }
        const int ii = i0 + fr;
#pragma unroll
        for (int jt = 0; jt < 8; ++jt)
#pragma unroll
            for (int jj = 0; jj < 4; ++jj) { const int dj = ii - (16 * jt + 4 * fq + jj); sa[jt][jj] = dj >= 0 ? sa[jt][jj] * exp2f((float)dj * l2g) : 0.f; }
        union { bf16x8 v; u32x4 q; } Pf[4];
#pragma unroll
        for (int cc = 0; cc < 4; ++cc) {
            Pf[cc].q.x = cvt_pk_bf16(sa[2 * cc][0], sa[2 * cc][1]); Pf[cc].q.y = cvt_pk_bf16(sa[2 * cc][2], sa[2 * cc][3]);
            Pf[cc].q.z = cvt_pk_bf16(sa[2 * cc + 1][0], sa[2 * cc + 1][1]); Pf[cc].q.w = cvt_pk_bf16(sa[2 * cc + 1][2], sa[2 * cc + 1][3]);
        }
        const float qw = exp2f((float)(ii + 1) * l2g);
        f32x4 y[16];
#pragma unroll
        for (int et = 0; et < 16; ++et) {
            f32x4 a = {0.f, 0.f, 0.f, 0.f};
            const bf16_t* sp = SPTu + (16 * et + fr) * 128 + fq * 8;
#pragma unroll
            for (int kc = 0; kc < 4; ++kc) a = mfma16(*(const bf16x8*)(sp + kc * 32), Qf[kc], a);
            a = a * qw;
            const bf16_t* vp = VTu + (16 * et + fr) * 128 + 4 * fq;
#pragma unroll
            for (int cc = 0; cc < 4; ++cc) {
                if (2 * cc <= w) {
                    union { bf16x8 v; u32x2 hh[2]; } af;
                    af.hh[0] = *(const u32x2*)(vp + 32 * cc); af.hh[1] = *(const u32x2*)(vp + 32 * cc + 16);
                    a = mfma16(af.v, Pf[cc].v, a);
                }
            }
            y[et] = a;
        }
        float ss = 0.f;
#pragma unroll
        for (int et = 0; et < 16; ++et) ss += (y[et][0] * y[et][0] + y[et][1] * y[et][1]) + (y[et][2] * y[et][2] + y[et][3] * y[et][3]);
        ss += __shfl_xor(ss, 16); ss += __shfl_xor(ss, 32);
        const float rstd = rsqrtf(ss * (1.0f / 256.0f) + EPS);
        const bf16_t* gp = PROJ + (size_t)irow * DIN + C_GR + h * 256 + 4 * fq;
        bf16_t* op = ORb + (size_t)irow * D + h * 256 + 4 * fq;
#pragma unroll
        for (int et = 0; et < 16; ++et) {
            const u32x2 gv = *(const u32x2*)(gp + 16 * et);
            u32x2 wv; wv.x = cvt_pk_bf16(y[et][0] * rstd * bflo(gv.x), y[et][1] * rstd * bfhi(gv.x)); wv.y = cvt_pk_bf16(y[et][2] * rstd * bflo(gv.y), y[et][3] * rstd * bfhi(gv.y));
            *(u32x2*)(op + 16 * et) = wv;
        }
    }
}

#define XB_TMO      128
#define XB_XCNT(j)  (256  + 64 * (j))
#define XB_XSUB(j)  (1280 + 64 * (j))
#define XB_XGEN(j)  (2304 + 64 * (j))
#define XB_TOP      3328
#define XB_TOPGEN   3392
#define XCD_BAR_WORDS 3456
#define XB_SPIN_CAP (1u << 18)

__device__ __forceinline__ unsigned xb_ld(unsigned* p)              { return __hip_atomic_load(p, __ATOMIC_RELAXED, __HIP_MEMORY_SCOPE_AGENT); }
__device__ __forceinline__ unsigned xb_add(unsigned* p, unsigned v) { return __hip_atomic_fetch_add(p, v, __ATOMIC_RELAXED, __HIP_MEMORY_SCOPE_AGENT); }
__device__ __forceinline__ unsigned xb_xcc_id() { return (unsigned)__builtin_amdgcn_s_getreg((3 << 11) | 20) & 0xFu; }
#define XB_SPIN(cond, bar) do { unsigned _sp = 0; while (cond) { __builtin_amdgcn_s_sleep(1); \
    if ((++_sp & 255u) == 0u) { if (xb_ld(&(bar)[XB_TMO])) break; if (_sp > XB_SPIN_CAP) { atomicAdd(&(bar)[XB_TMO], 1u); break; } } } } while (0)

struct XcdBarrier {
    unsigned* bar; unsigned x;
    volatile LAS unsigned* st;
};

__device__ __forceinline__ XcdBarrier xcd_barrier_post(unsigned* bar, volatile LAS unsigned* st) {
    XcdBarrier b; b.bar = bar; b.x = xb_xcc_id(); b.st = st;
    if (threadIdx.x == 0) (void)xb_add(&bar[XB_XCNT(b.x)], 1u);
    return b;
}
__device__ __forceinline__ void xcd_barrier_complete(unsigned* bar, unsigned x, unsigned& nloc, unsigned& nx) {
    const unsigned G = gridDim.x * gridDim.y * gridDim.z;
    unsigned sum, cnt, mine, sp = 0u;
    for (;;) {
        sum = 0u; cnt = 0u; mine = 0u;
#pragma unroll
        for (unsigned j = 0; j < 16; ++j) { const unsigned c = xb_ld(&bar[XB_XCNT(j)]); sum += c; cnt += (c > 0u) ? 1u : 0u; mine = (j == x) ? c : mine; }
        if (sum == G) break;
        __builtin_amdgcn_s_sleep(1);
        if ((++sp & 255u) == 0u) { if (xb_ld(&bar[XB_TMO])) break; if (sp > XB_SPIN_CAP) { atomicAdd(&bar[XB_TMO], 1u); break; } }
    }
    nloc = mine > 0u ? mine : 1u; nx = cnt > 0u ? cnt : 1u;
}

__device__ __forceinline__ void xcd_barrier(const XcdBarrier& b) {
    asm volatile("s_waitcnt vmcnt(0)" ::: "memory");
    __syncthreads();
    if (threadIdx.x == 0) {
        unsigned* bar = b.bar;
        __builtin_amdgcn_s_waitcnt(0);
        unsigned nloc = b.st[0], nx = b.st[1];
        if (nloc == 0u) { xcd_barrier_complete(bar, b.x, nloc, nx); b.st[0] = nloc; b.st[1] = nx; }
        const unsigned old = xb_add(&bar[XB_XSUB(b.x)], 1u);
        const unsigned gen = old / nloc;
        if (old + 1u == (gen + 1u) * nloc) {
            __builtin_amdgcn_fence(__ATOMIC_RELEASE, "agent");
            asm volatile("s_waitcnt vmcnt(0)" ::: "memory");
            const unsigned og = xb_add(&bar[XB_TOP], 1u);
            const unsigned tg = og / nx;
            if (og + 1u == (tg + 1u) * nx) xb_add(&bar[XB_TOPGEN], 1u);
            else XB_SPIN(xb_ld(&bar[XB_TOPGEN]) == tg, bar);
            __builtin_amdgcn_fence(__ATOMIC_ACQUIRE, "agent");
            xb_add(&bar[XB_XGEN(b.x)], 1u);
            asm volatile("s_waitcnt vmcnt(0)" ::: "memory");
        } else {
            XB_SPIN(xb_ld(&bar[XB_XGEN(b.x)]) == gen, bar);
            __builtin_amdgcn_fence(__ATOMIC_ACQUIRE, "agent");
            asm volatile("s_waitcnt vmcnt(0)" ::: "memory");
        }
    }
    __syncthreads();
}


__device__ __forceinline__ void gemm_part(const Params& p, LAS unsigned char* lds, int which) {
    unsigned char* ws = p.ws;
    EpiPart E; E.P01 = (bf16_t*)(ws + WS_F); E.P23 = (bf16_t*)(ws + WS_PART23);
    const bf16_t* A; const bf16_t* Bt; int K;
    if (which == 1) { A = (const bf16_t*)(ws + WS_PROJ); Bt = (const bf16_t*)(ws + WS_WD1); K = DFF; }
    else if (which == 2) { A = (const bf16_t*)(ws + WS_HB); Bt = (const bf16_t*)(ws + WS_WO); K = D; }
    else { A = (const bf16_t*)(ws + WS_PROJ); Bt = (const bf16_t*)(ws + WS_WD2); K = DFF; }
    run_gemm(lds, A, Bt, MT, D, K, E, 4);
}
__device__ __forceinline__ void gemm_gu(const Params& p, LAS unsigned char* lds, int which) {
    unsigned char* ws = p.ws;
    EpiSwiGLU E; E.O = (bf16_t*)(ws + WS_PROJ);
    run_gemm(lds, (const bf16_t*)(ws + WS_HB), (const bf16_t*)(ws + (which == 0 ? WS_WGU1 : WS_WGU2)), MT, 2 * DFF, D, E);
}
__device__ __forceinline__ void gemm_win(const Params& p, LAS unsigned char* lds) {
    unsigned char* ws = p.ws;
    EpiWin E; E.O = (bf16_t*)(ws + WS_PROJ); E.rc = (const float*)(ws + WS_ROTC); E.rs = (const float*)(ws + WS_ROTS);
    run_gemm(lds, (const bf16_t*)(ws + WS_HB), (const bf16_t*)(ws + WS_WIN), MT, DIN, D, E);
}
__device__ __forceinline__ void gemm_papr(const Params& p, LAS unsigned char* lds) {
    unsigned char* ws = p.ws;
    EpiPa E1; E1.T = (float*)(ws + WS_F); E1.P = (const bf16_t*)(ws + WS_PROJ);
    run_gemm(lds, (const bf16_t*)(ws + WS_OA), (const bf16_t*)(ws + WS_WPA), MT, D, 1024, E1);
    EpiPr E2; E2.T = (const float*)(ws + WS_F); E2.P = (const bf16_t*)(ws + WS_PROJ); E2.O = (bf16_t*)(ws + WS_HB);
    run_gemm(lds, (const bf16_t*)(ws + WS_OR), (const bf16_t*)(ws + WS_WPR), MT, D, D, E2);
}

#ifndef XSYNC
#define XSYNC 0
#endif
#ifndef DUPMASK
#define DUPMASK 0
#endif
#ifndef PHMASK
#define PHMASK 0xFFFF
#endif
#define PHASE(k, body) if (((PHMASK >> (k)) & 1) && p.ph_lo <= (k) && (k) < p.ph_hi) { if ((k) > p.ph_lo) { xcd_barrier(xb); for (int _x = 0; _x < XSYNC; ++_x) xcd_barrier(xb); } body; if ((DUPMASK >> (k)) & 1) { xcd_barrier(xb); body; } }
__global__ __launch_bounds__(512, 2) void mega(Params p) {
    extern __shared__ __attribute__((aligned(16))) unsigned char shm[];
    LAS unsigned char* lds = (LAS unsigned char*)shm;
    cg::grid_group grid = cg::this_grid();
    if (p.ph_lo < 0) grid.sync();
    volatile LAS unsigned* xst = (volatile LAS unsigned*)(lds + LDS_BYTES - 16);
    if (threadIdx.x == 0) { xst[0] = 0u; xst[1] = 0u; }
    __syncthreads();
    const XcdBarrier xb = xcd_barrier_post((unsigned*)p.ws, xst);
    PHASE(PH_PREP, phase_prep(p, lds))
    PHASE(PH_ADA, phase_ada(p, lds))
    PHASE(PH_ROW0, phase_row<0>(p))
    PHASE(PH_GU1, (gemm_gu(p, lds, 0), tail_tjobs(p, lds, 36 * 44, 2, 3), tail_tjobs(p, lds, 36 * 44, 7, 8)))
    PHASE(PH_D1, (gemm_part(p, lds, 1), tail_tjobs(p, lds, 36 * 8 * 4, 4, 7), tail_tjobs(p, lds, 36 * 8 * 4, 3, 4, 8832)))
    PHASE(PH_ROW1, phase_row<1>(p))
    PHASE(PH_WIN, (gemm_win(p, lds), tail_tjobs(p, lds, 36 * 46, 8, 9)))
    PHASE(PH_MIX1, phase_mix1(p, lds))
    PHASE(PH_SCAN, phase_scan(p))
    PHASE(PH_RET3, phase_ret3(p))
    PHASE(PH_PAPR, (gemm_papr(p, lds), tail_tjobs(p, lds, 36 * 8, 9, 10)))
    PHASE(PH_WO, gemm_part(p, lds, 2))
    PHASE(PH_ROW2, phase_row<2>(p))
    PHASE(PH_GU2, gemm_gu(p, lds, 1))
    PHASE(PH_D2, gemm_part(p, lds, 3))
    PHASE(PH_ROW3, phase_row<3>(p))
}

extern "C" void kernel_launch(void* const* d_in, const int* in_sizes, int n_in, void* d_out, int out_size, void* d_ws, size_t ws_size, hipStream_t stream) {
    static int grid = 0;
    if (grid == 0) {
        if (n_in != 22 || ws_size < WS_END) { fprintf(stderr, "kernel_launch: need 22 inputs and %zu bytes of workspace (got %d, %zu)\n", (size_t)WS_END, n_in, ws_size); grid = -1; return; }
        int dev = 0, cus = 0, per_cu = 0;
        (void)hipGetDevice(&dev);
        (void)hipDeviceGetAttribute(&cus, hipDeviceAttributeMultiprocessorCount, dev);
        if (hipFuncSetAttribute((const void*)mega, hipFuncAttributeMaxDynamicSharedMemorySize, LDS_BYTES) != hipSuccess) { fprintf(stderr, "kernel_launch: hipFuncSetAttribute failed\n"); grid = -1; return; }
        if (hipOccupancyMaxActiveBlocksPerMultiprocessor(&per_cu, (const void*)mega, 512, LDS_BYTES) != hipSuccess || per_cu < 1) { fprintf(stderr, "kernel_launch: occupancy query says %d\n", per_cu); per_cu = 1; }
        (void)hipGetLastError();
        grid = cus;
        if (grid <= 0) grid = 256;
    }
    if (grid < 0) return;
    if (hipMemsetAsync(d_ws, 0, XCD_BAR_WORDS * sizeof(unsigned), stream) != hipSuccess) { fprintf(stderr, "kernel_launch: memset of the barrier words failed\n"); return; }
    Params p{};
    for (int i = 0; i < 22; ++i) p.in[i] = (const float*)d_in[i];
    p.out = (float*)d_out; p.ws = (unsigned char*)d_ws;
#if MK_SPLIT
    for (int ph = 0; ph < NPH; ++ph) {
        p.ph_lo = ph; p.ph_hi = ph + 1;
        void* args[] = {&p};
        hipError_t e = hipLaunchCooperativeKernel((const void*)mega, dim3(grid), dim3(512), args, LDS_BYTES, stream);
        if (e != hipSuccess) { fprintf(stderr, "cooperative launch failed: %s (grid %d)\n", hipGetErrorString(e), grid); break; }
    }
#else
    p.ph_lo = 0; p.ph_hi = NPH;
    void* args[] = {&p};
    hipError_t e = hipLaunchCooperativeKernel((const void*)mega, dim3(grid), dim3(512), args, LDS_BYTES, stream);
    if (e != hipSuccess) fprintf(stderr, "cooperative launch failed: %s (grid %d)\n", hipGetErrorString(e), grid);
#endif
}
```
